# Optimizing an MI355X kernel written in HIP

```python
import jax
import jax.numpy as jnp
from jax import lax
import numpy as np

D_MODEL = 1024
BATCH = 4
SEQ = 8192
DEPTH = 2

D_ATTN = D_MODEL // 2
N_ATTN_HEADS = 8
HEAD_DIM = D_ATTN // N_ATTN_HEADS
N_KV = 2
HEADS_PER_KV = N_ATTN_HEADS // N_KV
D_REC = D_MODEL - D_ATTN
N_REC_BLOCKS = 8
REC_BW = D_REC // N_REC_BLOCKS
L_CMP = 32
STRIDE = 16
L_SLC = 64
N_SEL = 16
N_LOCAL = 2
W_WIN = 512
CMP_HID = 2 * HEAD_DIM
NSA_QB = 64
R_CMP = L_CMP // STRIDE
R_SLC = L_SLC // STRIDE
N_GATES = 3
CONV_W = 4
C_LRU = 8.0
D_FF = 2816
N_EXPERTS = 8
TOP_K = 2
D_FF_EXPERT = 3584
MOE_BLOCK = 256
N_DENSE = (DEPTH + 1) // 2
N_MOE = DEPTH // 2
PLE_DIM = 256
RMS_EPS = 1e-6
NEG_INF = -1e30
KV_W = N_KV * HEAD_DIM
IN_SPLITS = (D_ATTN, KV_W, KV_W, KV_W, KV_W, KV_W, KV_W, N_ATTN_HEADS * N_GATES, D_REC, D_REC)
IN_COLS = sum(IN_SPLITS)

kernel_name = 'hybrid_nsa_rglru_moe_ple'


def rmsnorm(x, g):
    x32 = x.astype(jnp.float32)
    y = x32 * lax.rsqrt(jnp.mean(x32 * x32, axis=-1, keepdims=True) + RMS_EPS)
    return (y * g.astype(jnp.float32)).astype(x.dtype)


def alibi_slopes(n):
    return 2.0 ** (-8.0 * jnp.arange(1, n + 1, dtype=jnp.float32) / n)


def masked_softmax(s, mask):
    s = jnp.where(mask, s, NEG_INF)
    e = jnp.where(mask, jnp.exp(s - jnp.max(s, axis=-1, keepdims=True)), 0.0)
    return e / jnp.maximum(jnp.sum(e, axis=-1, keepdims=True), 1e-30)


def compress_blocks(kv, pos, w1, w2):
    b_, g_, t_, _ = kv.shape
    n_chunk = t_ // STRIDE
    n_cmp = n_chunk - R_CMP + 1
    chunks = kv.reshape(b_, g_, n_chunk, STRIDE, HEAD_DIM)
    blocks = jnp.concatenate([chunks[:, :, j:j + n_cmp] for j in range(R_CMP)], axis=3)
    flat = (blocks + pos).reshape(b_, g_, n_cmp, L_CMP * HEAD_DIM)
    return jax.nn.gelu(flat @ w1) @ w2


def nsa_attention(q, k_cmp, v_cmp, k_slc, v_slc, k_win, v_win, gates, cmp_pos, cmp_w1, cmp_w2):
    b_, t_ = q.shape[0], q.shape[1]
    n_qb = t_ // NSA_QB
    n_slc = t_ // L_SLC
    n_chunk = t_ // STRIDE
    k_top = min(N_SEL, n_slc)
    scale = HEAD_DIM ** -0.5
    grp = lambda a: a.transpose(0, 2, 1, 3)
    kc = compress_blocks(grp(k_cmp), cmp_pos[0], cmp_w1[0], cmp_w2[0])
    vc = compress_blocks(grp(v_cmp), cmp_pos[1], cmp_w1[1], cmp_w2[1])
    n_cmp = kc.shape[2]
    cmp_end = jnp.arange(n_cmp) * STRIDE + (L_CMP - 1)
    ks_blocks = grp(k_slc).reshape(b_, N_KV, n_slc, L_SLC, HEAD_DIM)
    vs_blocks = grp(v_slc).reshape(b_, N_KV, n_slc, L_SLC, HEAD_DIM)
    win_pad = ((0, 0), (0, 0), (W_WIN, 0), (0, 0))
    kw_pad = jnp.pad(grp(k_win), win_pad)
    vw_pad = jnp.pad(grp(v_win), win_pad)
    qg = q.reshape(b_, t_, N_KV, HEADS_PER_KV, HEAD_DIM).transpose(0, 2, 3, 1, 4)
    gg = jax.nn.sigmoid(gates.astype(jnp.float32)).reshape(b_, t_, N_KV, HEADS_PER_KV, N_GATES).transpose(0, 2, 3, 1, 4)
    q_blocks = jnp.moveaxis(qg.reshape(b_, N_KV, HEADS_PER_KV, n_qb, NSA_QB, HEAD_DIM), 3, 0)
    g_blocks = jnp.moveaxis(gg.reshape(b_, N_KV, HEADS_PER_KV, n_qb, NSA_QB, N_GATES), 3, 0)
    slopes = alibi_slopes(N_ATTN_HEADS).reshape(N_KV, HEADS_PER_KV, 1, 1)
    gather_blocks = jax.vmap(jax.vmap(lambda blocks, idx: blocks[idx]))
    blk_ids = jnp.arange(n_slc)
    win_offsets = jnp.arange(W_WIN + NSA_QB)

    def block_fn(args):
        qb, gb, qi = args
        s0 = qi * NSA_QB
        t = s0 + jnp.arange(NSA_QB)
        dist_c = t[:, None] - cmp_end[None, :]
        s_c = jnp.einsum('bghqd,bgcd->bghqc', qb, kc).astype(jnp.float32) * scale - slopes * dist_c.astype(jnp.float32)
        p_c = masked_softmax(s_c, dist_c >= 0)
        o_c = jnp.einsum('bghqc,bgcd->bghqd', p_c.astype(vc.dtype), vc)
        p_grp = jnp.pad(jnp.sum(p_c, axis=2), ((0, 0), (0, 0), (0, 0), (R_CMP - 1, R_CMP - 1)))
        p_chunk = sum(p_grp[..., R_CMP - 1 - n:R_CMP - 1 - n + n_chunk] for n in range(R_CMP))
        p_slc = p_chunk.reshape(b_, N_KV, NSA_QB, n_slc, R_SLC).sum(axis=-1)
        cur = t // L_SLC
        valid = blk_ids[None, :] <= cur[:, None]
        forced = valid & ((blk_ids[None, :] == 0) | (blk_ids[None, :] > cur[:, None] - N_LOCAL))
        score = jnp.where(forced, jnp.inf, jnp.where(valid, p_slc, -jnp.inf))
        _, sel = lax.top_k(score, k_top)
        ks_sel = gather_blocks(ks_blocks, sel)
        vs_sel = gather_blocks(vs_blocks, sel)
        pos_s = sel[..., None] * L_SLC + jnp.arange(L_SLC)
        dist_s = t[:, None, None] - pos_s
        mask_s = (sel <= cur[:, None])[..., None] & (dist_s >= 0)
        s_s = jnp.einsum('bghqd,bgqkld->bghqkl', qb, ks_sel).astype(jnp.float32) * scale - slopes[..., None] * dist_s[:, :, None].astype(jnp.float32)
        n_keys = k_top * L_SLC
        p_s = masked_softmax(s_s.reshape(b_, N_KV, HEADS_PER_KV, NSA_QB, n_keys), mask_s.reshape(b_, N_KV, 1, NSA_QB, n_keys))
        o_s = jnp.einsum('bghqn,bgqnd->bghqd', p_s.astype(vs_sel.dtype), vs_sel.reshape(b_, N_KV, NSA_QB, n_keys, HEAD_DIM))
        kwin = lax.dynamic_slice_in_dim(kw_pad, s0, W_WIN + NSA_QB, axis=2)
        vwin = lax.dynamic_slice_in_dim(vw_pad, s0, W_WIN + NSA_QB, axis=2)
        pos_w = s0 - W_WIN + win_offsets
        dist_w = t[:, None] - pos_w[None, :]
        mask_w = (pos_w[None, :] >= 0) & (dist_w >= 0) & (dist_w < W_WIN)
        s_w = jnp.einsum('bghqd,bgkd->bghqk', qb, kwin).astype(jnp.float32) * scale - slopes * dist_w.astype(jnp.float32)
        p_w = masked_softmax(s_w, mask_w)
        o_w = jnp.einsum('bghqk,bgkd->bghqd', p_w.astype(vwin.dtype), vwin)
        out = gb[..., 0:1] * o_c + gb[..., 1:2] * o_s + gb[..., 2:3] * o_w
        return out.astype(qb.dtype)

    out = lax.map(block_fn, (q_blocks, g_blocks, jnp.arange(n_qb)))
    out = jnp.moveaxis(out, 0, 3).reshape(b_, N_KV, HEADS_PER_KV, t_, HEAD_DIM)
    return out.transpose(0, 3, 1, 2, 4).reshape(b_, t_, D_ATTN)


def rglru_mixer(xr, yg, conv_w, conv_b, wa, ba, wx, bx, lam):
    b_, t_, c_ = xr.shape
    xc = lax.conv_general_dilated(xr, conv_w[:, None, :], window_strides=(1,), padding=[(CONV_W - 1, 0)],
                                  dimension_numbers=('NWC', 'WIO', 'NWC'), feature_group_count=c_) + conv_b
    xb = xc.reshape(b_, t_, N_REC_BLOCKS, REC_BW)
    r = jax.nn.sigmoid((jnp.einsum('btnc,ncd->btnd', xb, wa).reshape(b_, t_, c_) + ba).astype(jnp.float32))
    i = jax.nn.sigmoid((jnp.einsum('btnc,ncd->btnd', xb, wx).reshape(b_, t_, c_) + bx).astype(jnp.float32))
    log_a = -C_LRU * r * jax.nn.softplus(-lam.astype(jnp.float32))
    a = jnp.exp(log_a)
    b = jnp.sqrt(-jnp.expm1(2.0 * log_a)) * i * xc.astype(jnp.float32)

    def combine(left, right):
        a_l, b_l = left
        a_r, b_r = right
        return a_l * a_r, a_r * b_l + b_r

    _, h = lax.associative_scan(combine, (a, b), axis=1)
    return (h * jax.nn.gelu(yg.astype(jnp.float32))).astype(xr.dtype)


def dense_swiglu(h, wg, wu, wd):
    return (jax.nn.silu(h @ wg) * (h @ wu)) @ wd


def moe_swiglu(h, router_w, wg, wu, wd):
    n_tok, d_ = h.shape
    nk = n_tok * TOP_K
    n_blocks = -(-nk // MOE_BLOCK) + N_EXPERTS
    n_slots = n_blocks * MOE_BLOCK
    logits = (h @ router_w).astype(jnp.float32)
    top_logit, top_e = lax.top_k(logits, TOP_K)
    gates = jax.nn.softmax(top_logit, axis=-1).astype(h.dtype)
    flat_e = top_e.reshape(-1)
    flat_tok = jnp.arange(nk, dtype=jnp.int32) // TOP_K
    flat_g = gates.reshape(-1)
    order = jnp.argsort(flat_e, stable=True)
    e_sorted = flat_e[order]
    counts = jnp.bincount(flat_e, length=N_EXPERTS)
    starts = jnp.cumsum(counts) - counts
    padded = (counts + MOE_BLOCK - 1) // MOE_BLOCK * MOE_BLOCK
    pad_ends = jnp.cumsum(padded)
    pad_starts = pad_ends - padded
    dest = pad_starts[e_sorted] + jnp.arange(nk) - starts[e_sorted]
    slot_tok = jnp.full((n_slots,), n_tok, jnp.int32).at[dest].set(flat_tok[order])
    slot_g = jnp.zeros((n_slots,), h.dtype).at[dest].set(flat_g[order])
    block_e = jnp.minimum(jnp.searchsorted(pad_ends, jnp.arange(n_blocks) * MOE_BLOCK, side='right'), N_EXPERTS - 1)
    h_pad = jnp.concatenate([h, jnp.zeros((1, d_), h.dtype)], axis=0)
    xb = h_pad[slot_tok].reshape(n_blocks, MOE_BLOCK, d_)

    def expert_block(args):
        xblk, e = args
        return (jax.nn.silu(xblk @ wg[e]) * (xblk @ wu[e])) @ wd[e]

    yb = lax.map(expert_block, (xb, block_e)).reshape(n_slots, d_)
    y = jax.ops.segment_sum(yb * slot_g[:, None], slot_tok, num_segments=n_tok + 1)
    return y[:n_tok]


def setup_inputs(seed: int = 0) -> dict:
    key = jax.random.key(seed)
    k = jax.random.split(key, 32)
    f32 = jnp.float32
    nrm = lambda kk, shape, fan_in: jax.random.normal(kk, shape, f32) * (fan_in ** -0.5)
    gain = lambda kk, shape: 1.0 + 0.05 * jax.random.normal(kk, shape, f32)
    small = lambda kk, shape: 0.01 * jax.random.normal(kk, shape, f32)
    a0 = jax.random.uniform(k[13], (DEPTH, D_REC), f32, 0.9, 0.999)
    sig = a0 ** (1.0 / C_LRU)
    lru_lambda = jnp.log(sig) - jnp.log1p(-sig)
    return {
        'x': jax.random.normal(k[0], (BATCH, SEQ, D_MODEL), f32),
        'p': jax.random.normal(k[1], (DEPTH, BATCH, SEQ, PLE_DIM), f32),
        'attn_norm': gain(k[2], (DEPTH, D_MODEL)),
        'w_in': nrm(k[3], (DEPTH, D_MODEL, IN_COLS), D_MODEL),
        'cmp_pos': 0.02 * jax.random.normal(k[4], (DEPTH, 2, L_CMP, HEAD_DIM), f32),
        'cmp_w1': nrm(k[5], (DEPTH, 2, L_CMP * HEAD_DIM, CMP_HID), L_CMP * HEAD_DIM),
        'cmp_w2': nrm(k[6], (DEPTH, 2, CMP_HID, HEAD_DIM), CMP_HID),
        'conv_w': nrm(k[7], (DEPTH, CONV_W, D_REC), CONV_W),
        'conv_b': small(k[8], (DEPTH, D_REC)),
        'lru_wa': nrm(k[9], (DEPTH, N_REC_BLOCKS, REC_BW, REC_BW), REC_BW),
        'lru_ba': small(k[10], (DEPTH, D_REC)),
        'lru_wx': nrm(k[11], (DEPTH, N_REC_BLOCKS, REC_BW, REC_BW), REC_BW),
        'lru_bx': small(k[12], (DEPTH, D_REC)),
        'lru_lambda': lru_lambda,
        'out_norm_attn': gain(k[14], (DEPTH, D_ATTN)),
        'out_norm_rec': gain(k[15], (DEPTH, D_REC)),
        'w_out': nrm(k[16], (DEPTH, D_MODEL, D_MODEL), D_MODEL),
        'ffn_norm': gain(k[17], (DEPTH, D_MODEL)),
        'dense_w_gate': nrm(k[18], (N_DENSE, D_MODEL, D_FF), D_MODEL),
        'dense_w_up': nrm(k[19], (N_DENSE, D_MODEL, D_FF), D_MODEL),
        'dense_w_down': nrm(k[20], (N_DENSE, D_FF, D_MODEL), D_FF),
        'router_w': nrm(k[21], (N_MOE, D_MODEL, N_EXPERTS), D_MODEL),
        'moe_w_gate': nrm(k[22], (N_MOE, N_EXPERTS, D_MODEL, D_FF_EXPERT), D_MODEL),
        'moe_w_up': nrm(k[23], (N_MOE, N_EXPERTS, D_MODEL, D_FF_EXPERT), D_MODEL),
        'moe_w_down': nrm(k[24], (N_MOE, N_EXPERTS, D_FF_EXPERT, D_MODEL), D_FF_EXPERT),
        'ple_norm': gain(k[25], (DEPTH, D_MODEL)),
        'ple_w_gate': nrm(k[26], (DEPTH, D_MODEL, D_MODEL), D_MODEL),
        'ple_w_proj': nrm(k[27], (DEPTH, PLE_DIM, D_MODEL), PLE_DIM),
        'final_norm': gain(k[28], (D_MODEL,)),
    }


def reference(x, p, attn_norm, w_in, cmp_pos, cmp_w1, cmp_w2, conv_w, conv_b, lru_wa, lru_ba, lru_wx, lru_bx,
              lru_lambda, out_norm_attn, out_norm_rec, w_out, ffn_norm, dense_w_gate, dense_w_up, dense_w_down,
              router_w, moe_w_gate, moe_w_up, moe_w_down, ple_norm, ple_w_gate, ple_w_proj, final_norm):
    b_, t_, _ = x.shape
    split_idx = np.cumsum(IN_SPLITS)[:-1].tolist()
    for i in range(DEPTH):
        h = rmsnorm(x, attn_norm[i])
        q, kc, vc, ks_, vs_, kw, vw, g, xr, yg = jnp.split(h @ w_in[i], split_idx, axis=-1)
        kvh = (b_, t_, N_KV, HEAD_DIM)
        o_attn = nsa_attention(q.reshape(b_, t_, N_ATTN_HEADS, HEAD_DIM), kc.reshape(kvh), vc.reshape(kvh),
                               ks_.reshape(kvh), vs_.reshape(kvh), kw.reshape(kvh), vw.reshape(kvh),
                               g.reshape(b_, t_, N_ATTN_HEADS, N_GATES), cmp_pos[i], cmp_w1[i], cmp_w2[i])
        o_rec = rglru_mixer(xr, yg, conv_w[i], conv_b[i], lru_wa[i], lru_ba[i], lru_wx[i], lru_bx[i], lru_lambda[i])
        mixed = jnp.concatenate([rmsnorm(o_attn, out_norm_attn[i]), rmsnorm(o_rec, out_norm_rec[i])], axis=-1)
        x = x + mixed @ w_out[i]
        h = rmsnorm(x, ffn_norm[i])
        j = i // 2
        if i % 2 == 0:
            y = dense_swiglu(h, dense_w_gate[j], dense_w_up[j], dense_w_down[j])
        else:
            y = moe_swiglu(h.reshape(b_ * t_, D_MODEL), router_w[j], moe_w_gate[j], moe_w_up[j],
                           moe_w_down[j]).reshape(b_, t_, D_MODEL)
        x = x + y
        gate = jax.nn.sigmoid(rmsnorm(x, ple_norm[i]) @ ple_w_gate[i])
        x = x + gate * (p[i] @ ple_w_proj[i])
    return rmsnorm(x, final_norm)
```

```cpp
#include <hip/hip_runtime.h>
#include <cstdio>
#include <cstdint>

#ifndef MK_ONE_LAUNCH
#define MK_ONE_LAUNCH 0
#endif

#define GAS __attribute__((address_space(1)))
#define LAS __attribute__((address_space(3)))
typedef unsigned short bf16;
typedef float f32x4 __attribute__((ext_vector_type(4)));
typedef unsigned u32x4 __attribute__((ext_vector_type(4)));
typedef unsigned u32x2 __attribute__((ext_vector_type(2)));

constexpr int NB_ = 4, T_ = 8192, D_ = 1024, NTOK = NB_ * T_;
constexpr int DEPTH = 2;
constexpr int NH = 8, HD = 64, NG = 2, HG = 4;
constexpr int D_ATTN = 512, D_REC = 512;
constexpr int L_CMP = 32, STRIDE = 16, L_SLC = 64, N_SEL = 16, W_WIN = 512;
constexpr int N_CMP = T_ / STRIDE - 1;
constexpr int N_SLC = T_ / L_SLC;
constexpr int CMP_HID = 128;
constexpr int IN_COLS = 2328;
constexpr int C_Q = 0, C_KC = 512, C_VC = 640, C_KS = 768, C_VS = 896, C_KW = 1024, C_VW = 1152, C_G = 1280, C_XR = 1304, C_YG = 1816;
constexpr int D_FF = 2816, N_EXP = 8, D_FFE = 3584, FFE_HALF = 1792;
constexpr int MOE_BLOCK = 256, N_PANEL = NTOK * 2 / MOE_BLOCK + N_EXP, NSLOT = N_PANEL * MOE_BLOCK;
constexpr int PLE_DIM = 256;
constexpr float RMS_EPS = 1e-6f;
constexpr float LOG2E = 1.4426950408889634f;
constexpr float QSCALE = 0.125f * LOG2E;
constexpr int LRU_CHUNK = 128, LRU_NCH = T_ / LRU_CHUNK;

constexpr size_t MiB = 1u << 20;
constexpr size_t WS_CTL = 0, CTL_ZERO_BYTES = 1 * MiB;
constexpr size_t WS_SSP = 1 * MiB;
constexpr size_t WS_MISC = 15 * MiB;
constexpr size_t WS_XB = 20 * MiB;
constexpr size_t WS_BIG = 84 * MiB;
constexpr size_t WS_Q = WS_BIG;
constexpr size_t WS_KV = WS_Q + 32 * MiB;
constexpr size_t KV_STRIDE = (size_t)NTOK * 128 * 2;
constexpr size_t WS_XR = WS_KV + 48 * MiB;
constexpr size_t WS_YG = WS_XR + 32 * MiB;
constexpr size_t WS_GATE = WS_YG + 32 * MiB;
constexpr size_t WS_MIXED = WS_GATE + 4 * MiB;
constexpr size_t WS_OATT = WS_MIXED + 64 * MiB;
constexpr size_t WS_HID = WS_OATT + 64 * MiB;
constexpr size_t WS_MIX_END = WS_HID + 4 * MiB;
constexpr size_t WS_ACT = WS_BIG;
constexpr size_t WS_XG = WS_BIG + 232 * MiB;
constexpr size_t WS_FFN_END = WS_XG + 132 * MiB;
constexpr size_t WS_PROJ = WS_BIG;
constexpr size_t WS_END = WS_FFN_END;
constexpr size_t MS_KCMP = WS_MISC;
constexpr size_t MS_VCMP = MS_KCMP + 512 * 1024;
constexpr size_t MS_LRUA = MS_VCMP + 512 * 1024;
constexpr size_t MS_LRUB = MS_LRUA + 512 * 1024;
constexpr size_t MS_TOPE = MS_LRUB + 512 * 1024;
constexpr size_t MS_TOPG = MS_TOPE + 256 * 1024;
constexpr size_t MS_UCNT = MS_TOPG + 256 * 1024;
constexpr size_t MS_SLOTTOK = MS_UCNT + 16 * 1024;
constexpr size_t MS_SLOTG = MS_SLOTTOK + 272 * 1024;
constexpr size_t MS_SLOTRS = MS_SLOTG + 272 * 1024;
constexpr size_t MS_PANELE = MS_SLOTRS + 272 * 1024;
constexpr size_t MS_END = MS_PANELE + 4096;
static_assert(MS_END <= WS_XB && WS_MIX_END <= WS_END + 64 * MiB, "ws map");
constexpr size_t WS_NEED = (WS_MIX_END > WS_FFN_END ? WS_MIX_END : WS_FFN_END);

constexpr int CW_BAR = 4096;

constexpr int LDS_BYTES = 147456;
constexpr int LDS_WORK = 131072;
constexpr int LDSCTL_OFF = LDS_WORK, MISC_OFF = LDSCTL_OFF + 320;
constexpr int NWAVES = 8, NTHR = 512;

__device__ __forceinline__ float bf2f(bf16 v) { return __uint_as_float(((unsigned)v) << 16); }
__device__ __forceinline__ bf16 f2bf(float f) { unsigned u = __float_as_uint(f); return (bf16)((u + 0x7fffu + ((u >> 16) & 1u)) >> 16); }
__device__ __forceinline__ unsigned pk2(float lo, float hi) { return (unsigned)f2bf(lo) | ((unsigned)f2bf(hi) << 16); }
__device__ __forceinline__ float wave_sum(float v) {
#pragma unroll
    for (int o = 1; o < 64; o <<= 1) v += __shfl_xor(v, o);
    return v;
}
__device__ __forceinline__ float wave_max(float v) {
#pragma unroll
    for (int o = 1; o < 64; o <<= 1) v = fmaxf(v, __shfl_xor(v, o));
    return v;
}
__device__ __forceinline__ float sigmoidf_(float x) { return 1.f / (1.f + __expf(-x)); }
__device__ __forceinline__ float gelu_tanh(float x) { const float u = 0.7978845608028654f * (x + 0.044715f * x * x * x); return x * sigmoidf_(2.f * u); }
__device__ __forceinline__ float silu_(float x) { return x * sigmoidf_(x); }

#define XB_TMO      128
#define XB_XCNT(j)  (256  + 64 * (j))
#define XB_XSUB(j)  (1280 + 64 * (j))
#define XB_XGEN(j)  (2304 + 64 * (j))
#define XB_TOP      3328
#define XB_TOPGEN   3392
#define XCD_BAR_WORDS 3456
#define XB_SPIN_CAP (1u << 22)
__device__ __forceinline__ unsigned xb_ld(unsigned* p)              { return __hip_atomic_load(p, __ATOMIC_RELAXED, __HIP_MEMORY_SCOPE_AGENT); }
__device__ __forceinline__ unsigned xb_add(unsigned* p, unsigned v) { return __hip_atomic_fetch_add(p, v, __ATOMIC_RELAXED, __HIP_MEMORY_SCOPE_AGENT); }
__device__ __forceinline__ unsigned xb_xcc_id() { return (unsigned)__builtin_amdgcn_s_getreg((3 << 11) | 20) & 0xFu; }
#define XB_SPIN(cond, bar) do { unsigned _sp = 0; while (cond) { __builtin_amdgcn_s_sleep(1); \
    if ((++_sp & 255u) == 0u) { if (xb_ld(&(bar)[XB_TMO])) break; if (_sp > XB_SPIN_CAP) { atomicAdd(&(bar)[XB_TMO], 1u); break; } } } } while (0)
struct XcdBarrier { unsigned* bar; unsigned x; volatile LAS unsigned* st; };
__device__ __forceinline__ XcdBarrier xcd_barrier_post(unsigned* bar, volatile LAS unsigned* st) {
    XcdBarrier b; b.bar = bar; b.x = xb_xcc_id(); b.st = st;
    if (threadIdx.x == 0) (void)xb_add(&bar[XB_XCNT(b.x)], 1u);
    return b;
}
__device__ __forceinline__ void xcd_barrier_complete(unsigned* bar, unsigned x, unsigned& nloc, unsigned& nx) {
    const unsigned G = gridDim.x * gridDim.y * gridDim.z;
    unsigned sum, cnt, mine, sp = 0u;
    for (;;) {
        sum = 0u; cnt = 0u; mine = 0u;
#pragma unroll
        for (unsigned j = 0; j < 16; ++j) { const unsigned c = xb_ld(&bar[XB_XCNT(j)]); sum += c; cnt += (c > 0u) ? 1u : 0u; mine = (j == x) ? c : mine; }
        if (sum == G) break;
        __builtin_amdgcn_s_sleep(1);
        if ((++sp & 255u) == 0u) { if (xb_ld(&bar[XB_TMO])) break; if (sp > XB_SPIN_CAP) { atomicAdd(&bar[XB_TMO], 1u); break; } }
    }
    nloc = mine > 0u ? mine : 1u; nx = cnt > 0u ? cnt : 1u;
}
__device__ __forceinline__ void xcd_barrier(const XcdBarrier& b) {
    asm volatile("s_waitcnt vmcnt(0)" ::: "memory");
    __syncthreads();
    if (threadIdx.x == 0) {
        unsigned* bar = b.bar;
        __builtin_amdgcn_s_waitcnt(0);
        unsigned nloc = b.st[0], nx = b.st[1];
        if (nloc == 0u) { xcd_barrier_complete(bar, b.x, nloc, nx); b.st[0] = nloc; b.st[1] = nx; }
        const unsigned old = xb_add(&bar[XB_XSUB(b.x)], 1u);
        const unsigned gen = old / nloc;
        if (old + 1u == (gen + 1u) * nloc) {
            __builtin_amdgcn_fence(__ATOMIC_RELEASE, "agent");
            asm volatile("s_waitcnt vmcnt(0)" ::: "memory");
            const unsigned og = xb_add(&bar[XB_TOP], 1u);
            const unsigned tg = og / nx;
            if (og + 1u == (tg + 1u) * nx) xb_add(&bar[XB_TOPGEN], 1u);
            else XB_SPIN(xb_ld(&bar[XB_TOPGEN]) == tg, bar);
            __builtin_amdgcn_fence(__ATOMIC_ACQUIRE, "agent");
            xb_add(&bar[XB_XGEN(b.x)], 1u);
            asm volatile("s_waitcnt vmcnt(0)" ::: "memory");
        } else {
            XB_SPIN(xb_ld(&bar[XB_XGEN(b.x)]) == gen, bar);
            __builtin_amdgcn_fence(__ATOMIC_ACQUIRE, "agent");
            asm volatile("s_waitcnt vmcnt(0)" ::: "memory");
        }
    }
    __syncthreads();
}

enum { I_X = 0, I_P, I_ATTN_NORM, I_W_IN, I_CMP_POS, I_CMP_W1, I_CMP_W2, I_CONV_W, I_CONV_B, I_LRU_WA, I_LRU_BA, I_LRU_WX, I_LRU_BX, I_LRU_LAMBDA,
       I_OUT_NORM_ATTN, I_OUT_NORM_REC, I_W_OUT, I_FFN_NORM, I_DENSE_WG, I_DENSE_WU, I_DENSE_WD, I_ROUTER_W, I_MOE_WG, I_MOE_WU, I_MOE_WD,
       I_PLE_NORM, I_PLE_WG, I_PLE_WP, I_FINAL_NORM, N_IN };
struct Args { const float* in[N_IN]; float* out; unsigned char* ws; int ph_lo, ph_hi, li, pad; };

typedef const __attribute__((address_space(4))) Args* KArgs;
__device__ __forceinline__ KArgs kargs() { KArgs p = (KArgs)__builtin_amdgcn_kernarg_segment_ptr(); asm volatile("" : "+s"(p)); return p; }
struct Ctx {
    LAS float* lds; int tid, lane, wave, bid, nblk;
    float* X; bf16* XB; float* SSP;
};
__device__ __forceinline__ Ctx fresh(const Ctx& c) {
    Ctx f = c;
    asm volatile("" : "+v"(f.tid), "+v"(f.lane));
    asm volatile("" : "+s"(f.wave), "+s"(f.bid), "+s"(f.nblk));
    asm volatile("" : "+s"(f.X), "+s"(f.XB), "+s"(f.SSP));
    return f;
}
#define CA_IN(i) (ka->in[i])
#define CA_WS (ka->ws)

__device__ __forceinline__ float row_rs(const float* SSP, int stage, int row) {
    const f32x4* p = (const f32x4*)(SSP + ((size_t)stage * NTOK + row) * 16);
    f32x4 a = p[0], b = p[1], c = p[2], d = p[3];
    float s = ((a.x + a.y) + (a.z + a.w)) + ((b.x + b.y) + (b.z + b.w)) + ((c.x + c.y) + (c.z + c.w)) + ((d.x + d.y) + (d.z + d.w));
    return rsqrtf(s * (1.f / D_) + RMS_EPS);
}

template <int NB, class AF, class BF, class EF>
__device__ __forceinline__ void gemm_naive(Ctx c, int M, int N, int K, AF a_at, BF b_at, EF epi) {
    LAS float* As = c.lds; LAS float* Bs = c.lds + 16 * 132;
    int tid = c.tid; asm volatile("" : "+v"(tid));
    const int ntm = (M + 127) / 128, ntn = (N + 127) / 128, tx = tid & 31, ty = tid >> 5;
    for (int tile = c.bid; tile < ntm * ntn; tile += c.nblk) {
        const int tm = tile / ntn, tn = tile % ntn, r0 = tm * 128, c0 = tn * 128;
        float acc[NB][8][4];
#pragma unroll
        for (int b = 0; b < NB; ++b)
#pragma unroll
            for (int i = 0; i < 8; ++i)
#pragma unroll
                for (int j = 0; j < 4; ++j) acc[b][i][j] = 0.f;
#pragma unroll 1
        for (int k0 = 0; k0 < K; k0 += 16) {
#pragma unroll
            for (int i = 0; i < 4; ++i) { const int e = tid + i * 512, r = e >> 4, kk = e & 15; As[kk * 132 + r] = (r0 + r < M) ? a_at(r0 + r, k0 + kk) : 0.f; }
#pragma unroll
            for (int b = 0; b < NB; ++b)
#pragma unroll
                for (int i = 0; i < 4; ++i) { const int e = tid + i * 512, kk = e >> 7, cc = e & 127; Bs[(b * 16 + kk) * 132 + cc] = (c0 + cc < N) ? b_at(b, k0 + kk, c0 + cc, r0) : 0.f; }
            __syncthreads();
#pragma unroll 2
            for (int kk = 0; kk < 16; ++kk) {
                float av[8], bv[NB][4];
#pragma unroll
                for (int i = 0; i < 8; ++i) av[i] = As[kk * 132 + ty * 8 + i];
#pragma unroll
                for (int b = 0; b < NB; ++b)
#pragma unroll
                    for (int j = 0; j < 4; ++j) bv[b][j] = Bs[(b * 16 + kk) * 132 + tx * 4 + j];
#pragma unroll
                for (int b = 0; b < NB; ++b)
#pragma unroll
                    for (int i = 0; i < 8; ++i)
#pragma unroll
                        for (int j = 0; j < 4; ++j) acc[b][i][j] = fmaf(av[i], bv[b][j], acc[b][i][j]);
            }
            __syncthreads();
        }
#pragma unroll
        for (int i = 0; i < 8; ++i)
#pragma unroll
            for (int j = 0; j < 4; ++j) { const int r = r0 + ty * 8 + i, cc = c0 + tx * 4 + j; if (r < M && cc < N) { float v[NB];
#pragma unroll
                for (int b = 0; b < NB; ++b) v[b] = acc[b][i][j];
                epi(r, cc, v); } }
    }
}

__device__ __forceinline__ void phase_fix(Ctx c, const float* src, int stage) {
    const int gw = c.bid * NWAVES + c.wave, NGW = c.nblk * NWAVES;
    for (int m = gw; m < NTOK; m += NGW) {
        const f32x4* xr = (const f32x4*)(src + (size_t)m * D_) + c.lane;
        f32x4 v[4]; float s = 0.f;
#pragma unroll
        for (int j = 0; j < 4; ++j) { v[j] = xr[64 * j]; s += (v[j].x * v[j].x + v[j].y * v[j].y) + (v[j].z * v[j].z + v[j].w * v[j].w); }
        s = wave_sum(s);
        if (src != c.X) { f32x4* xo = (f32x4*)(c.X + (size_t)m * D_) + c.lane;
#pragma unroll
            for (int j = 0; j < 4; ++j) xo[64 * j] = v[j]; }
        u32x2* o8 = (u32x2*)(c.XB + (size_t)m * D_) + c.lane;
#pragma unroll
        for (int j = 0; j < 4; ++j) { u32x2 w; w.x = pk2(v[j].x, v[j].y); w.y = pk2(v[j].z, v[j].w); o8[64 * j] = w; }
        if (c.lane < 16) c.SSP[((size_t)stage * NTOK + m) * 16 + c.lane] = (c.lane == 0) ? s : 0.f;
    }
}
__device__ __forceinline__ void phase_final(Ctx c, int stage) {
    KArgs ka = kargs();
    const float* gn = CA_IN(I_FINAL_NORM);
    const int gw = c.bid * NWAVES + c.wave, NGW = c.nblk * NWAVES;
    for (int m = gw; m < NTOK; m += NGW) {
        f32x4* xr = (f32x4*)(c.X + (size_t)m * D_) + c.lane;
        const float rs = row_rs(c.SSP, stage, m);
#pragma unroll
        for (int j = 0; j < 4; ++j) { f32x4 v = xr[64 * j]; const f32x4 g = ((const f32x4*)gn)[64 * j + c.lane]; v.x *= rs * g.x; v.y *= rs * g.y; v.z *= rs * g.z; v.w *= rs * g.w; xr[64 * j] = v; }
    }
}

__device__ __forceinline__ void phase_inproj_naive(Ctx c, int L, int stage) {
    KArgs ka = kargs();
    const float* W = CA_IN(I_W_IN) + (size_t)L * D_ * IN_COLS; const float* gn = CA_IN(I_ATTN_NORM) + L * D_;
    const bf16* XB = c.XB; const float* SSP = c.SSP; unsigned char* ws = CA_WS;
    bf16* Q = (bf16*)(ws + WS_Q); bf16* XR = (bf16*)(ws + WS_XR); bf16* YG = (bf16*)(ws + WS_YG); float* GATE = (float*)(ws + WS_GATE);
    gemm_naive<1>(c, NTOK, IN_COLS, D_,
        [=](int r, int k) { return bf2f(XB[(size_t)r * D_ + k]); },
        [=](int, int k, int n, int) { return gn[k] * W[(size_t)k * IN_COLS + n]; },
        [=](int r, int n, const float* v) {
            const float val = v[0] * row_rs(SSP, stage, r);
            if (n < C_KC) Q[(size_t)r * 512 + n] = f2bf(val * QSCALE);
            else if (n < C_G) { const int j = (n - C_KC) >> 7, cc = (n - C_KC) & 127, g = cc >> 6, d = cc & 63, b = r / T_, t = r % T_;
                ((bf16*)(ws + WS_KV + j * KV_STRIDE))[(((size_t)b * NG + g) * T_ + t) * 64 + d] = f2bf(val); }
            else if (n < C_XR) GATE[(size_t)r * 24 + (n - C_G)] = sigmoidf_(val);
            else if (n < C_YG) XR[(size_t)r * 512 + (n - C_XR)] = f2bf(val);
            else YG[(size_t)r * 512 + (n - C_YG)] = f2bf(val);
        });
}

__device__ __forceinline__ void phase_cmp1_naive(Ctx c, int L) {
    KArgs ka = kargs();
    unsigned char* ws = CA_WS; float* HID = (float*)(ws + WS_HID);
    for (int kv = 0; kv < 2; ++kv) {
        const bf16* RAW = (const bf16*)(ws + WS_KV + kv * KV_STRIDE);
        const float* W1 = CA_IN(I_CMP_W1) + ((size_t)L * 2 + kv) * (L_CMP * HD) * CMP_HID;
        const float* POS = CA_IN(I_CMP_POS) + ((size_t)L * 2 + kv) * (L_CMP * HD);
        float* H = HID + (size_t)kv * 4096 * CMP_HID;
        gemm_naive<1>(c, NB_ * NG * N_CMP, CMP_HID, L_CMP * HD,
            [=](int r, int k) { const int bg = r / N_CMP, cc = r % N_CMP; return bf2f(RAW[((size_t)bg * T_ + 16 * cc) * 64 + k]) + POS[k]; },
            [=](int, int k, int n, int) { return W1[(size_t)k * CMP_HID + n]; },
            [=](int r, int n, const float* v) { H[(size_t)r * CMP_HID + n] = gelu_tanh(v[0]); });
    }
}
__device__ __forceinline__ void phase_cmp2_naive(Ctx c, int L) {
    KArgs ka = kargs();
    unsigned char* ws = CA_WS; const float* HID = (const float*)(ws + WS_HID);
    for (int kv = 0; kv < 2; ++kv) {
        const float* W2 = CA_IN(I_CMP_W2) + ((size_t)L * 2 + kv) * CMP_HID * HD;
        const float* H = HID + (size_t)kv * 4096 * CMP_HID;
        bf16* O = (bf16*)(ws + (kv ? MS_VCMP : MS_KCMP));
        gemm_naive<1>(c, NB_ * NG * N_CMP, HD, CMP_HID,
            [=](int r, int k) { return H[(size_t)r * CMP_HID + k]; },
            [=](int, int k, int n, int) { return W2[(size_t)k * HD + n]; },
            [=](int r, int n, const float* v) { const int bg = r / N_CMP, cc = r % N_CMP; O[((size_t)bg * 512 + cc) * 64 + n] = f2bf(v[0]); });
        for (int i = c.bid * NTHR + c.tid; i < NB_ * NG * 64; i += c.nblk * NTHR) O[((size_t)(i >> 6) * 512 + 511) * 64 + (i & 63)] = 0;
    }
}

template <bool FINAL>
__device__ __forceinline__ void phase_lru(Ctx c, int L) {
    KArgs ka = kargs();
    unsigned char* ws = CA_WS;
    const bf16* XR = (const bf16*)(ws + WS_XR); const bf16* YG = (const bf16*)(ws + WS_YG); bf16* MIXED = (bf16*)(ws + WS_MIXED);
    float* SA = (float*)(ws + MS_LRUA); float* SB = (float*)(ws + MS_LRUB);
    const float* conv_w = CA_IN(I_CONV_W) + L * 4 * D_REC; const float* conv_b = CA_IN(I_CONV_B) + L * D_REC;
    const float* wa = CA_IN(I_LRU_WA) + (size_t)L * 8 * 64 * 64; const float* wx = CA_IN(I_LRU_WX) + (size_t)L * 8 * 64 * 64;
    const float* ba = CA_IN(I_LRU_BA) + L * D_REC; const float* bx = CA_IN(I_LRU_BX) + L * D_REC; const float* lam = CA_IN(I_LRU_LAMBDA) + L * D_REC;
    const int ch = c.tid, blk = ch >> 6, d = ch & 63;
    LAS float* xcs = c.lds;
    LAS float* red = c.lds + 8 * 512;
    const float cw0 = conv_w[0 * D_REC + ch], cw1 = conv_w[1 * D_REC + ch], cw2 = conv_w[2 * D_REC + ch], cw3 = conv_w[3 * D_REC + ch], cb = conv_b[ch];
    const float b_a = ba[ch], b_x = bx[ch];
    const float lmb = lam[ch]; const float sp = (lmb > 0.f) ? log1pf(__expf(-lmb)) : (-lmb + log1pf(__expf(lmb)));
    const float* wap = wa + (size_t)blk * 4096 + d; const float* wxp = wx + (size_t)blk * 4096 + d;
    for (int u = c.bid; u < NB_ * LRU_NCH; u += c.nblk) {
        const int b = u / LRU_NCH, cki = u % LRU_NCH, t0 = cki * LRU_CHUNK;
        float h = 0.f, Aprod = 1.f;
        if (FINAL) { for (int j = 0; j < cki; ++j) { const float aj = SA[((size_t)b * LRU_NCH + j) * D_REC + ch], bj = SB[((size_t)b * LRU_NCH + j) * D_REC + ch]; h = aj * h + bj; } }
        const bf16* xrp = XR + ((size_t)b * T_) * D_REC + ch;
        float x1 = (t0 >= 1) ? bf2f(xrp[(size_t)(t0 - 1) * D_REC]) : 0.f, x2 = (t0 >= 2) ? bf2f(xrp[(size_t)(t0 - 2) * D_REC]) : 0.f, x3 = (t0 >= 3) ? bf2f(xrp[(size_t)(t0 - 3) * D_REC]) : 0.f;
        for (int s = 0; s < LRU_CHUNK; s += 8) {
            float xc[8];
#pragma unroll
            for (int i = 0; i < 8; ++i) { const float x0 = bf2f(xrp[(size_t)(t0 + s + i) * D_REC]); xc[i] = cw0 * x3 + cw1 * x2 + cw2 * x1 + cw3 * x0 + cb; x3 = x2; x2 = x1; x1 = x0; xcs[i * 512 + ch] = xc[i]; }
            __syncthreads();
            float ra[8], ri[8];
#pragma unroll
            for (int i = 0; i < 8; ++i) { ra[i] = b_a; ri[i] = b_x; }
            for (int k = 0; k < 64; ++k) { const float w1 = wap[k * 64], w2 = wxp[k * 64];
#pragma unroll
                for (int i = 0; i < 8; ++i) { const float xv = xcs[i * 512 + blk * 64 + k]; ra[i] = fmaf(xv, w1, ra[i]); ri[i] = fmaf(xv, w2, ri[i]); } }
            float o[8];
#pragma unroll
            for (int i = 0; i < 8; ++i) { const float r = sigmoidf_(ra[i]), ig = sigmoidf_(ri[i]); const float la = -8.f * r * sp; const float a = __expf(la); const float bb = sqrtf(fmaxf(-expm1f(2.f * la), 0.f)) * ig * xc[i];
                h = a * h + bb; Aprod *= a; o[i] = h; }
            if (FINAL) {
#pragma unroll
                for (int i = 0; i < 8; ++i) { const float y = bf2f(YG[((size_t)b * T_ + t0 + s + i) * D_REC + ch]); o[i] *= gelu_tanh(y); const float q = wave_sum(o[i] * o[i]); if (c.lane == 0) red[i * 8 + c.wave] = q; }
                __syncthreads();
#pragma unroll
                for (int i = 0; i < 8; ++i) { float q = 0.f;
#pragma unroll
                    for (int w = 0; w < 8; ++w) q += red[i * 8 + w];
                    const float rs = rsqrtf(q * (1.f / D_REC) + RMS_EPS); MIXED[((size_t)b * T_ + t0 + s + i) * D_ + 512 + ch] = f2bf(o[i] * rs); }
            }
            __syncthreads();
        }
        if (!FINAL) { SA[((size_t)b * LRU_NCH + cki) * D_REC + ch] = Aprod; SB[((size_t)b * LRU_NCH + cki) * D_REC + ch] = h; }
    }
}

__device__ __forceinline__ float dot64_lds_bf16(const LAS float* q, const bf16* krow) {
    float s = 0.f;
#pragma unroll
    for (int j = 0; j < 8; ++j) { const u32x4 w = *(const u32x4*)(krow + 8 * j); const f32x4 qa = *(const LAS f32x4*)(q + 8 * j), qb = *(const LAS f32x4*)(q + 8 * j + 4);
        s = fmaf(qa.x, __uint_as_float(w.x << 16), s); s = fmaf(qa.y, __uint_as_float(w.x & 0xffff0000u), s);
        s = fmaf(qa.z, __uint_as_float(w.y << 16), s); s = fmaf(qa.w, __uint_as_float(w.y & 0xffff0000u), s);
        s = fmaf(qb.x, __uint_as_float(w.z << 16), s); s = fmaf(qb.y, __uint_as_float(w.z & 0xffff0000u), s);
        s = fmaf(qb.z, __uint_as_float(w.w << 16), s); s = fmaf(qb.w, __uint_as_float(w.w & 0xffff0000u), s); }
    return s;
}
__device__ __forceinline__ void phase_attn_naive(Ctx c) {
    KArgs ka = kargs();
    unsigned char* ws = CA_WS;
    const bf16* Q = (const bf16*)(ws + WS_Q); const float* GATE = (const float*)(ws + WS_GATE); float* OATT = (float*)(ws + WS_OATT);
    const bf16* KCMP = (const bf16*)(ws + MS_KCMP); const bf16* VCMP = (const bf16*)(ws + MS_VCMP);
    const bf16* KS = (const bf16*)(ws + WS_KV + 2 * KV_STRIDE); const bf16* VS = (const bf16*)(ws + WS_KV + 3 * KV_STRIDE);
    const bf16* KW = (const bf16*)(ws + WS_KV + 4 * KV_STRIDE); const bf16* VW = (const bf16*)(ws + WS_KV + 5 * KV_STRIDE);
    LAS float* wl = c.lds + c.wave * 3072;
    LAS float* ql = wl; LAS float* sc = wl + 256; LAS float* pg = wl + 256 + 2048; LAS int* sel = (LAS int*)(wl + 256 + 2048 + 512);
    const int lane = c.lane;
    const int gw = c.bid * NWAVES + c.wave, NGW = c.nblk * NWAVES;
    for (int task = gw; task < NTOK * NG; task += NGW) {
        const int g = task % NG, row = task / NG, b = row / T_, t = row % T_;
        const size_t bg = (size_t)b * NG + g;
#pragma unroll
        for (int i = 0; i < 4; ++i) ql[i * 64 + lane] = bf2f(Q[(size_t)row * 512 + (g * 4 + i) * 64 + lane]);
        const int ncmp = (t >= 31) ? ((t - 31) / 16 + 1) : 0;
        const bf16* kc = KCMP + bg * 512 * 64; const bf16* vc = VCMP + bg * 512 * 64;
        float mx[4] = {-INFINITY, -INFINITY, -INFINITY, -INFINITY};
        for (int cc = lane; cc < ncmp; cc += 64) {
            const float dist = (float)(t - (16 * cc + 31));
#pragma unroll
            for (int i = 0; i < 4; ++i) { const float slope = exp2f(-(float)(g * 4 + i + 1)) * LOG2E; const float s = dot64_lds_bf16(ql + i * 64, kc + (size_t)cc * 64) - slope * dist; sc[i * 512 + cc] = s; mx[i] = fmaxf(mx[i], s); }
        }
        float ls[4];
#pragma unroll
        for (int i = 0; i < 4; ++i) { mx[i] = wave_max(mx[i]); ls[i] = 0.f; }
        for (int cc = lane; cc < ncmp; cc += 64) {
#pragma unroll
            for (int i = 0; i < 4; ++i) { const float e = exp2f(sc[i * 512 + cc] - mx[i]); sc[i * 512 + cc] = e; ls[i] += e; }
        }
#pragma unroll
        for (int i = 0; i < 4; ++i) { ls[i] = wave_sum(ls[i]); ls[i] = 1.f / fmaxf(ls[i], 1e-30f); }
        for (int cc = lane; cc < 512; cc += 64) {
            float sgrp = 0.f;
            if (cc < ncmp) {
#pragma unroll
                for (int i = 0; i < 4; ++i) { const float p = sc[i * 512 + cc] * ls[i]; sc[i * 512 + cc] = p; sgrp += p; } }
            pg[cc] = sgrp;
        }
        float oc[4] = {0.f, 0.f, 0.f, 0.f};
        for (int cc = 0; cc < ncmp; ++cc) { const float v = bf2f(vc[(size_t)cc * 64 + lane]);
#pragma unroll
            for (int i = 0; i < 4; ++i) oc[i] = fmaf(sc[i * 512 + cc], v, oc[i]); }
        const int cur = t >> 6;
        float v0, v1;
        {
            const int n0 = lane, n1 = lane + 64;
            auto pslc = [&](int n) { const float a = (4 * n - 1 >= 0) ? pg[4 * n - 1] : 0.f; return a + 2.f * (pg[4 * n] + pg[4 * n + 1] + pg[4 * n + 2]) + pg[4 * n + 3]; };
            auto scr = [&](int n) { const bool valid = n <= cur; const bool forced = valid && (n == 0 || n > cur - 2); return forced ? INFINITY : (valid ? pslc(n) : -INFINITY); };
            v0 = scr(n0); v1 = scr(n1);
        }
        bool tk0 = false, tk1 = false;
        for (int k = 0; k < N_SEL; ++k) {
            float bv; int bi;
            if (!tk0 && (tk1 || v0 >= v1)) { bv = v0; bi = lane; } else if (!tk1) { bv = v1; bi = lane + 64; } else { bv = -INFINITY; bi = 1 << 20; }
            if (tk0 && tk1) { bv = -INFINITY; bi = 1 << 20; }
#pragma unroll
            for (int o = 1; o < 64; o <<= 1) { const float ov = __shfl_xor(bv, o); const int oi = __shfl_xor(bi, o); if (oi < (1 << 20) && (bi >= (1 << 20) || ov > bv || (ov == bv && oi < bi))) { bv = ov; bi = oi; } }
            if (bi == lane) tk0 = true; if (bi == lane + 64) tk1 = true;
            if (lane == 0) sel[k] = bi;
        }
        const bf16* ks = KS + bg * T_ * 64; const bf16* vs = VS + bg * T_ * 64; const bf16* kw = KW + bg * T_ * 64; const bf16* vw = VW + bg * T_ * 64;
        for (int i = 0; i < 4; ++i) {
            const int h = g * 4 + i; const float slope = exp2f(-(float)(h + 1)) * LOG2E; const LAS float* qh = ql + i * 64;
            float m = -INFINITY;
            for (int k = 0; k < N_SEL; ++k) { const int sb = sel[k]; float s = -INFINITY;
                if (sb <= cur) { const int pos = sb * 64 + lane; if (pos <= t) s = dot64_lds_bf16(qh, ks + (size_t)pos * 64) - slope * (float)(t - pos); }
                sc[k * 64 + lane] = s; m = fmaxf(m, s); }
            m = wave_max(m); float l = 0.f;
            for (int k = 0; k < N_SEL; ++k) { const float s = sc[k * 64 + lane]; const float e = (s == -INFINITY) ? 0.f : exp2f(s - m); sc[k * 64 + lane] = e; l += e; }
            l = wave_sum(l); const float il = 1.f / fmaxf(l, 1e-30f);
            float os = 0.f;
            for (int k = 0; k < N_SEL; ++k) { const int sb = sel[k]; if (sb > cur) continue; const int p0 = sb * 64; const int nk = min(64, t - p0 + 1);
                for (int j = 0; j < nk; ++j) os = fmaf(sc[k * 64 + j], bf2f(vs[(size_t)(p0 + j) * 64 + lane]), os); }
            os *= il;
            m = -INFINITY;
#pragma unroll
            for (int j = 0; j < 8; ++j) { const int idx = lane + 64 * j, pos = t - 511 + idx; float s = -INFINITY; if (pos >= 0) s = dot64_lds_bf16(qh, kw + (size_t)pos * 64) - slope * (float)(t - pos); sc[idx] = s; m = fmaxf(m, s); }
            m = wave_max(m); l = 0.f;
#pragma unroll
            for (int j = 0; j < 8; ++j) { const int idx = lane + 64 * j; const float s = sc[idx]; const float e = (s == -INFINITY) ? 0.f : exp2f(s - m); sc[idx] = e; l += e; }
            l = wave_sum(l); const float ilw = 1.f / fmaxf(l, 1e-30f);
            float ow = 0.f;
            { const int j0 = max(0, 511 - t); for (int j = j0; j < 512; ++j) ow = fmaf(sc[j], bf2f(vw[(size_t)(t - 511 + j) * 64 + lane]), ow); }
            ow *= ilw;
            const float* gt = GATE + (size_t)row * 24 + h * 3;
            OATT[(size_t)row * 512 + h * 64 + lane] = gt[0] * oc[i] + gt[1] * os + gt[2] * ow;
        }
    }
}
__device__ __forceinline__ void phase_attn_norm(Ctx c) {
    KArgs ka = kargs();
    unsigned char* ws = CA_WS; const float* OATT = (const float*)(ws + WS_OATT); bf16* MIXED = (bf16*)(ws + WS_MIXED);
    const int gw = c.bid * NWAVES + c.wave, NGW = c.nblk * NWAVES;
    for (int m = gw; m < NTOK; m += NGW) {
        const f32x4* xr = (const f32x4*)(OATT + (size_t)m * 512) + c.lane;
        f32x4 v[2]; float s = 0.f;
#pragma unroll
        for (int j = 0; j < 2; ++j) { v[j] = xr[64 * j]; s += (v[j].x * v[j].x + v[j].y * v[j].y) + (v[j].z * v[j].z + v[j].w * v[j].w); }
        const float rs = rsqrtf(wave_sum(s) * (1.f / 512.f) + RMS_EPS);
        u32x2* o8 = (u32x2*)(MIXED + (size_t)m * D_) + c.lane;
#pragma unroll
        for (int j = 0; j < 2; ++j) { u32x2 w; w.x = pk2(v[j].x * rs, v[j].y * rs); w.y = pk2(v[j].z * rs, v[j].w * rs); o8[64 * j] = w; }
    }
}

__device__ __forceinline__ void phase_outproj_naive(Ctx c, int L) {
    KArgs ka = kargs();
    const float* W = CA_IN(I_W_OUT) + (size_t)L * D_ * D_; const float* ga = CA_IN(I_OUT_NORM_ATTN) + L * 512; const float* gr = CA_IN(I_OUT_NORM_REC) + L * 512;
    const bf16* MIXED = (const bf16*)(CA_WS + WS_MIXED); float* X = c.X;
    gemm_naive<1>(c, NTOK, D_, D_,
        [=](int r, int k) { return bf2f(MIXED[(size_t)r * D_ + k]); },
        [=](int, int k, int n, int) { return (k < 512 ? ga[k] : gr[k - 512]) * W[(size_t)k * D_ + n]; },
        [=](int r, int n, const float* v) { X[(size_t)r * D_ + n] += v[0]; });
}
__device__ __forceinline__ void phase_ffn_gu_naive(Ctx c, int stage) {
    KArgs ka = kargs();
    const float* WG = CA_IN(I_DENSE_WG); const float* WU = CA_IN(I_DENSE_WU); const float* gn = CA_IN(I_FFN_NORM);
    const bf16* XB = c.XB; const float* SSP = c.SSP; bf16* ACT = (bf16*)(CA_WS + WS_ACT);
    gemm_naive<2>(c, NTOK, D_FF, D_,
        [=](int r, int k) { return bf2f(XB[(size_t)r * D_ + k]); },
        [=](int b, int k, int n, int) { return gn[k] * (b ? WU : WG)[(size_t)k * D_FF + n]; },
        [=](int r, int n, const float* v) { const float rs = row_rs(SSP, stage, r); ACT[(size_t)r * D_FF + n] = f2bf(silu_(v[0] * rs) * (v[1] * rs)); });
}
__device__ __forceinline__ void phase_ffn_dn_naive(Ctx c) {
    KArgs ka = kargs();
    const float* WD = CA_IN(I_DENSE_WD); const bf16* ACT = (const bf16*)(CA_WS + WS_ACT); float* X = c.X;
    gemm_naive<1>(c, NTOK, D_, D_FF,
        [=](int r, int k) { return bf2f(ACT[(size_t)r * D_FF + k]); },
        [=](int, int k, int n, int) { return WD[(size_t)k * D_ + n]; },
        [=](int r, int n, const float* v) { X[(size_t)r * D_ + n] += v[0]; });
}
__device__ __forceinline__ void phase_ple_proj_naive(Ctx c, int L) {
    KArgs ka = kargs();
    const float* P = CA_IN(I_P) + (size_t)L * NTOK * PLE_DIM; const float* WP = CA_IN(I_PLE_WP) + (size_t)L * PLE_DIM * D_; bf16* PROJ = (bf16*)(CA_WS + WS_PROJ);
    gemm_naive<1>(c, NTOK, D_, PLE_DIM,
        [=](int r, int k) { return P[(size_t)r * PLE_DIM + k]; },
        [=](int, int k, int n, int) { return WP[(size_t)k * D_ + n]; },
        [=](int r, int n, const float* v) { PROJ[(size_t)r * D_ + n] = f2bf(v[0]); });
}
__device__ __forceinline__ void phase_ple_naive(Ctx c, int L, int stage) {
    KArgs ka = kargs();
    const float* WG = CA_IN(I_PLE_WG) + (size_t)L * D_ * D_; const float* gn = CA_IN(I_PLE_NORM) + L * D_;
    const bf16* XB = c.XB; const float* SSP = c.SSP; const bf16* PROJ = (const bf16*)(CA_WS + WS_PROJ); float* X = c.X;
    gemm_naive<1>(c, NTOK, D_, D_,
        [=](int r, int k) { return bf2f(XB[(size_t)r * D_ + k]); },
        [=](int, int k, int n, int) { return gn[k] * WG[(size_t)k * D_ + n]; },
        [=](int r, int n, const float* v) { X[(size_t)r * D_ + n] += sigmoidf_(v[0] * row_rs(SSP, stage, r)) * bf2f(PROJ[(size_t)r * D_ + n]); });
}

__device__ __forceinline__ void phase_moe_route(Ctx c, int stage) {
    KArgs ka = kargs();
    unsigned char* ws = CA_WS; int* TOPE = (int*)(ws + MS_TOPE); float* TOPG = (float*)(ws + MS_TOPG); int* UCNT = (int*)(ws + MS_UCNT);
    const float* RW = CA_IN(I_ROUTER_W); const float* gn = CA_IN(I_FFN_NORM) + 1 * D_;
    LAS int* cnt = (LAS int*)c.lds;
    for (int u = c.bid; u < 256; u += c.nblk) {
        if (c.tid < 8) cnt[c.tid] = 0;
        __syncthreads();
        for (int i = 0; i < 16; ++i) {
            const int m = u * 128 + c.wave * 16 + i;
            const float rs = row_rs(c.SSP, stage, m);
            float lg[8] = {0, 0, 0, 0, 0, 0, 0, 0};
            for (int j = 0; j < 16; ++j) { const int k = c.lane + 64 * j; const float hv = c.X[(size_t)m * D_ + k] * rs * gn[k]; const f32x4 w0 = *(const f32x4*)(RW + (size_t)k * 8), w1 = *(const f32x4*)(RW + (size_t)k * 8 + 4);
                lg[0] = fmaf(hv, w0.x, lg[0]); lg[1] = fmaf(hv, w0.y, lg[1]); lg[2] = fmaf(hv, w0.z, lg[2]); lg[3] = fmaf(hv, w0.w, lg[3]);
                lg[4] = fmaf(hv, w1.x, lg[4]); lg[5] = fmaf(hv, w1.y, lg[5]); lg[6] = fmaf(hv, w1.z, lg[6]); lg[7] = fmaf(hv, w1.w, lg[7]); }
#pragma unroll
            for (int e = 0; e < 8; ++e) lg[e] = wave_sum(lg[e]);
            int e0 = 0; float l0 = lg[0];
#pragma unroll
            for (int e = 1; e < 8; ++e) if (lg[e] > l0) { l0 = lg[e]; e0 = e; }
            int e1 = -1; float l1 = -INFINITY;
#pragma unroll
            for (int e = 0; e < 8; ++e) if (e != e0 && lg[e] > l1) { l1 = lg[e]; e1 = e; }
            const float z = __expf(l1 - l0), g0 = 1.f / (1.f + z), g1 = z / (1.f + z);
            if (c.lane == 0) { TOPE[m * 2] = e0; TOPE[m * 2 + 1] = e1; TOPG[m * 2] = g0; TOPG[m * 2 + 1] = g1; __hip_atomic_fetch_add(&cnt[e0], 1, __ATOMIC_RELAXED, __HIP_MEMORY_SCOPE_WORKGROUP); __hip_atomic_fetch_add(&cnt[e1], 1, __ATOMIC_RELAXED, __HIP_MEMORY_SCOPE_WORKGROUP); }
        }
        __syncthreads();
        if (c.tid < 8) UCNT[u * 8 + c.tid] = cnt[c.tid];
        __syncthreads();
    }
}
__device__ __forceinline__ void phase_moe_slots(Ctx c, int stage) {
    KArgs ka = kargs();
    unsigned char* ws = CA_WS; const int* TOPE = (const int*)(ws + MS_TOPE); const float* TOPG = (const float*)(ws + MS_TOPG); const int* UCNT = (const int*)(ws + MS_UCNT);
    int* SLOT_TOK = (int*)(ws + MS_SLOTTOK); float* SLOT_G = (float*)(ws + MS_SLOTG); float* SLOT_RS = (float*)(ws + MS_SLOTRS); int* PANEL_E = (int*)(ws + MS_PANELE);
    bf16* XG = (bf16*)(ws + WS_XG);
    LAS int* sh = (LAS int*)c.lds;
    if (c.tid < 8) { int tot = 0; for (int u = 0; u < 256; ++u) tot += UCNT[u * 8 + c.tid]; sh[c.tid] = tot; }
    __syncthreads();
    if (c.tid == 0) { int ps = 0; for (int e = 0; e < 8; ++e) { sh[8 + e] = ps; ps += (sh[e] + 255) / 256 * 256; } sh[24] = ps; }
    __syncthreads();
    for (int s = c.bid * NTHR + c.tid; s < NSLOT; s += c.nblk * NTHR) {
        int e = 7; for (int k = 0; k < 8; ++k) { if (s >= sh[8 + k] && s < sh[8 + k] + (sh[k] + 255) / 256 * 256) { e = k; break; } }
        const bool used = s < sh[24];
        const bool real = used && (s - sh[8 + e]) < sh[e];
        if (!real) { SLOT_TOK[s] = -1; SLOT_G[s] = 0.f; SLOT_RS[s] = 0.f; }
        if ((s & 255) == 0) PANEL_E[s >> 8] = used ? e : -1;
    }
    for (int u = c.bid; u < 256; u += c.nblk) {
        __syncthreads();
        if (c.tid < 8) { int base = 0; for (int v = 0; v < u; ++v) base += UCNT[v * 8 + c.tid]; sh[16 + c.tid] = base; }
        __syncthreads();
        if (c.tid < 8) { const int e = c.tid; int r = sh[8 + e] + sh[16 + e];
            for (int i = 0; i < 256; ++i) { const int m = u * 128 + (i >> 1); if (TOPE[m * 2 + (i & 1)] == e) { sh[32 + i] = r; ++r; } } }
        __syncthreads();
        for (int i = c.wave * 32; i < c.wave * 32 + 32; ++i) {
            const int m = u * 128 + (i >> 1), k = i & 1, s = sh[32 + i];
            if (c.lane == 0) { SLOT_TOK[s] = m; SLOT_G[s] = TOPG[m * 2 + k]; SLOT_RS[s] = row_rs(c.SSP, stage, m); }
            const u32x4* src = (const u32x4*)(c.XB + (size_t)m * D_); u32x4* dst = (u32x4*)(XG + (size_t)s * D_);
            dst[c.lane] = src[c.lane]; dst[c.lane + 64] = src[c.lane + 64];
        }
    }
}
__device__ __forceinline__ void phase_moe_gu_naive(Ctx c, int half) {
    KArgs ka = kargs();
    unsigned char* ws = CA_WS; const int* SLOT_TOK = (const int*)(ws + MS_SLOTTOK); const float* SLOT_RS = (const float*)(ws + MS_SLOTRS); const int* PANEL_E = (const int*)(ws + MS_PANELE);
    const bf16* XG = (const bf16*)(ws + WS_XG); bf16* ACT = (bf16*)(ws + WS_ACT);
    const float* WG = CA_IN(I_MOE_WG); const float* WU = CA_IN(I_MOE_WU); const float* gn = CA_IN(I_FFN_NORM) + 1 * D_;
    const int coff = half * FFE_HALF;
    gemm_naive<2>(c, NSLOT, FFE_HALF, D_,
        [=](int r, int k) { return (SLOT_TOK[r] >= 0) ? bf2f(XG[(size_t)r * D_ + k]) : 0.f; },
        [=](int b, int k, int n, int r0) { int e = PANEL_E[r0 >> 8]; e = e < 0 ? 0 : e; return gn[k] * (b ? WU : WG)[((size_t)e * D_ + k) * D_FFE + coff + n]; },
        [=](int r, int n, const float* v) { const float rs = SLOT_RS[r]; ACT[(size_t)r * FFE_HALF + n] = f2bf(silu_(v[0] * rs) * (v[1] * rs)); });
}
__device__ __forceinline__ void phase_moe_dn_naive(Ctx c, int half) {
    KArgs ka = kargs();
    unsigned char* ws = CA_WS; const int* SLOT_TOK = (const int*)(ws + MS_SLOTTOK); const float* SLOT_G = (const float*)(ws + MS_SLOTG); const int* PANEL_E = (const int*)(ws + MS_PANELE);
    const bf16* ACT = (const bf16*)(ws + WS_ACT); const float* WD = CA_IN(I_MOE_WD); float* X = c.X;
    const int koff = half * FFE_HALF;
    gemm_naive<1>(c, NSLOT, D_, FFE_HALF,
        [=](int r, int k) { return (SLOT_TOK[r] >= 0) ? bf2f(ACT[(size_t)r * FFE_HALF + k]) : 0.f; },
        [=](int, int k, int n, int r0) { int e = PANEL_E[r0 >> 8]; e = e < 0 ? 0 : e; return WD[((size_t)e * D_FFE + koff + k) * D_ + n]; },
        [=](int r, int n, const float* v) { const int tok = SLOT_TOK[r]; if (tok >= 0) atomicAdd(&X[(size_t)tok * D_ + n], SLOT_G[r] * v[0]); });
}

constexpr int PL = 17, PH_FINAL = 1 + DEPTH * PL, N_PHASES = PH_FINAL + 1;
__global__ void __launch_bounds__(NTHR, 2) fwd_kernel(Args args) {
    extern __shared__ __attribute__((aligned(16))) unsigned char lds_raw[];
    Ctx c; c.lds = (LAS float*)lds_raw; c.tid = threadIdx.x; c.lane = c.tid & 63; c.wave = __builtin_amdgcn_readfirstlane(c.tid >> 6); c.bid = blockIdx.x; c.nblk = gridDim.x;
    { KArgs k0 = kargs(); c.X = k0->out; c.XB = (bf16*)(k0->ws + WS_XB); c.SSP = (float*)(k0->ws + WS_SSP); }
    volatile LAS unsigned* MISC = (volatile LAS unsigned*)((LAS unsigned char*)lds_raw + MISC_OFF);
    for (int u = c.tid; u < (LDS_BYTES - LDSCTL_OFF) / 4; u += NTHR) ((LAS unsigned*)((LAS unsigned char*)lds_raw + LDSCTL_OFF))[u] = 0u;
    __syncthreads();
    KArgs kb = kargs();
    XcdBarrier bar; bar.bar = (unsigned*)(kb->ws + WS_CTL) + CW_BAR; bar.x = 0; bar.st = nullptr;
    const int lo = kb->ph_lo, hi = kb->ph_hi;
    const bool multi = (hi - lo) > 1;
    if (multi) bar = xcd_barrier_post((unsigned*)(kb->ws + WS_CTL) + CW_BAR, MISC + 8);
#ifndef PHASE_MASK
#define PHASE_MASK 0xFFFFFFFFu
#endif
#define EN(x) (((PHASE_MASK) >> (x)) & 1u)
#define IN(k) (lo <= (k) && (k) < hi)
#define SEAM(k) do { if (IN(k) && IN((k) + 1)) xcd_barrier(bar); } while (0)
    if (EN(0) && IN(0)) { KArgs k1 = kargs(); phase_fix(fresh(c), k1->in[I_X], 0); } SEAM(0);
    for (int L = 0; L < DEPTH; ++L) {
        const int pb = 1 + L * PL, s0 = 3 * L;
        if (EN(1) && IN(pb + 0)) phase_inproj_naive(fresh(c), L, s0);
        SEAM(pb + 0);
        if (IN(pb + 1)) { if (EN(2)) phase_cmp1_naive(fresh(c), L); if (EN(16)) phase_lru<false>(fresh(c), L); }
        SEAM(pb + 1);
        if (EN(3) && IN(pb + 2)) phase_cmp2_naive(fresh(c), L);
        SEAM(pb + 2);
        if (IN(pb + 3)) { if (EN(4)) phase_attn_naive(fresh(c)); __syncthreads(); if (EN(17)) phase_lru<true>(fresh(c), L); }
        SEAM(pb + 3);
        if (EN(5) && IN(pb + 4)) phase_attn_norm(fresh(c));
        SEAM(pb + 4);
        if (EN(6) && IN(pb + 5)) phase_outproj_naive(fresh(c), L);
        SEAM(pb + 5);
        if (EN(0) && IN(pb + 6)) phase_fix(fresh(c), c.X, s0 + 1);
        SEAM(pb + 6);
        if (L == 0) {
            if (EN(7) && IN(pb + 7)) phase_ffn_gu_naive(fresh(c), s0 + 1);
            SEAM(pb + 7);
            if (EN(8) && IN(pb + 8)) phase_ffn_dn_naive(fresh(c));
            SEAM(pb + 8); SEAM(pb + 9); SEAM(pb + 10); SEAM(pb + 11); SEAM(pb + 12);
        } else {
            if (EN(9) && IN(pb + 7)) phase_moe_route(fresh(c), s0 + 1);
            SEAM(pb + 7);
            if (EN(10) && IN(pb + 8)) phase_moe_slots(fresh(c), s0 + 1);
            SEAM(pb + 8);
            if (EN(11) && IN(pb + 9)) phase_moe_gu_naive(fresh(c), 0);
            SEAM(pb + 9);
            if (EN(12) && IN(pb + 10)) phase_moe_dn_naive(fresh(c), 0);
            SEAM(pb + 10);
            if (EN(11) && IN(pb + 11)) phase_moe_gu_naive(fresh(c), 1);
            SEAM(pb + 11);
            if (EN(12) && IN(pb + 12)) phase_moe_dn_naive(fresh(c), 1);
            SEAM(pb + 12);
        }
        if (EN(0) && IN(pb + 13)) phase_fix(fresh(c), c.X, s0 + 2);
        SEAM(pb + 13);
        if (EN(13) && IN(pb + 14)) phase_ple_proj_naive(fresh(c), L);
        SEAM(pb + 14);
        if (EN(14) && IN(pb + 15)) phase_ple_naive(fresh(c), L, s0 + 2);
        SEAM(pb + 15);
        if (EN(0) && IN(pb + 16)) phase_fix(fresh(c), c.X, s0 + 3);
        SEAM(pb + 16);
    }
    if (EN(15) && IN(PH_FINAL)) phase_final(fresh(c), 3 * DEPTH);
#undef IN
#undef SEAM
}

extern "C" void kernel_launch(void* const* d_in, const int* in_sizes, int n_in, void* d_out, int out_size, void* d_ws, size_t ws_size, hipStream_t stream) {
    static int grid = 0;
    if (grid == 0) {
        if (n_in != N_IN || out_size != NTOK * D_ || ws_size < WS_NEED) { fprintf(stderr, "kernel_launch: unexpected arguments (n_in %d, out %d, ws %zu < %zu)\n", n_in, out_size, ws_size, (size_t)WS_NEED); grid = -1; return; }
        int dev = 0, cus = 0;
        if (hipGetDevice(&dev) != hipSuccess || hipDeviceGetAttribute(&cus, hipDeviceAttributeMultiprocessorCount, dev) != hipSuccess) { grid = -1; return; }
        if (hipFuncSetAttribute((const void*)fwd_kernel, hipFuncAttributeMaxDynamicSharedMemorySize, LDS_BYTES) != hipSuccess) { grid = -1; return; }
        int per_cu = 0;
        (void)hipOccupancyMaxActiveBlocksPerMultiprocessor(&per_cu, (const void*)fwd_kernel, NTHR, LDS_BYTES);
        (void)hipGetLastError();
        grid = cus;
    }
    if (grid < 0) return;
    (void)hipMemsetAsync((char*)d_ws + WS_CTL, 0, CTL_ZERO_BYTES, stream);
    Args a{};
    for (int i = 0; i < N_IN; ++i) a.in[i] = (const float*)d_in[i];
    a.out = (float*)d_out; a.ws = (unsigned char*)d_ws; a.li = 0; a.pad = 0;
#if MK_ONE_LAUNCH
    a.ph_lo = 0; a.ph_hi = N_PHASES;
    hipLaunchKernelGGL(fwd_kernel, dim3(grid), dim3(NTHR), LDS_BYTES, stream, a);
#else
    for (int p = 0; p < N_PHASES; ++p) {
        if (p >= 1 + 9 && p <= 1 + 12) continue;
        a.ph_lo = p; a.ph_hi = p + 1;
        hipLaunchKernelGGL(fwd_kernel, dim3(grid), dim3(NTHR), LDS_BYTES, stream, a);
    }
#endif
}
```

```cpp
#include <hip/hip_runtime.h>
#include <cstdio>
#include <cstdint>


#define GAS __attribute__((address_space(1)))
#define LAS __attribute__((address_space(3)))
typedef unsigned short bf16;
typedef float f32x4 __attribute__((ext_vector_type(4)));
typedef unsigned u32x4 __attribute__((ext_vector_type(4)));
typedef unsigned u32x2 __attribute__((ext_vector_type(2)));
typedef float f32x16 __attribute__((ext_vector_type(16)));
typedef short s16x8 __attribute__((ext_vector_type(8)));
typedef short s16x4 __attribute__((ext_vector_type(4)));

constexpr int NB_ = 4, T_ = 8192, D_ = 1024, NTOK = NB_ * T_;
constexpr int DEPTH = 2;
constexpr int NH = 8, HD = 64, NG = 2, HG = 4;
constexpr int D_ATTN = 512, D_REC = 512;
constexpr int L_CMP = 32, STRIDE = 16, L_SLC = 64, N_SEL = 16, W_WIN = 512;
constexpr int N_CMP = T_ / STRIDE - 1;
constexpr int N_SLC = T_ / L_SLC;
constexpr int CMP_HID = 128;
constexpr int IN_COLS = 2328;
constexpr int C_Q = 0, C_KC = 512, C_VC = 640, C_KS = 768, C_VS = 896, C_KW = 1024, C_VW = 1152, C_G = 1280, C_XR = 1304, C_YG = 1816;
constexpr int D_FF = 2816, N_EXP = 8, D_FFE = 3584;
constexpr int MOE_BLOCK = 256, N_PANEL = NTOK * 2 / MOE_BLOCK + 2 * N_EXP, NSLOT = N_PANEL * MOE_BLOCK;
constexpr int KPANEL_MAX = NTOK / MOE_BLOCK + N_EXP;
constexpr int PLE_DIM = 256;
constexpr float RMS_EPS = 1e-6f;
constexpr float LOG2E = 1.4426950408889634f;
constexpr float QSCALE = 0.125f * LOG2E;
constexpr int LRU_CHUNK = 128, LRU_NCH = T_ / LRU_CHUNK;
constexpr float W8_SCALE = 256.f, X8_SCALE = 8.f, ACT8_SCALE = 8.f;

constexpr size_t MiB = 1u << 20;
constexpr size_t WS_CTL = 0, CTL_ZERO_BYTES = 64 * 1024;
constexpr size_t WS_SSP = 1 * MiB;
constexpr size_t WS_MISC = 15 * MiB;
constexpr size_t WS_XB = 20 * MiB;
constexpr size_t WS_BIG = 84 * MiB;
constexpr size_t WS_Q = WS_BIG;
constexpr size_t WS_KV = WS_Q + 32 * MiB;
constexpr size_t KV_STRIDE = (size_t)NTOK * 128 * 2;
constexpr size_t WS_XR = WS_KV + 48 * MiB;
constexpr size_t WS_YG = WS_XR + 32 * MiB;
constexpr size_t WS_GATE = WS_YG + 32 * MiB;
constexpr size_t WS_MIXED = WS_GATE + 4 * MiB;
constexpr size_t WS_MIX_END = WS_MIXED + 64 * MiB;
constexpr size_t WS_ACT = WS_BIG;
constexpr size_t WS_PROJ = WS_BIG;
constexpr size_t MS_KCMP = WS_MISC;
constexpr size_t MS_VCMP = MS_KCMP + 512 * 1024;
constexpr size_t MS_LRUA = MS_VCMP + 512 * 1024;
constexpr size_t MS_LRUB = MS_LRUA + 512 * 1024;
constexpr size_t MS_TOPE = MS_LRUB + 512 * 1024;
constexpr size_t MS_TOPG = MS_TOPE + 256 * 1024;
constexpr size_t MS_UCNT = MS_TOPG + 256 * 1024;
constexpr size_t MS_SLOTTOK = MS_UCNT + 16 * 1024;
constexpr size_t MS_SLOTG = MS_SLOTTOK + 272 * 1024;
constexpr size_t MS_SLOTRS = MS_SLOTG + 272 * 1024;
constexpr size_t MS_PANELE = MS_SLOTRS + 272 * 1024;
constexpr size_t MS_END = MS_PANELE + 4096;
static_assert(MS_END <= WS_XB, "ws map");

constexpr size_t WS_W = 364 * MiB;
constexpr size_t WB_IN = WS_W, WB_OUT = WS_W + 10 * MiB, WB_GU = WS_W + 14 * MiB, WB_DN = WS_W + 25 * MiB, WB_PLEG = WS_W + 31 * MiB, WB_PLEP = WS_W + 35 * MiB, WB_END = WS_W + 36 * MiB;
constexpr size_t WS_PB = WB_END;
constexpr size_t WB_MGU = WS_PB + 32 * MiB;
constexpr size_t WB_MDN = WB_MGU + 112 * MiB;
constexpr size_t WS_NEED2 = WB_MDN + 56 * MiB;
constexpr size_t WS_SMALL = 324 * MiB;
constexpr size_t WB_C1T = WS_SMALL;
constexpr size_t WB_C2T = WB_C1T + 2 * MiB;
constexpr size_t WB_POSBP = WB_C2T + 64 * 1024;
constexpr size_t WB_LWA = WB_POSBP + 64 * 1024;
constexpr size_t WB_LWX = WB_LWA + 128 * 1024;
constexpr size_t WS_PART = 212 * MiB;
constexpr size_t X8_OFF = 64 * MiB;
constexpr int DN_MAIN_PANELS = 128, DN_KSPLIT = 7, DN_KSLICE = D_FFE / DN_KSPLIT, DN_KSLICE_P = DN_KSLICE / 2;
static_assert(WS_MIX_END <= WS_W, "BIG region vs weights");

constexpr int CW_BAR = 4096;

constexpr int LDS_BYTES = 161792;
constexpr int LDS_WORK = 160768;
constexpr int LDSCTL_OFF = LDS_WORK, MISC_OFF = LDSCTL_OFF + 320;
constexpr int NWAVES = 8, NTHR = 512;

__device__ __forceinline__ float bf2f(bf16 v) { return __uint_as_float(((unsigned)v) << 16); }
__device__ __forceinline__ unsigned pk2(float lo, float hi) { unsigned r; asm("v_cvt_pk_bf16_f32 %0, %1, %2" : "=v"(r) : "v"(lo), "v"(hi)); return r; }
__device__ __forceinline__ bf16 f2bf(float f) { return (bf16)pk2(f, f); }
__device__ __forceinline__ float blo(unsigned w) { return __uint_as_float(w << 16); }
__device__ __forceinline__ float bhi(unsigned w) { return __uint_as_float(w & 0xffff0000u); }
__device__ __forceinline__ float shx(float v, int o, int lane) { return __int_as_float(__builtin_amdgcn_ds_bpermute((lane ^ o) << 2, __float_as_int(v))); }
__device__ __forceinline__ int shxi(int v, int o, int lane) { return __builtin_amdgcn_ds_bpermute((lane ^ o) << 2, v); }
__device__ __forceinline__ float wave_sum(float v, int lane) {
#pragma unroll
    for (int o = 1; o < 64; o <<= 1) v += shx(v, o, lane);
    return v;
}
__device__ __forceinline__ float wave_max(float v, int lane) {
#pragma unroll
    for (int o = 1; o < 64; o <<= 1) v = fmaxf(v, shx(v, o, lane));
    return v;
}
__device__ __forceinline__ float sigmoidf_(float x) { return __builtin_amdgcn_rcpf(1.f + __expf(-x)); }
__device__ __forceinline__ float gelu_tanh(float x) { const float u = 0.7978845608028654f * (x + 0.044715f * x * x * x); return x * sigmoidf_(2.f * u); }
__device__ __forceinline__ float silu_(float x) { return x * sigmoidf_(x); }

#define XB_TMO      128
#define XB_XCNT(j)  (256  + 64 * (j))
#define XB_XSUB(j)  (1280 + 64 * (j))
#define XB_XGEN(j)  (2304 + 64 * (j))
#define XB_TOP      3328
#define XB_TOPGEN   3392
#define XCD_BAR_WORDS 3456
#define XB_SPIN_CAP (1u << 22)
__device__ __forceinline__ unsigned xb_ld(unsigned* p)              { return __hip_atomic_load(p, __ATOMIC_RELAXED, __HIP_MEMORY_SCOPE_AGENT); }
__device__ __forceinline__ unsigned xb_add(unsigned* p, unsigned v) { return __hip_atomic_fetch_add(p, v, __ATOMIC_RELAXED, __HIP_MEMORY_SCOPE_AGENT); }
__device__ __forceinline__ unsigned xb_xcc_id() { return (unsigned)__builtin_amdgcn_s_getreg((3 << 11) | 20) & 0xFu; }
#define XB_SPIN(cond, bar) do { unsigned _sp = 0; while (cond) { __builtin_amdgcn_s_sleep(1); \
    if ((++_sp & 255u) == 0u) { if (xb_ld(&(bar)[XB_TMO])) break; if (_sp > XB_SPIN_CAP) { atomicAdd(&(bar)[XB_TMO], 1u); break; } } } } while (0)
struct XcdBarrier { unsigned* bar; unsigned x; volatile LAS unsigned* st; };
__device__ __forceinline__ XcdBarrier xcd_barrier_post(unsigned* bar, volatile LAS unsigned* st, bool leader) {
    XcdBarrier b; b.bar = bar; b.x = (unsigned)__builtin_amdgcn_readfirstlane((int)xb_xcc_id()); b.st = st;
    if (leader) (void)xb_add(&bar[XB_XCNT(b.x)], 1u);
    return b;
}
__device__ __forceinline__ void xcd_barrier_complete(unsigned* bar, unsigned x, unsigned& nloc, unsigned& nx) {
    const unsigned G = gridDim.x * gridDim.y * gridDim.z;
    unsigned sum, cnt, mine, sp = 0u;
    for (;;) {
        sum = 0u; cnt = 0u; mine = 0u;
#pragma unroll
        for (unsigned j = 0; j < 16; ++j) { const unsigned c = xb_ld(&bar[XB_XCNT(j)]); sum += c; cnt += (c > 0u) ? 1u : 0u; mine = (j == x) ? c : mine; }
        if (sum == G) break;
        __builtin_amdgcn_s_sleep(1);
        if ((++sp & 255u) == 0u) { if (xb_ld(&bar[XB_TMO])) break; if (sp > XB_SPIN_CAP) { atomicAdd(&bar[XB_TMO], 1u); break; } }
    }
    nloc = mine > 0u ? mine : 1u; nx = cnt > 0u ? cnt : 1u;
}
__device__ __forceinline__ void xcd_barrier(unsigned* bar_in, volatile LAS unsigned* st_in, int wave) {
    XcdBarrier b; b.bar = bar_in; b.st = st_in; b.x = (unsigned)__builtin_amdgcn_readfirstlane((int)xb_xcc_id());
    asm volatile("s_waitcnt vmcnt(0)" ::: "memory");
    __syncthreads();
    if (wave == 0 && __builtin_amdgcn_mbcnt_hi(~0u, __builtin_amdgcn_mbcnt_lo(~0u, 0u)) == 0u) {
        unsigned* bar = b.bar;
        __builtin_amdgcn_s_waitcnt(0);
        unsigned nloc = b.st[0], nx = b.st[1];
        if (nloc == 0u) { xcd_barrier_complete(bar, b.x, nloc, nx); b.st[0] = nloc; b.st[1] = nx; }
        const unsigned old = xb_add(&bar[XB_XSUB(b.x)], 1u);
        const unsigned gen = old / nloc;
        if (old + 1u == (gen + 1u) * nloc) {
            __builtin_amdgcn_fence(__ATOMIC_RELEASE, "agent");
            asm volatile("s_waitcnt vmcnt(0)" ::: "memory");
            const unsigned og = xb_add(&bar[XB_TOP], 1u);
            const unsigned tg = og / nx;
            if (og + 1u == (tg + 1u) * nx) xb_add(&bar[XB_TOPGEN], 1u);
            else XB_SPIN(xb_ld(&bar[XB_TOPGEN]) == tg, bar);
            __builtin_amdgcn_fence(__ATOMIC_ACQUIRE, "agent");
            xb_add(&bar[XB_XGEN(b.x)], 1u);
            asm volatile("s_waitcnt vmcnt(0)" ::: "memory");
        } else {
            XB_SPIN(xb_ld(&bar[XB_XGEN(b.x)]) == gen, bar);
            __builtin_amdgcn_fence(__ATOMIC_ACQUIRE, "agent");
            asm volatile("s_waitcnt vmcnt(0)" ::: "memory");
        }
    }
    __syncthreads();
}

namespace pg8 {
#define PG8_LAS __attribute__((address_space(3)))
typedef unsigned short bf16_t;
typedef short bf16x8 __attribute__((ext_vector_type(8)));
typedef float f32x4 __attribute__((ext_vector_type(4)));
typedef unsigned u32x4 __attribute__((ext_vector_type(4)));
constexpr int BM = 256, BK = 64, HALF = 128, HTB = HALF * BK * 2  , STAGE_BYTES = 8 * HTB, NXCD = 8, WGM = 8;

__host__ __device__ __forceinline__ int lds_byte(int r, int c) { const int st = (r >> 4) * 2 + (c >> 5), rr = r & 15, cc = c & 31, ob = rr * 64 + cc * 2; return st * 1024 + (ob ^ (((ob >> 9) & 1) << 5)); }
__host__ __device__ __forceinline__ void stage_rc(int b, int& R, int& C) { const int st = b / 1024, sb = b % 1024, swz = sb ^ (((sb >> 9) & 1) << 5); R = (st >> 1) * 16 + swz / 64; C = (st & 1) * 32 + (swz % 64) / 2; }
__host__ __device__ __forceinline__ int perm32(int rho) { const int n = rho >> 4, i = rho & 15; return 8 * (i >> 2) + 4 * n + (i & 3); }

struct Unit { int pm, pn, kofs; };
struct Gemm { const bf16_t* A; const bf16_t* Bt; int M, N, K; const int* panel_e; size_t e_stride; int lda, ldb; };
struct RowsIdent { static constexpr bool GATHER = false; __device__ __forceinline__ unsigned row(int r) const { return (unsigned)r; } };
struct RowsGather { const int* map; static constexpr bool GATHER = true; __device__ __forceinline__ unsigned row(int r) const { const int t = map[r]; return (unsigned)(t < 0 ? 0 : t); } };

struct StaticOrder {
    int nM, nN, nwg, G, c;
    __host__ __device__ void init(int M, int N, int G_, int c_) { nM = M / BM; nN = N / BM; nwg = nM * nN; G = G_; c = c_; }
    __host__ __device__ bool next(int i, Unit& u) const {
        const long L = (long)i * G + c; if (L >= nwg) return false;
        int wgid = (int)L; { const int q = nwg / NXCD, r = nwg % NXCD, xcd = wgid % NXCD, off = wgid / NXCD; wgid = (xcd < r ? xcd * (q + 1) : r * (q + 1) + (xcd - r) * q) + off; }
        const int nig = WGM * nN, gid = wgid / nig, fm = gid * WGM, gsz = (nM - fm) < WGM ? (nM - fm) : WGM;
        u.pm = fm + ((wgid % nig) % gsz); u.pn = (wgid % nig) / gsz; u.kofs = 0; return true;
    }
    __device__ __forceinline__ void a_ready(const Unit&) const {}
    __device__ __forceinline__ void done(const Unit&) const {}
};

typedef int i32x8 __attribute__((ext_vector_type(8)));
typedef int i32x4 __attribute__((ext_vector_type(4)));
__device__ __forceinline__ unsigned cvt_pk_bf16(float lo, float hi) { unsigned r; asm volatile("v_cvt_pk_bf16_f32 %0, %1, %2" : "=v"(r) : "v"(lo), "v"(hi)); return r; }
template <class Epi, class Sched, bool ALIGN_EPI = false, bool SP2 = false, class AMap = RowsIdent, bool FP8 = false>
__device__ __forceinline__ void gemm_phase(PG8_LAS unsigned char* lds, const Gemm g, const Sched& S, const Epi& E, int tid_in, const AMap AM = AMap()) {
    int tid_ = tid_in; asm volatile("" : "+v"(tid_));
    const int tid = tid_, wid = __builtin_amdgcn_readfirstlane(tid >> 6), lane = tid & 63, wr = wid >> 2, wc = wid & 3, fr = lane & 15, fq = lane >> 4;
    int K_ = g.K; asm volatile("" : "+s"(K_));
    const int K = K_, nt = K / BK, lda = g.lda ? g.lda : K_, ldb = g.ldb ? g.ldb : K_;
    unsigned voffB[2]; int RA[2], CA2[2];
#pragma unroll
    for (int i = 0; i < 2; ++i) { int R, C; stage_rc(tid * 16 + i * 8192, R, C); const int Rb = Epi::PERM ? ((R & ~31) + perm32(R & 31)) : R;
        RA[i] = R; CA2[i] = C * 2; voffB[i] = (unsigned)(Rb * ldb + C) * 2u; }
    unsigned voC[2][2], voN[2][2];
#define PG8_CALCA(vo, pm_, ko_) do { _Pragma("unroll") for (int h_ = 0; h_ < 2; ++h_) _Pragma("unroll") for (int i_ = 0; i_ < 2; ++i_) \
        vo[h_][i_] = AM.row((pm_) * BM + h_ * HALF + RA[i_]) * (unsigned)(lda * 2) + (unsigned)(CA2[i_] + 2 * (ko_)); } while (0)
    const size_t kstep = (size_t)(BK * 2);
    const size_t hstep = (size_t)HALF * ldb * 2;
    const size_t tstep = 2 * hstep;
    const unsigned ldsw = (unsigned)wid * 1024u;
    const int aoff = lds_byte(wr * 64 + fr, fq * 8), boff = lds_byte(wc * 32 + fr, fq * 8);
#define PG8_SA(b, h) (((b) * 2 + (h)) * HTB)
#define PG8_SB(b, h) ((4 + (b) * 2 + (h)) * HTB)
#define PG8_STAGE(bufoff, gbase, voff) do { _Pragma("unroll") for (int _i = 0; _i < 2; ++_i) \
        __builtin_amdgcn_global_load_lds((const unsigned*)((const char*)(gbase) + (voff)[_i]), (PG8_LAS unsigned*)(lds + (bufoff) + ldsw + _i * 8192), 16, 0, 0); } while (0)
#define PG8_LDA(dst, b, h) do { _Pragma("unroll") for (int m = 0; m < 4; ++m) { if constexpr (FP8) { dst##8[m].lo = *(const PG8_LAS i32x4*)(lds + PG8_SA(b, h) + aoff + m * 2048); dst##8[m].hi = *(const PG8_LAS i32x4*)(lds + PG8_SA(b, h) + aoff + m * 2048 + 1024); } \
        else { _Pragma("unroll") for (int k = 0; k < 2; ++k) dst[m][k] = *(const PG8_LAS bf16x8*)(lds + PG8_SA(b, h) + aoff + m * 2048 + k * 1024); } } } while (0)
#define PG8_LDB(dst, b, h) do { _Pragma("unroll") for (int n = 0; n < 2; ++n) { if constexpr (FP8) { dst##8[n].lo = *(const PG8_LAS i32x4*)(lds + PG8_SB(b, h) + boff + n * 2048); dst##8[n].hi = *(const PG8_LAS i32x4*)(lds + PG8_SB(b, h) + boff + n * 2048 + 1024); } \
        else { _Pragma("unroll") for (int k = 0; k < 2; ++k) dst[n][k] = *(const PG8_LAS bf16x8*)(lds + PG8_SB(b, h) + boff + n * 2048 + k * 1024); } } } while (0)
#define PG8_MMA(ai, bj, At, Bt) do { __builtin_amdgcn_s_setprio(1); _Pragma("unroll") for (int m = 0; m < 4; ++m) _Pragma("unroll") for (int n = 0; n < 2; ++n) { \
        if constexpr (FP8) asm volatile("v_mfma_f32_16x16x128_f8f6f4 %0, %1, %2, %0" : "+v"(acc[ai][bj][m][n]) : "v"(Bt##8[n]), "v"(At##8[m]));   \
        else { _Pragma("unroll") for (int k = 0; k < 2; ++k) acc[ai][bj][m][n] = __builtin_amdgcn_mfma_f32_16x16x32_bf16(Bt[n][k], At[m][k], acc[ai][bj][m][n], 0, 0, 0); } } __builtin_amdgcn_s_setprio(0); } while (0)
#define PG8_WAIT_V(n) asm volatile("s_waitcnt vmcnt(" #n ")" ::: "memory")
#define PG8_WAIT_L(n) asm volatile("s_waitcnt lgkmcnt(" #n ")" ::: "memory")
#define PG8_BAR __builtin_amdgcn_s_barrier()
#define PG8_SCHED __builtin_amdgcn_sched_barrier(0)
    Unit cur, nxt; int ui = 0;
    if (!S.next(0, cur)) return;
    f32x4 acc[2][2][4][2];
#pragma unroll
    for (int a = 0; a < 2; ++a)
#pragma unroll
        for (int b = 0; b < 2; ++b)
#pragma unroll
            for (int m = 0; m < 4; ++m)
#pragma unroll
                for (int n = 0; n < 2; ++n) acc[a][b][m][n] = (f32x4){0.f, 0.f, 0.f, 0.f};
    bf16x8 At[4][2], B0[2][2], B1[2][2];
    i32x8 At8[4], B08[2], B18[2];
    const char* const Ab = (const char*)g.A;
#define PG8_BBASE(u_) ((const char*)g.Bt + (g.panel_e ? (size_t)g.panel_e[(u_).pm] * g.e_stride * 2 : (size_t)0) + (size_t)(u_).pn * tstep + (size_t)(u_).kofs * 2)
    const char* cB = PG8_BBASE(cur); PG8_CALCA(voC, cur.pm, cur.kofs);
    S.a_ready(cur);
    if constexpr (SP2) {
        PG8_STAGE(PG8_SB(0, 0), cB, voffB); PG8_STAGE(PG8_SB(0, 1), cB + hstep, voffB); PG8_STAGE(PG8_SA(0, 0), Ab, voC[0]); PG8_STAGE(PG8_SA(0, 1), Ab, voC[1]);
        if (wr == 1) PG8_BAR;
        PG8_WAIT_V(2); PG8_BAR;
        PG8_STAGE(PG8_SB(1, 0), cB + kstep, voffB); PG8_STAGE(PG8_SA(1, 0), Ab + kstep, voC[0]); PG8_STAGE(PG8_SB(1, 1), cB + hstep + kstep, voffB);
        PG8_WAIT_V(6); PG8_BAR;
    } else {
        PG8_STAGE(PG8_SB(0, 0), cB, voffB); PG8_STAGE(PG8_SA(0, 0), Ab, voC[0]); PG8_STAGE(PG8_SB(0, 1), cB + hstep, voffB); PG8_STAGE(PG8_SA(0, 1), Ab, voC[1]);
        if (wr == 1) PG8_BAR;
        PG8_WAIT_V(4); PG8_BAR;
        PG8_STAGE(PG8_SB(1, 0), cB + kstep, voffB); PG8_STAGE(PG8_SA(1, 0), Ab + kstep, voC[0]); PG8_STAGE(PG8_SB(1, 1), cB + hstep + kstep, voffB);
        PG8_WAIT_V(6); PG8_BAR;
    }
    for (;;) {
        const bool has_next = S.next(ui + 1, nxt);
        const char* nB = has_next ? PG8_BBASE(nxt) : cB;
        if (has_next) { PG8_CALCA(voN, nxt.pm, nxt.kofs); } else {
#pragma unroll
            for (int h_ = 0; h_ < 2; ++h_)
#pragma unroll
                for (int i_ = 0; i_ < 2; ++i_) voN[h_][i_] = voC[h_][i_]; }
        for (int t = 0; t < nt; t += 2) {
            const bool last = (t == nt - 2);
            const char* a1 = Ab + (size_t)(t + 1) * kstep;
            const char* a2 = last ? Ab : Ab + (size_t)(t + 2) * kstep; const char* b2 = last ? nB : cB + (size_t)(t + 2) * kstep;
            const char* a3 = a2 + kstep; const char* b3 = b2 + kstep;
            unsigned vo2[2][2];
#pragma unroll
            for (int h_ = 0; h_ < 2; ++h_)
#pragma unroll
                for (int i_ = 0; i_ < 2; ++i_) vo2[h_][i_] = last ? voN[h_][i_] : voC[h_][i_];
            if (last && has_next) S.a_ready(nxt);
            if constexpr (SP2) {
            PG8_LDB(B0, 0, 0); PG8_LDB(B1, 0, 1); PG8_SCHED; PG8_LDA(At, 0, 0); PG8_STAGE(PG8_SA(1, 1), a1, voC[1]);
            PG8_WAIT_V(8); PG8_WAIT_L(0); PG8_BAR; PG8_MMA(0, 0, At, B0); PG8_MMA(0, 1, At, B1); PG8_BAR; PG8_SCHED;
            PG8_LDA(At, 0, 1); PG8_STAGE(PG8_SB(0, 0), b2, voffB); PG8_STAGE(PG8_SB(0, 1), b2 + hstep, voffB); PG8_STAGE(PG8_SA(0, 0), a2, vo2[0]);
            PG8_WAIT_V(8); PG8_WAIT_L(0); PG8_BAR; PG8_MMA(1, 0, At, B0); PG8_MMA(1, 1, At, B1); PG8_BAR; PG8_SCHED;
            PG8_LDB(B0, 1, 0); PG8_LDB(B1, 1, 1); PG8_SCHED; PG8_LDA(At, 1, 0); PG8_STAGE(PG8_SA(0, 1), a2, vo2[1]);
            PG8_WAIT_V(8); PG8_WAIT_L(0); PG8_BAR; PG8_MMA(0, 0, At, B0); PG8_MMA(0, 1, At, B1); PG8_BAR; PG8_SCHED;
            PG8_LDA(At, 1, 1); PG8_STAGE(PG8_SB(1, 0), b3, voffB); PG8_STAGE(PG8_SB(1, 1), b3 + hstep, voffB); PG8_STAGE(PG8_SA(1, 0), a3, vo2[0]);
            PG8_WAIT_V(8); PG8_WAIT_L(0); PG8_BAR; PG8_MMA(1, 0, At, B0); PG8_MMA(1, 1, At, B1); PG8_BAR; PG8_SCHED;
            } else {
            PG8_LDB(B0, 0, 0); PG8_SCHED; PG8_LDA(At, 0, 0); PG8_STAGE(PG8_SA(1, 1), a1, voC[1]);
            PG8_WAIT_L(8); PG8_BAR; PG8_WAIT_L(0); PG8_MMA(0, 0, At, B0); PG8_BAR; PG8_SCHED;
            PG8_LDB(B1, 0, 1); PG8_STAGE(PG8_SB(0, 0), b2, voffB);
            PG8_BAR; PG8_WAIT_L(0); PG8_MMA(0, 1, At, B1); PG8_BAR;
            PG8_LDA(At, 0, 1); PG8_STAGE(PG8_SA(0, 0), a2, vo2[0]);
            PG8_BAR; PG8_WAIT_L(0); PG8_MMA(1, 0, At, B0); PG8_BAR; PG8_SCHED;
            PG8_STAGE(PG8_SB(0, 1), b2 + hstep, voffB);
            PG8_WAIT_V(6); PG8_BAR; PG8_MMA(1, 1, At, B1); PG8_BAR;
            PG8_LDB(B0, 1, 0); PG8_SCHED; PG8_LDA(At, 1, 0); PG8_STAGE(PG8_SA(0, 1), a2, vo2[1]);
            PG8_WAIT_L(8); PG8_BAR; PG8_WAIT_L(0); PG8_MMA(0, 0, At, B0); PG8_BAR; PG8_SCHED;
            PG8_LDB(B1, 1, 1); PG8_STAGE(PG8_SB(1, 0), b3, voffB);
            PG8_BAR; PG8_WAIT_L(0); PG8_MMA(0, 1, At, B1); PG8_BAR;
            PG8_LDA(At, 1, 1); PG8_STAGE(PG8_SA(1, 0), a3, vo2[0]);
            PG8_BAR; PG8_WAIT_L(0); PG8_MMA(1, 0, At, B0); PG8_BAR; PG8_SCHED;
            PG8_STAGE(PG8_SB(1, 1), b3 + hstep, voffB);
            PG8_WAIT_V(6); PG8_BAR; PG8_MMA(1, 1, At, B1); PG8_BAR;
            }
        }
        if constexpr (FP8) asm volatile("s_nop 15\n\ts_nop 15" ::: "memory");
        if constexpr (ALIGN_EPI) { if (wr == 0) PG8_BAR; }
        if constexpr (!Epi::AFTER_DRAIN) { E(acc, cur, wr, wc, fr, fq); S.done(cur); }
        if (!has_next) break;
#pragma unroll
        for (int a = 0; a < 2; ++a)
#pragma unroll
            for (int b = 0; b < 2; ++b)
#pragma unroll
                for (int m = 0; m < 4; ++m)
#pragma unroll
                    for (int n = 0; n < 2; ++n) acc[a][b][m][n] = (f32x4){0.f, 0.f, 0.f, 0.f};
        cur = nxt; cB = nB; ++ui;
#pragma unroll
        for (int h_ = 0; h_ < 2; ++h_)
#pragma unroll
            for (int i_ = 0; i_ < 2; ++i_) voC[h_][i_] = voN[h_][i_];
        if constexpr (ALIGN_EPI) { if (wr == 1) PG8_BAR; }
    }
    PG8_WAIT_V(0);
    if constexpr (!ALIGN_EPI) { if (wr == 0) PG8_BAR; }
    PG8_BAR;
    if constexpr (Epi::AFTER_DRAIN) { E.fused(acc, cur, wr, wc, fr, fq, lds, wid, lane); S.done(cur); }
#undef PG8_CALCA
#undef PG8_BBASE
#undef PG8_SA
#undef PG8_SB
#undef PG8_STAGE
#undef PG8_LDA
#undef PG8_LDB
#undef PG8_MMA
#undef PG8_WAIT_V
#undef PG8_WAIT_L
#undef PG8_BAR
#undef PG8_SCHED
}
}

enum { I_X = 0, I_P, I_ATTN_NORM, I_W_IN, I_CMP_POS, I_CMP_W1, I_CMP_W2, I_CONV_W, I_CONV_B, I_LRU_WA, I_LRU_BA, I_LRU_WX, I_LRU_BX, I_LRU_LAMBDA,
       I_OUT_NORM_ATTN, I_OUT_NORM_REC, I_W_OUT, I_FFN_NORM, I_DENSE_WG, I_DENSE_WU, I_DENSE_WD, I_ROUTER_W, I_MOE_WG, I_MOE_WU, I_MOE_WD,
       I_PLE_NORM, I_PLE_WG, I_PLE_WP, I_FINAL_NORM, N_IN };
struct Args { const float* in[N_IN]; float* out; unsigned char* ws; int ph_lo, ph_hi, li, pad; };

typedef const __attribute__((address_space(4))) Args* KArgs;
__device__ __forceinline__ KArgs kargs() { KArgs p = (KArgs)__builtin_amdgcn_kernarg_segment_ptr(); asm volatile("" : "+s"(p)); return p; }
struct Ctx {
    LAS float* lds; int tid, lane, wave, bid, nblk;
    bf16* XO; bf16* XB; float* SSP;
};
__device__ __forceinline__ Ctx fresh(const Ctx& c) {
    Ctx f = c;
    asm volatile("" : "+s"(f.wave), "+s"(f.bid), "+s"(f.nblk));
    f.lane = (int)__builtin_amdgcn_mbcnt_hi(~0u, __builtin_amdgcn_mbcnt_lo(~0u, 0u)); f.tid = f.wave * 64 + f.lane;
    asm volatile("" : "+v"(f.tid), "+v"(f.lane));
    asm volatile("" : "+s"(f.XO), "+s"(f.XB), "+s"(f.SSP));
    return f;
}
#define CA_IN(i) (ka->in[i])
#define CA_WS (ka->ws)

__device__ __forceinline__ float row_rs(const float* SSP, int stage, int row) {
    const f32x4* p = (const f32x4*)(SSP + ((size_t)stage * NTOK + row) * 16);
    f32x4 a = p[0], b = p[1], c = p[2], d = p[3];
    float s = ((a.x + a.y) + (a.z + a.w)) + ((b.x + b.y) + (b.z + b.w)) + ((c.x + c.y) + (c.z + c.w)) + ((d.x + d.y) + (d.z + d.w));
    return __builtin_amdgcn_rsqf(s * (1.f / D_) + RMS_EPS);
}

__device__ __forceinline__ void phase_fix(Ctx c, const float* src, int stage) {
    const int gw = c.bid * NWAVES + c.wave, NGW = c.nblk * NWAVES;
    for (int m = gw; m < NTOK; m += NGW) {
        const f32x4* xr = (const f32x4*)(src + (size_t)m * D_) + c.lane;
        f32x4 v[4]; float s = 0.f;
#pragma unroll
        for (int j = 0; j < 4; ++j) { v[j] = xr[64 * j]; s += (v[j].x * v[j].x + v[j].y * v[j].y) + (v[j].z * v[j].z + v[j].w * v[j].w); }
        s = wave_sum(s, c.lane);
        u32x2* o8 = (u32x2*)(c.XB + (size_t)m * D_) + c.lane;
#pragma unroll
        for (int j = 0; j < 4; ++j) { u32x2 w; w.x = pk2(v[j].x, v[j].y); w.y = pk2(v[j].z, v[j].w); o8[64 * j] = w; }
        if (c.lane < 16) c.SSP[((size_t)stage * NTOK + m) * 16 + c.lane] = (c.lane == 0) ? s : 0.f;
    }
}
__device__ __forceinline__ void phase_final(Ctx c, int stage) {
    KArgs ka = kargs();
    const float* gn = CA_IN(I_FINAL_NORM); const bf16* RIN = (const bf16*)(CA_WS + WS_MIXED); float* out = ka->out;
    const int gw = c.bid * NWAVES + c.wave, NGW = c.nblk * NWAVES;
    for (int m = gw; m < NTOK; m += NGW) {
        const u32x2* xr = (const u32x2*)(RIN + (size_t)m * D_) + c.lane; f32x4* orow = (f32x4*)(out + (size_t)m * D_) + c.lane;
        const float rs = row_rs(c.SSP, stage, m);
#pragma unroll
        for (int j = 0; j < 4; ++j) { const u32x2 w = xr[64 * j]; const f32x4 g = ((const f32x4*)gn)[64 * j + c.lane];
            orow[64 * j] = (f32x4){blo(w.x) * rs * g.x, bhi(w.x) * rs * g.y, blo(w.y) * rs * g.z, bhi(w.y) * rs * g.w}; }
    }
}

template <bool FINAL>
__device__ __forceinline__ void phase_lru(Ctx c, int L) {
    KArgs ka = kargs();
    unsigned char* ws = CA_WS;
    const bf16* XR = (const bf16*)(ws + WS_XR); const bf16* YG = (const bf16*)(ws + WS_YG); bf16* MIXED = (bf16*)(ws + WS_MIXED);
    float* SA = (float*)(ws + MS_LRUA); float* SB = (float*)(ws + MS_LRUB);
    const float* conv_w = CA_IN(I_CONV_W) + L * 4 * D_REC; const float* conv_b = CA_IN(I_CONV_B) + L * D_REC;
    const float* ba = CA_IN(I_LRU_BA) + L * D_REC; const float* bx = CA_IN(I_LRU_BX) + L * D_REC; const float* lam = CA_IN(I_LRU_LAMBDA) + L * D_REC;
    const int ch = c.tid, blk = c.wave, lane = c.lane, fr = lane & 15, fq = lane >> 4;
    LAS char* lds = (LAS char*)c.lds;
    LAS unsigned short* xcb = (LAS unsigned short*)lds;
    LAS float* pre = (LAS float*)(lds + 16640);
    LAS float* red = (LAS float*)(lds + 16640 + 65536);
    const float cw0 = conv_w[0 * D_REC + ch], cw1 = conv_w[1 * D_REC + ch], cw2 = conv_w[2 * D_REC + ch], cw3 = conv_w[3 * D_REC + ch], cb = conv_b[ch];
    const float b_a = ba[ch], b_x = bx[ch];
    const float lmb = lam[ch]; const float sp = (lmb > 0.f) ? __logf(1.f + __expf(-lmb)) : (-lmb + __logf(1.f + __expf(lmb)));
    s16x8 wfa[4][2], wfx[4][2];
    { const bf16* WA = (const bf16*)(ws + WB_LWA) + ((size_t)L * 8 + blk) * 4096; const bf16* WX = (const bf16*)(ws + WB_LWX) + ((size_t)L * 8 + blk) * 4096;
#pragma unroll
      for (int ct = 0; ct < 4; ++ct)
#pragma unroll
          for (int ks = 0; ks < 2; ++ks) { wfa[ct][ks] = *(const s16x8*)(WA + (16 * ct + fr) * 64 + 32 * ks + 8 * fq); wfx[ct][ks] = *(const s16x8*)(WX + (16 * ct + fr) * 64 + 32 * ks + 8 * fq); } }
#define LRU_BAR() asm volatile("s_waitcnt lgkmcnt(0)\n\ts_barrier" ::: "memory")
    for (int u = c.bid; u < NB_ * LRU_NCH; u += c.nblk) {
        const int b = u / LRU_NCH, cki = u % LRU_NCH, t0 = cki * LRU_CHUNK;
        float h = 0.f, Aprod = 1.f;
        const bf16* xrp = XR + ((size_t)b * T_) * D_REC + ch; const bf16* ygp = YG + ((size_t)b * T_) * D_REC + ch;
        unsigned short xn[16], yn[16];
#pragma unroll
        for (int i = 0; i < 16; ++i) { xn[i] = xrp[(size_t)(t0 + i) * D_REC]; if (FINAL) yn[i] = ygp[(size_t)(t0 + i) * D_REC]; }
        float x1 = (t0 >= 1) ? bf2f(xrp[(size_t)(t0 - 1) * D_REC]) : 0.f, x2 = (t0 >= 2) ? bf2f(xrp[(size_t)(t0 - 2) * D_REC]) : 0.f, x3 = (t0 >= 3) ? bf2f(xrp[(size_t)(t0 - 3) * D_REC]) : 0.f;
        if (FINAL) {
            for (int j0 = 0; j0 < cki; j0 += 16) { float aa[16], bq[16];
#pragma unroll
                for (int k = 0; k < 16; ++k) { const bool v = j0 + k < cki; aa[k] = v ? SA[((size_t)b * LRU_NCH + j0 + k) * D_REC + ch] : 1.f; bq[k] = v ? SB[((size_t)b * LRU_NCH + j0 + k) * D_REC + ch] : 0.f; }
#pragma unroll
                for (int k = 0; k < 16; ++k) h = aa[k] * h + bq[k]; } }
        __syncthreads();
        for (int s = 0; s < LRU_CHUNK; s += 16) {
            float xc[16], yv[16];
#pragma unroll
            for (int i = 0; i < 16; ++i) { const float x0 = bf2f(xn[i]); if (FINAL) yv[i] = bf2f(yn[i]); xc[i] = cw0 * x3 + cw1 * x2 + cw2 * x1 + cw3 * x0 + cb; x3 = x2; x2 = x1; x1 = x0; xcb[i * 520 + ch] = f2bf(xc[i]); }
            if (s + 16 < LRU_CHUNK) {
#pragma unroll
                for (int i = 0; i < 16; ++i) { xn[i] = xrp[(size_t)(t0 + s + 16 + i) * D_REC]; if (FINAL) yn[i] = ygp[(size_t)(t0 + s + 16 + i) * D_REC]; } }
            LRU_BAR();
            { s16x8 af[2];
#pragma unroll
              for (int ks = 0; ks < 2; ++ks) af[ks] = *(const LAS s16x8*)(xcb + fr * 520 + blk * 64 + 32 * ks + 8 * fq);
#pragma unroll
              for (int ct = 0; ct < 4; ++ct) { f32x4 ra = (f32x4){0.f, 0.f, 0.f, 0.f}, rx = ra;
#pragma unroll
                  for (int ks = 0; ks < 2; ++ks) { ra = __builtin_amdgcn_mfma_f32_16x16x32_bf16(af[ks], wfa[ct][ks], ra, 0, 0, 0); rx = __builtin_amdgcn_mfma_f32_16x16x32_bf16(af[ks], wfx[ct][ks], rx, 0, 0, 0); }
#pragma unroll
                  for (int i = 0; i < 4; ++i) { pre[(4 * fq + i) * 512 + blk * 64 + 16 * ct + fr] = ra[i]; pre[8192 + (4 * fq + i) * 512 + blk * 64 + 16 * ct + fr] = rx[i]; } } }
            LRU_BAR();
            float o[16];
            typedef float f32x2 __attribute__((ext_vector_type(2)));
            const float ca = -8.f * sp * LOG2E;
#pragma unroll
            for (int i = 0; i < 16; i += 2) {
                const f32x2 pa = (f32x2){pre[i * 512 + ch], pre[(i + 1) * 512 + ch]} + b_a, px = (f32x2){pre[8192 + i * 512 + ch], pre[8192 + (i + 1) * 512 + ch]} + b_x;
                const f32x2 ta = pa * (-LOG2E), tx = px * (-LOG2E);
                const f32x2 da = (f32x2){__builtin_amdgcn_exp2f(ta.x), __builtin_amdgcn_exp2f(ta.y)} + 1.f, dx = (f32x2){__builtin_amdgcn_exp2f(tx.x), __builtin_amdgcn_exp2f(tx.y)} + 1.f;
                const f32x2 r = (f32x2){__builtin_amdgcn_rcpf(da.x), __builtin_amdgcn_rcpf(da.y)}, ig = (f32x2){__builtin_amdgcn_rcpf(dx.x), __builtin_amdgcn_rcpf(dx.y)};
                const f32x2 la2 = r * ca; const f32x2 av = (f32x2){__builtin_amdgcn_exp2f(la2.x), __builtin_amdgcn_exp2f(la2.y)};
                const f32x2 om = 1.f - av * av; const f32x2 sq = (f32x2){__builtin_amdgcn_sqrtf(fmaxf(om.x, 0.f)), __builtin_amdgcn_sqrtf(fmaxf(om.y, 0.f))};
                const f32x2 bb = sq * ig * (f32x2){xc[i], xc[i + 1]};
                h = av.x * h + bb.x; o[i] = h; h = av.y * h + bb.y; o[i + 1] = h; Aprod *= av.x * av.y; }
            if (FINAL) {
                float v8[8], v4[4], v2[2], v1;
#pragma unroll
                for (int i = 0; i < 16; i += 2) {
                    const f32x2 y = (f32x2){yv[i], yv[i + 1]}; const f32x2 t = (y * y * 0.044715f + 1.f) * y * (-2.f * 0.7978845608028654f * LOG2E);
                    const f32x2 d = (f32x2){__builtin_amdgcn_exp2f(t.x), __builtin_amdgcn_exp2f(t.y)} + 1.f;
                    const f32x2 gl = y * (f32x2){__builtin_amdgcn_rcpf(d.x), __builtin_amdgcn_rcpf(d.y)};
                    o[i] *= gl.x; o[i + 1] *= gl.y; }
                { const bool up = (lane & 32) != 0;
#pragma unroll
                  for (int i = 0; i < 8; ++i) { const float lo = o[i] * o[i], hi2 = o[i + 8] * o[i + 8]; const float keep = up ? hi2 : lo, send = up ? lo : hi2; v8[i] = keep + shx(send, 32, lane); } }
                { const bool up = (lane & 16) != 0;
#pragma unroll
                  for (int i = 0; i < 4; ++i) { const float keep = up ? v8[i + 4] : v8[i], send = up ? v8[i] : v8[i + 4]; v4[i] = keep + shx(send, 16, lane); } }
                { const bool up = (lane & 8) != 0;
#pragma unroll
                  for (int i = 0; i < 2; ++i) { const float keep = up ? v4[i + 2] : v4[i], send = up ? v4[i] : v4[i + 2]; v2[i] = keep + shx(send, 8, lane); } }
                { const bool up = (lane & 4) != 0; const float keep = up ? v2[1] : v2[0], send = up ? v2[0] : v2[1]; v1 = keep + shx(send, 4, lane); }
                v1 += shx(v1, 2, lane); v1 += shx(v1, 1, lane);
                if ((lane & 3) == 0) red[(((lane >> 5) & 1) * 8 + ((lane >> 4) & 1) * 4 + ((lane >> 3) & 1) * 2 + ((lane >> 2) & 1)) * 8 + c.wave] = v1;
                LRU_BAR();
                float rsl = 0.f;
                if ((lane & 3) == 0) { float q = 0.f;
#pragma unroll
                    for (int w = 0; w < 8; ++w) q += red[(lane >> 2) * 8 + w];
                    rsl = __builtin_amdgcn_rsqf(q * (1.f / D_REC) + RMS_EPS); }
#pragma unroll
                for (int i = 0; i < 16; ++i) { const float rs = __builtin_bit_cast(float, __builtin_amdgcn_readlane(__builtin_bit_cast(int, rsl), 4 * i)); MIXED[((size_t)b * T_ + t0 + s + i) * D_ + 512 + ch] = f2bf(o[i] * rs); }
            }
            LRU_BAR();
        }
        if (!FINAL) { SA[((size_t)b * LRU_NCH + cki) * D_REC + ch] = Aprod; SB[((size_t)b * LRU_NCH + cki) * D_REC + ch] = h; }
    }
    __syncthreads();
}

constexpr int AT_K = 0, AT_V = 24576, AT_PSLC = 57344, AT_PSLC_LD = 132, AT_SEL = AT_PSLC + 64 * AT_PSLC_LD * 4, AT_MISC = AT_SEL + 1024, AT_OST = AT_MISC + 2560, AT_END = AT_OST + 65536;
constexpr float NEG_BIG = -INFINITY;
__device__ __forceinline__ unsigned cvtpk(float lo, float hi) { unsigned r; asm("v_cvt_pk_bf16_f32 %0, %1, %2" : "=v"(r) : "v"(lo), "v"(hi)); return r; }
__device__ __forceinline__ s16x4 vtr(const LAS char* p) { return __builtin_bit_cast(s16x4, __builtin_amdgcn_ds_read_tr16_b64_v4i16((LAS s16x4*)p)); }
__device__ __forceinline__ void dma16(const void* g, LAS char* l) { __builtin_amdgcn_global_load_lds((const unsigned*)g, (LAS unsigned*)l, 16, 0, 0); }

struct AttnW {
    LAS char* lds; int lane, wave, r32, hi, hl, qh;
};
__device__ __forceinline__ void at_load_tile(const AttnW& w, const bf16* Kt, const bf16* Vt, int tile) {
    dma16((const char*)Kt + (8 * w.wave + (w.lane >> 3)) * 128 + (((w.lane & 7) ^ (w.lane >> 3)) * 16), w.lds + AT_K + (tile % 3) * 8192 + w.wave * 1024);
    dma16((const char*)Vt + (16 * (w.wave & 3) + (w.lane >> 2)) * 128 + (w.wave >> 2) * 64 + (w.lane & 3) * 16, w.lds + AT_V + (tile & 3) * 8192 + w.wave * 1024);
}
__device__ __forceinline__ void at_ldk(const AttnW& w, int tile, s16x8 (&kf)[8]) {
    const unsigned ka = (unsigned)(uintptr_t)w.lds + (unsigned)(AT_K + (tile % 3) * 8192 + w.r32 * 128);
#pragma unroll
    for (int d0 = 0; d0 < 4; ++d0) { const unsigned kd = ka + (unsigned)((((2 * d0 + w.hi) ^ (w.r32 & 7))) * 16);
        asm volatile("ds_read_b128 %0, %1 offset:0" : "=v"(kf[2 * d0]) : "v"(kd) : "memory");
        asm volatile("ds_read_b128 %0, %1 offset:4096" : "=v"(kf[2 * d0 + 1]) : "v"(kd) : "memory"); }
}
__device__ __forceinline__ void at_ldv(const AttnW& w, int tile, s16x4 (&vl)[8], s16x4 (&vh)[8]) {
    const unsigned va = (unsigned)(uintptr_t)w.lds + (unsigned)(AT_V + (tile & 3) * 8192 + ((w.lane >> 4) & 1) * 32 + (w.lane & 3) * 8 + (4 * w.hi + ((w.lane & 15) >> 2)) * 64);
#pragma unroll
    for (int i = 0; i < 8; ++i) {
        asm volatile("ds_read_b64_tr_b16 %0, %1 offset:%2" : "=v"(vl[i]) : "v"(va), "n"((i >> 2) * 4096 + (i & 3) * 1024) : "memory");
        asm volatile("ds_read_b64_tr_b16 %0, %1 offset:%2" : "=v"(vh[i]) : "v"(va), "n"((i >> 2) * 4096 + (i & 3) * 1024 + 512) : "memory"); }
}
#define AT_LGKM0() do { asm volatile("s_waitcnt lgkmcnt(0)" ::: "memory"); __builtin_amdgcn_sched_barrier(0); } while (0)
__device__ __forceinline__ void at_bias(const AttnW& w, float ks, float lb, f32x16& p0, f32x16& p1) {
    float bb = lb + ks * (float)(4 * w.hi); const float k32 = 32.f * ks, k5 = 5.f * ks;
#pragma unroll
    for (int r = 0; r < 16; ++r) { p0[r] = bb; p1[r] = bb + k32; bb += ((r & 3) == 3) ? k5 : ks; }
}
template <int MASK>
__device__ __forceinline__ void at_bias_m(const AttnW& w, float ks, float lb, int lim, f32x16& p0, f32x16& p1) {
    float bb = lb + ks * (float)(4 * w.hi); const float k32 = 32.f * ks, k5 = 5.f * ks;
    int l0 = lim - 4 * w.hi; asm volatile("" : "+v"(l0));
#pragma unroll
    for (int r = 0; r < 16; ++r) { const int kc = (r & 3) + 8 * (r >> 2);
        const bool k0 = (MASK == 1) ? (kc <= l0) : (kc > l0), k1 = (MASK == 1) ? (kc + 32 <= l0) : (kc + 32 > l0);
        p0[r] = k0 ? bb : NEG_BIG; p1[r] = k1 ? bb + k32 : NEG_BIG; bb += ((r & 3) == 3) ? k5 : ks; }
}
__device__ __forceinline__ void at_qk(const s16x8 (&kf)[8], const s16x8 (&qr)[4], f32x16& p0, f32x16& p1) {
#pragma unroll
    for (int d0 = 0; d0 < 4; ++d0) { p0 = __builtin_amdgcn_mfma_f32_32x32x16_bf16(kf[2 * d0], qr[d0], p0, 0, 0, 0); p1 = __builtin_amdgcn_mfma_f32_32x32x16_bf16(kf[2 * d0 + 1], qr[d0], p1, 0, 0, 0); }
}
template <int MASK>
__device__ __forceinline__ void at_mask(const AttnW& w, f32x16& p0, f32x16& p1, int lim) {
    int l0 = lim - 4 * w.hi; asm volatile("" : "+v"(l0));
#pragma unroll
    for (int r = 0; r < 16; ++r) { const int kc = (r & 3) + 8 * (r >> 2);
        if (MASK == 1) { if (!(kc <= l0)) p0[r] = NEG_BIG; if (!(kc + 32 <= l0)) p1[r] = NEG_BIG; }
        if (MASK == 2) { if (!(kc > l0)) p0[r] = NEG_BIG; if (!(kc + 32 > l0)) p1[r] = NEG_BIG; } }
}
__device__ __forceinline__ void at_softmax(f32x16& p0, f32x16& p1, float& l, u32x4 (&pw)[4]) {
    float ls = 0.f;
#pragma unroll
    for (int r = 0; r < 16; ++r) { p0[r] = __builtin_amdgcn_exp2f(p0[r]); p1[r] = __builtin_amdgcn_exp2f(p1[r]); ls += p0[r] + p1[r]; }
    l += ls;
#pragma unroll
    for (int k = 0; k < 2; ++k) { pw[k] = (u32x4){cvtpk(p0[8 * k], p0[8 * k + 1]), cvtpk(p0[8 * k + 2], p0[8 * k + 3]), cvtpk(p0[8 * k + 4], p0[8 * k + 5]), cvtpk(p0[8 * k + 6], p0[8 * k + 7])};
        pw[2 + k] = (u32x4){cvtpk(p1[8 * k], p1[8 * k + 1]), cvtpk(p1[8 * k + 2], p1[8 * k + 3]), cvtpk(p1[8 * k + 4], p1[8 * k + 5]), cvtpk(p1[8 * k + 6], p1[8 * k + 7])}; }
}
__device__ __forceinline__ void at_pv(const s16x4 (&vl)[8], const s16x4 (&vh)[8], const u32x4 (&pw)[4], f32x16 (&o)[2]) {
#pragma unroll
    for (int dh = 0; dh < 2; ++dh)
#pragma unroll
        for (int k = 0; k < 4; ++k) { const s16x4 a = vl[dh * 4 + k], b = vh[dh * 4 + k];
            o[dh] = __builtin_amdgcn_mfma_f32_32x32x16_bf16((s16x8){a[0], a[1], a[2], a[3], b[0], b[1], b[2], b[3]}, __builtin_bit_cast(s16x8, pw[k]), o[dh], 0, 0, 0); }
}
#define AT_STEP(t, n, ACT_, BIASSTMT) AT_STEPM(t, n, ACT_, BIASSTMT, (void)0)
#define AT_STEPM(t, n, ACT_, BIASSTMT, MASKSTMT) do { \
        if (w.wave >= 4 && (t) > 0 && pend) { s16x4 vl[8], vh[8]; at_ldv(w, (t) - 1, vl, vh); AT_LGKM0(); at_pv(vl, vh, pw, o); } \
        pend = false; \
        if ((t) < (n) && (ACT_)) { f32x16 p0, p1; { s16x8 kf[8]; at_ldk(w, (t), kf); BIASSTMT; AT_LGKM0(); at_qk(kf, qr, p0, p1); } MASKSTMT; at_softmax(p0, p1, l, pw); pend = true; \
            if (w.wave < 4) { s16x4 vl[8], vh[8]; at_ldv(w, (t), vl, vh); AT_LGKM0(); at_pv(vl, vh, pw, o); } } } while (0)
#define AT_NEGL 60.f
#define AT_WAITBAR(newer) do { if (newer) asm volatile("s_waitcnt vmcnt(2) lgkmcnt(0)\n\ts_barrier" ::: "memory"); else asm volatile("s_waitcnt vmcnt(0) lgkmcnt(0)\n\ts_barrier" ::: "memory"); } while (0)

__device__ __forceinline__ void phase_attn_mfma(Ctx c) {
    KArgs ka = kargs(); unsigned char* ws = CA_WS;
    const bf16* Q = (const bf16*)(ws + WS_Q); const float* GATE = (const float*)(ws + WS_GATE); bf16* MIXED = (bf16*)(ws + WS_MIXED);
    AttnW w; w.lds = (LAS char*)c.lds; w.lane = c.lane; w.wave = c.wave; w.r32 = c.lane & 31; w.hi = c.lane >> 5; w.hl = (c.wave < 4) ? (c.wave >> 1) : 3 - ((c.wave - 4) >> 1); w.qh = c.wave & 1;
    LAS float* pslc = (LAS float*)(w.lds + AT_PSLC); LAS unsigned* selm = (LAS unsigned*)(w.lds + AT_SEL);
    LAS unsigned* uni = (LAS unsigned*)(w.lds + AT_MISC); LAS float* ssq = (LAS float*)(w.lds + AT_MISC + 256); LAS unsigned short* ost = (LAS unsigned short*)(w.lds + AT_OST);
    const f32x16 zero16 = (f32x16){0,0,0,0,0,0,0,0,0,0,0,0,0,0,0,0};
    for (int uu = c.bid; uu < NB_ * 128; uu += c.nblk) {
        const int b = (uu >> 6) & 3, i = (uu < 256) ? (uu & 63) : 127 - (uu & 63);
        const int s0 = i * 64;
        for (int g = 0; g < NG; ++g) {
            { int ln = c.lane; asm volatile("" : "+v"(ln)); w.lane = ln; w.r32 = ln & 31; w.hi = ln >> 5; c.lane = ln; c.tid = c.wave * 64 + ln; }
            const int qq = 32 * w.qh + w.r32, t = s0 + qq; const size_t row = (size_t)b * T_ + t;
            const size_t bg = (size_t)b * NG + g; const int h = g * 4 + w.hl;
            const float slope2 = __builtin_amdgcn_exp2f(-(float)(h + 1)) * LOG2E;
            const bf16* KC = (const bf16*)(ws + MS_KCMP) + bg * 512 * 64; const bf16* VC = (const bf16*)(ws + MS_VCMP) + bg * 512 * 64;
            const bf16* KS = (const bf16*)(ws + WS_KV + 2 * KV_STRIDE) + bg * T_ * 64; const bf16* VS = (const bf16*)(ws + WS_KV + 3 * KV_STRIDE) + bg * T_ * 64;
            const bf16* KW = (const bf16*)(ws + WS_KV + 4 * KV_STRIDE) + bg * T_ * 64; const bf16* VW = (const bf16*)(ws + WS_KV + 5 * KV_STRIDE) + bg * T_ * 64;
            s16x8 qr[4];
#pragma unroll
            for (int d0 = 0; d0 < 4; ++d0) qr[d0] = *(const s16x8*)(Q + row * 512 + h * 64 + 16 * d0 + 8 * w.hi);
            const float g0 = GATE[row * 24 + h * 3 + 0], g1 = GATE[row * 24 + h * 3 + 1], g2 = GATE[row * 24 + h * 3 + 2];
            f32x16 oacc[2]; oacc[0] = zero16; oacc[1] = zero16;
            for (int e = c.tid; e < 64 * AT_PSLC_LD; e += NTHR) pslc[e] = 0.f;
            const int ntc = ((4 * i + 2) >> 6) + 1;
            const int limc = (t - 31) >> 4;
            const float lbc = slope2 * (float)(31 - t);
            float l = 0.f; f32x16 o[2]; o[0] = zero16; o[1] = zero16;
            u32x4 pw[4]; bool pend = false;
            const int tmin = s0 + 32 * w.qh;
            {
            __syncthreads();
            at_load_tile(w, KC, VC, 0); if (ntc > 1) at_load_tile(w, KC + 4096, VC + 4096, 1);
            for (int j = 0; j <= ntc; ++j) {
                AT_WAITBAR(j + 1 < ntc);
                if (j + 2 < ntc) at_load_tile(w, KC + (size_t)(j + 2) * 4096, VC + (size_t)(j + 2) * 4096, j + 2);
                const int dmc = tmin - (1024 * j + 1039);
                AT_STEP(j, ntc, (dmc <= 0 || slope2 * (float)dmc < AT_NEGL), at_bias_m<1>(w, slope2 * 16.f, lbc + slope2 * (float)(1024 * j), limc - 64 * j, p0, p1));
            }
            }
            float lt = l + shx(l, 32, w.lane); float il = lt > 0.f ? 1.f / lt : 0.f;
#pragma unroll
            for (int r = 0; r < 16; ++r) { oacc[0][r] += o[0][r] * (g0 * il); oacc[1][r] += o[1][r] * (g0 * il); }
            if (i >= 16) {
                LAS float* ilbuf = (LAS float*)selm;
                if (w.hi == 0) ilbuf[w.hl * 64 + qq] = il;
                const int hd = w.r32 >> 3, q2 = 8 * w.wave + (w.r32 & 7), t2 = s0 + q2; const size_t row2 = (size_t)b * T_ + t2;
                s16x8 qr2[4];
#pragma unroll
                for (int d0 = 0; d0 < 4; ++d0) qr2[d0] = *(const s16x8*)(Q + row2 * 512 + (g * 4 + hd) * 64 + 16 * d0 + 8 * w.hi);
                const float sl2 = __builtin_amdgcn_exp2f(-(float)(g * 4 + hd + 1)) * LOG2E, lbc2 = sl2 * (float)(31 - t2); const int limc2 = (t2 - 31) >> 4;
                __syncthreads();
                const float il2 = ilbuf[hd * 64 + q2];
                at_load_tile(w, KC, VC, 0); if (ntc > 1) at_load_tile(w, KC + 4096, VC + 4096, 1);
                for (int j = 0; j < ntc; ++j) {
                    AT_WAITBAR(j + 1 < ntc);
                    if (j + 2 < ntc) at_load_tile(w, KC + (size_t)(j + 2) * 4096, VC + (size_t)(j + 2) * 4096, j + 2);
                    f32x16 p0, p1; { s16x8 kf[8]; at_ldk(w, j, kf); at_bias_m<1>(w, sl2 * 16.f, lbc2 + sl2 * (float)(1024 * j), limc2 - 64 * j, p0, p1); AT_LGKM0(); at_qk(kf, qr2, p0, p1); }
                    float av[8], bv[8];
#pragma unroll
                    for (int q4 = 0; q4 < 4; ++q4) {
                        const float a0 = __builtin_amdgcn_exp2f(p0[4 * q4]) * il2, a1 = __builtin_amdgcn_exp2f(p0[4 * q4 + 1]) * il2, a2 = __builtin_amdgcn_exp2f(p0[4 * q4 + 2]) * il2, a3 = __builtin_amdgcn_exp2f(p0[4 * q4 + 3]) * il2;
                        av[q4] = 2.f * ((a0 + a1) + a2) + a3; bv[q4] = a3;
                        const float c0 = __builtin_amdgcn_exp2f(p1[4 * q4]) * il2, c1 = __builtin_amdgcn_exp2f(p1[4 * q4 + 1]) * il2, c2 = __builtin_amdgcn_exp2f(p1[4 * q4 + 2]) * il2, c3 = __builtin_amdgcn_exp2f(p1[4 * q4 + 3]) * il2;
                        av[4 + q4] = 2.f * ((c0 + c1) + c2) + c3; bv[4 + q4] = c3; }
#pragma unroll
                    for (int e = 0; e < 8; ++e) { av[e] += shx(av[e], 8, w.lane); av[e] += shx(av[e], 16, w.lane); bv[e] += shx(bv[e], 8, w.lane); bv[e] += shx(bv[e], 16, w.lane); }
                    if (hd == 0) {
                        LAS float* prow = pslc + q2 * AT_PSLC_LD + 16 * j + w.hi;
#pragma unroll
                        for (int e = 0; e < 8; ++e) { LAS float* p = prow + 8 * (e >> 2) + 2 * (e & 3); *p += av[e]; }
                        asm volatile("s_waitcnt lgkmcnt(0)" ::: "memory");
#pragma unroll
                        for (int e = 0; e < 8; ++e) { LAS float* p = prow + 8 * (e >> 2) + 2 * (e & 3) + 1; *p += bv[e]; }
                        asm volatile("s_waitcnt lgkmcnt(0)" ::: "memory");
                    }
                }
            }
            __syncthreads();
            if (i < 16) { if (c.tid < 64) { selm[c.tid * 4] = (1u << (i + 1)) - 1u; selm[c.tid * 4 + 1] = 0u; selm[c.tid * 4 + 2] = 0u; selm[c.tid * 4 + 3] = 0u; }
                if (c.tid < 4) uni[c.tid] = (c.tid == 0) ? ((1u << (i + 1)) - 1u) : 0u; }
            else {
                unsigned uw0 = 0u, uw1 = 0u, uw2 = 0u, uw3 = 0u;
                for (int qi = 0; qi < 8; ++qi) {
                    const int q = w.wave * 8 + qi; const int n0 = w.lane, n1 = w.lane + 64;
                    const bool c0 = (n0 >= 1 && n0 <= i - 2), c1 = (n1 <= i - 2);
                    const unsigned v0 = c0 ? __float_as_uint(pslc[q * AT_PSLC_LD + n0]) : 0u, v1 = c1 ? __float_as_uint(pslc[q * AT_PSLC_LD + n1]) : 0u;
                    unsigned T = 0u;
                    for (int bit = 30; bit >= 0; --bit) { const unsigned cand = T | (1u << bit);
                        const int cnt = __builtin_popcountll(__ballot(c0 && v0 >= cand)) + __builtin_popcountll(__ballot(c1 && v1 >= cand));
                        if (cnt >= 13) { T = cand; if (cnt == 13) break; } }
                    const unsigned long long gt0 = __ballot(c0 && v0 > T), gt1 = __ballot(c1 && v1 > T), eq0 = __ballot(c0 && v0 == T), eq1 = __ballot(c1 && v1 == T);
                    const int need = 13 - (__builtin_popcountll(gt0) + __builtin_popcountll(gt1));
                    const unsigned long long below = (w.lane == 0) ? 0ull : (~0ull >> (64 - w.lane));
                    const bool s0b = (c0 && v0 > T) || (c0 && v0 == T && __builtin_popcountll(eq0 & below) < need);
                    const bool s1b = (c1 && v1 > T) || (c1 && v1 == T && (__builtin_popcountll(eq0) + __builtin_popcountll(eq1 & below)) < need);
                    unsigned long long m0 = __ballot(s0b), m1 = __ballot(s1b);
                    m0 |= 1ull; { const int f1 = i - 1, f2 = i; if (f1 < 64) m0 |= 1ull << f1; else m1 |= 1ull << (f1 - 64); if (f2 < 64) m0 |= 1ull << f2; else m1 |= 1ull << (f2 - 64); }
                    if (w.lane == 0) { selm[q * 4] = (unsigned)m0; selm[q * 4 + 1] = (unsigned)(m0 >> 32); selm[q * 4 + 2] = (unsigned)m1; selm[q * 4 + 3] = (unsigned)(m1 >> 32); }
                    uw0 |= (unsigned)m0; uw1 |= (unsigned)(m0 >> 32); uw2 |= (unsigned)m1; uw3 |= (unsigned)(m1 >> 32);
                }
                if (w.lane == 0) { uni[4 + w.wave * 4] = uw0; uni[4 + w.wave * 4 + 1] = uw1; uni[4 + w.wave * 4 + 2] = uw2; uni[4 + w.wave * 4 + 3] = uw3; }
                __syncthreads();
                if (c.tid < 4) { unsigned u = 0u; for (int k = 0; k < 8; ++k) u |= uni[4 + k * 4 + c.tid]; uni[c.tid] = u; }
            }
            __syncthreads();
            unsigned um[4]; um[0] = uni[0]; um[1] = uni[1]; um[2] = uni[2]; um[3] = uni[3];
            const unsigned sm0 = selm[qq * 4], sm1 = selm[qq * 4 + 1], sm2 = selm[qq * 4 + 2], sm3 = selm[qq * 4 + 3];
            {
                l = 0.f; o[0] = zero16; o[1] = zero16;
                um[0] = __builtin_amdgcn_readfirstlane(um[0]); um[1] = __builtin_amdgcn_readfirstlane(um[1]); um[2] = __builtin_amdgcn_readfirstlane(um[2]); um[3] = __builtin_amdgcn_readfirstlane(um[3]);
                int wsel = 0; unsigned cur = um[0];
                auto next_blk = [&]() -> int { while (cur == 0u && wsel < 3) { ++wsel; cur = (wsel == 1) ? um[1] : (wsel == 2) ? um[2] : um[3]; }
                    if (cur == 0u) return -1; const int bpos = __builtin_ctz(cur); cur &= cur - 1u; return wsel * 32 + bpos; };
                int nb = next_blk(), nb1 = next_blk(), it = 0;
                __syncthreads();
                at_load_tile(w, KS + (size_t)nb * 4096, VS + (size_t)nb * 4096, 0);
                if (nb1 >= 0) at_load_tile(w, KS + (size_t)nb1 * 4096, VS + (size_t)nb1 * 4096, 1);
                for (;;) {
                    const int nb2 = (nb1 >= 0) ? next_blk() : -1;
                    AT_WAITBAR(nb1 >= 0);
                    if (nb2 >= 0) at_load_tile(w, KS + (size_t)nb2 * 4096, VS + (size_t)nb2 * 4096, it + 2);
                    const int nbc = nb < 0 ? 0 : nb;
                    const unsigned smw = (nbc < 32) ? sm0 : (nbc < 64) ? sm1 : (nbc < 96) ? sm2 : sm3;
                    const bool en = (smw >> (nbc & 31)) & 1u;
                    const float lb = en ? slope2 * (float)(64 * nbc - t) : NEG_BIG;
                    const int dms = tmin - (64 * nbc + 63);
                    AT_STEP(it, (nb >= 0 ? it + 1 : it), (dms <= 0 || slope2 * (float)dms < AT_NEGL), if (nb == i) at_bias_m<1>(w, slope2, lb, qq, p0, p1); else at_bias(w, slope2, lb, p0, p1));
                    if (nb < 0) break;
                    nb = nb1; nb1 = nb2; ++it;
                }
                lt = l + shx(l, 32, w.lane); il = lt > 0.f ? 1.f / lt : 0.f;
#pragma unroll
                for (int r = 0; r < 16; ++r) { oacc[0][r] += o[0][r] * (g1 * il); oacc[1][r] += o[1][r] * (g1 * il); }
            }
            {
                l = 0.f; o[0] = zero16; o[1] = zero16;
                const int j0 = (i >= 8) ? 0 : 8 - i;
                const bf16* KW0 = KW + (ptrdiff_t)(s0 - 512) * 64; const bf16* VW0 = VW + (ptrdiff_t)(s0 - 512) * 64;
                __syncthreads();
                at_load_tile(w, KW0 + (ptrdiff_t)j0 * 4096, VW0 + (ptrdiff_t)j0 * 4096, 0); if (j0 < 8) at_load_tile(w, KW0 + (ptrdiff_t)(j0 + 1) * 4096, VW0 + (ptrdiff_t)(j0 + 1) * 4096, 1);
                for (int j = j0; j <= 9; ++j) {
                    AT_WAITBAR(j < 8);
                    if (j + 2 <= 8) at_load_tile(w, KW0 + (ptrdiff_t)(j + 2) * 4096, VW0 + (ptrdiff_t)(j + 2) * 4096, j - j0 + 2);
                    const int dmw = 32 * w.qh + 449 - 64 * j;
                    AT_STEPM(j - j0, 9 - j0, (dmw <= 0 || slope2 * (float)dmw < AT_NEGL), at_bias(w, slope2, slope2 * (float)(64 * j - 512 - qq), p0, p1), if (j == 0) at_mask<2>(w, p0, p1, qq); else if (j == 8) at_mask<1>(w, p0, p1, qq));
                }
                lt = l + shx(l, 32, w.lane); il = lt > 0.f ? 1.f / lt : 0.f;
#pragma unroll
                for (int r = 0; r < 16; ++r) { oacc[0][r] += o[0][r] * (g2 * il); oacc[1][r] += o[1][r] * (g2 * il); }
            }
            {
                float sq = 0.f;
#pragma unroll
                for (int dh = 0; dh < 2; ++dh)
#pragma unroll
                    for (int r4 = 0; r4 < 4; ++r4) { const float x0 = oacc[dh][4 * r4], x1 = oacc[dh][4 * r4 + 1], x2 = oacc[dh][4 * r4 + 2], x3 = oacc[dh][4 * r4 + 3];
                        sq += (x0 * x0 + x1 * x1) + (x2 * x2 + x3 * x3);
                        u32x2 pk; pk.x = cvtpk(x0, x1); pk.y = cvtpk(x2, x3);
                        *(LAS u32x2*)(ost + qq * 512 + h * 64 + 32 * dh + 8 * r4 + 4 * w.hi) = pk; }
                sq += shx(sq, 32, w.lane);
                if (w.hi == 0) ssq[(g * 4 + w.hl) * 64 + qq] = sq;
            }
            __syncthreads();
        }
        {
            const int q = c.tid >> 3, part = c.tid & 7;
            float ss = 0.f;
#pragma unroll
            for (int k = 0; k < 8; ++k) ss += ssq[k * 64 + q];
            const float rs = __builtin_amdgcn_rsqf(ss * (1.f / 512.f) + RMS_EPS);
            bf16* orow = MIXED + ((size_t)b * T_ + s0 + q) * D_ + part * 64;
#pragma unroll
            for (int k = 0; k < 8; ++k) { const u32x4 v = *(const LAS u32x4*)(ost + q * 512 + part * 64 + 8 * k);
                u32x4 o4; o4.x = cvtpk(__uint_as_float(v.x << 16) * rs, __uint_as_float(v.x & 0xffff0000u) * rs); o4.y = cvtpk(__uint_as_float(v.y << 16) * rs, __uint_as_float(v.y & 0xffff0000u) * rs);
                o4.z = cvtpk(__uint_as_float(v.z << 16) * rs, __uint_as_float(v.z & 0xffff0000u) * rs); o4.w = cvtpk(__uint_as_float(v.w << 16) * rs, __uint_as_float(v.w & 0xffff0000u) * rs);
                *(u32x4*)(orow + 8 * k) = o4; }
        }
        __syncthreads();
    }
}

static_assert(AT_END <= LDS_WORK, "attention LDS map");
typedef float f32x4v __attribute__((ext_vector_type(4)));
__device__ __forceinline__ void phase_cmp_mfma(Ctx c, int L) {
    KArgs ka = kargs(); unsigned char* ws = CA_WS;
    LAS char* lds = (LAS char*)c.lds; LAS char* hidl = lds + 69632;
    LAS float* pbl = (LAS float*)(lds + 69632 + 8704);
    const int lane = c.lane, wv = c.wave, fr = lane & 15, fq = lane >> 4;
    for (int u = c.bid; u < 2 * NB_ * NG * 16; u += c.nblk) {
        const int kv = u >> 7, bg = (u >> 4) & 7, c0 = (u & 15) * 32;
        const bf16* RAW = (const bf16*)(ws + WS_KV + kv * KV_STRIDE) + ((size_t)bg * T_ + 16 * c0) * 64;
        const bf16* W1T = (const bf16*)(ws + WB_C1T) + ((size_t)L * 2 + kv) * CMP_HID * (L_CMP * HD); const bf16* W2T = (const bf16*)(ws + WB_C2T) + ((size_t)L * 2 + kv) * HD * CMP_HID;
        const float* PP = (const float*)(ws + WB_POSBP) + ((size_t)L * 2 + kv) * 32 * CMP_HID;
        bf16* OUT = (bf16*)(ws + (kv ? MS_VCMP : MS_KCMP)) + (size_t)bg * 512 * 64;
        __syncthreads();
        for (int e = c.tid; e < 528 * 8; e += NTHR) { const int tk = e >> 3, ch = e & 7; *(LAS u32x4*)(lds + tk * 128 + (tk >> 4) * 16 + ch * 16) = *(const u32x4*)(RAW + (size_t)tk * 64 + ch * 8); }
        if (c.tid < CMP_HID) { float a = 0.f; for (int k = 0; k < 32; ++k) a += PP[k * CMP_HID + c.tid]; pbl[c.tid] = a; }
        __syncthreads();
        f32x4v acc[2]; acc[0] = (f32x4v){0.f, 0.f, 0.f, 0.f}; acc[1] = acc[0];
        const bf16* wrow = W1T + (size_t)(16 * wv + fr) * (L_CMP * HD) + 8 * fq;
#pragma unroll 4
        for (int st = 0; st < 64; ++st) {
            const s16x8 bfr = *(const s16x8*)(wrow + 32 * st);
            const int tk = st >> 1, off = tk * 128 + (tk >> 4) * 16 + (32 * (st & 1) + 8 * fq) * 2;
#pragma unroll
            for (int rt = 0; rt < 2; ++rt) { const s16x8 afr = *(const LAS s16x8*)(lds + (16 * rt + fr) * 2064 + off);
                acc[rt] = __builtin_amdgcn_mfma_f32_16x16x32_bf16(afr, bfr, acc[rt], 0, 0, 0); }
        }
        { const float pb = pbl[16 * wv + fr];
#pragma unroll
          for (int rt = 0; rt < 2; ++rt)
#pragma unroll
              for (int i = 0; i < 4; ++i) *(LAS unsigned short*)(hidl + ((16 * rt + 4 * fq + i) * 136 + 16 * wv + fr) * 2) = f2bf(gelu_tanh(acc[rt][i] + pb)); }
        __syncthreads();
        { const int rt = wv & 1, ct = wv >> 1; f32x4v o = (f32x4v){0.f, 0.f, 0.f, 0.f};
#pragma unroll
          for (int st = 0; st < 4; ++st) { const s16x8 afr = *(const LAS s16x8*)(hidl + ((16 * rt + fr) * 136 + 32 * st + 8 * fq) * 2); const s16x8 bfr = *(const s16x8*)(W2T + (size_t)(16 * ct + fr) * CMP_HID + 32 * st + 8 * fq);
              o = __builtin_amdgcn_mfma_f32_16x16x32_bf16(afr, bfr, o, 0, 0, 0); }
#pragma unroll
          for (int i = 0; i < 4; ++i) { const int cr = c0 + 16 * rt + 4 * fq + i; OUT[(size_t)cr * 64 + 16 * ct + fr] = (cr < N_CMP) ? f2bf(o[i]) : (bf16)0; } }
    }
}

__device__ __forceinline__ void phase_moe_route(Ctx c, int stage) {
    KArgs ka = kargs();
    unsigned char* ws = CA_WS; int* TOPE = (int*)(ws + MS_TOPE); float* TOPG = (float*)(ws + MS_TOPG); int* UCNT = (int*)(ws + MS_UCNT);
    const float* RW = CA_IN(I_ROUTER_W); const float* gn = CA_IN(I_FFN_NORM) + 1 * D_;
    LAS int* cnt = (LAS int*)c.lds;
    for (int u = c.bid; u < 256; u += c.nblk) {
        if (c.tid < 16) cnt[c.tid] = 0;
        __syncthreads();
        for (int i = 0; i < 16; ++i) {
            const int m = u * 128 + c.wave * 16 + i;
            const float rs = row_rs(c.SSP, stage, m);
            float lg[8] = {0, 0, 0, 0, 0, 0, 0, 0};
            for (int j = 0; j < 16; ++j) { const int k = c.lane + 64 * j; const float hv = bf2f(c.XB[(size_t)m * D_ + k]) * rs * gn[k]; const f32x4 w0 = *(const f32x4*)(RW + (size_t)k * 8), w1 = *(const f32x4*)(RW + (size_t)k * 8 + 4);
                lg[0] = fmaf(hv, w0.x, lg[0]); lg[1] = fmaf(hv, w0.y, lg[1]); lg[2] = fmaf(hv, w0.z, lg[2]); lg[3] = fmaf(hv, w0.w, lg[3]);
                lg[4] = fmaf(hv, w1.x, lg[4]); lg[5] = fmaf(hv, w1.y, lg[5]); lg[6] = fmaf(hv, w1.z, lg[6]); lg[7] = fmaf(hv, w1.w, lg[7]); }
#pragma unroll
            for (int e = 0; e < 8; ++e) lg[e] = wave_sum(lg[e], c.lane);
            int e0 = 0; float l0 = lg[0];
#pragma unroll
            for (int e = 1; e < 8; ++e) if (lg[e] > l0) { l0 = lg[e]; e0 = e; }
            int e1 = -1; float l1 = -INFINITY;
#pragma unroll
            for (int e = 0; e < 8; ++e) if (e != e0 && lg[e] > l1) { l1 = lg[e]; e1 = e; }
            const float z = __expf(l1 - l0), g0 = 1.f / (1.f + z), g1 = z / (1.f + z);
            if (c.lane == 0) { TOPE[m * 2] = e0; TOPE[m * 2 + 1] = e1; TOPG[m * 2] = g0; TOPG[m * 2 + 1] = g1; __hip_atomic_fetch_add(&cnt[e0], 1, __ATOMIC_RELAXED, __HIP_MEMORY_SCOPE_WORKGROUP); __hip_atomic_fetch_add(&cnt[8 + e1], 1, __ATOMIC_RELAXED, __HIP_MEMORY_SCOPE_WORKGROUP); }
        }
        __syncthreads();
        if (c.tid < 16) UCNT[c.tid * 256 + u] = cnt[c.tid];
        __syncthreads();
    }
}
__device__ __forceinline__ int wave_sum_i(int v, int lane) {
#pragma unroll
    for (int o = 1; o < 64; o <<= 1) v += shxi(v, o, lane);
    return v;
}
__device__ __forceinline__ void phase_moe_slots(Ctx c, int stage) {
    KArgs ka = kargs();
    unsigned char* ws = CA_WS; const int* TOPE = (const int*)(ws + MS_TOPE); const float* TOPG = (const float*)(ws + MS_TOPG); const int* UCNT = (const int*)(ws + MS_UCNT);
    int* SLOT_TOK = (int*)(ws + MS_SLOTTOK); float* SLOT_G = (float*)(ws + MS_SLOTG); float* SLOT_RS = (float*)(ws + MS_SLOTRS); int* PANEL_E = (int*)(ws + MS_PANELE);
    LAS int* sh = (LAS int*)c.lds;
    typedef int i32x4 __attribute__((ext_vector_type(4)));
    i32x4 cv[2];
#pragma unroll
    for (int j = 0; j < 2; ++j) { cv[j] = *(const i32x4*)(UCNT + (c.wave + 8 * j) * 256 + 4 * c.lane); const int t = wave_sum_i((cv[j].x + cv[j].y) + (cv[j].z + cv[j].w), c.lane); if (c.lane == 0) sh[c.wave + 8 * j] = t; }
    __syncthreads();
    if (c.tid == 0) { int ps = 0; for (int e = 0; e < 16; ++e) { sh[16 + e] = ps; ps += (sh[e] + 255) / 256 * 256; } sh[48] = ps; }
    __syncthreads();
    for (int s2 = c.bid * NTHR + c.tid; s2 < NSLOT; s2 += c.nblk * NTHR) {
        int gi = 15; for (int k = 0; k < 16; ++k) { if (s2 >= sh[16 + k] && s2 < sh[16 + k] + (sh[k] + 255) / 256 * 256) { gi = k; break; } }
        const bool used = s2 < sh[48];
        const bool real = used && (s2 - sh[16 + gi]) < sh[gi];
        if (!real) { SLOT_TOK[s2] = -1; SLOT_G[s2] = 0.f; SLOT_RS[s2] = 0.f; }
        if ((s2 & 255) == 0) PANEL_E[s2 >> 8] = used ? (gi & 7) : -1;
    }
    if (c.bid == 0 && c.tid == 0) { PANEL_E[300] = sh[16 + 8] >> 8; PANEL_E[301] = sh[48] >> 8; }
    for (int u = c.bid; u < 256; u += c.nblk) {
        __syncthreads();
#pragma unroll
        for (int j = 0; j < 2; ++j) { const int u4 = 4 * c.lane; const int bsum = (u4 < u ? cv[j].x : 0) + (u4 + 1 < u ? cv[j].y : 0) + (u4 + 2 < u ? cv[j].z : 0) + (u4 + 3 < u ? cv[j].w : 0);
            const int t = wave_sum_i(bsum, c.lane); if (c.lane == 0) sh[32 + c.wave + 8 * j] = t; }
        int rank = 0, e = -1, k = 0, m = 0;
        if (c.wave < 4) { k = c.wave >> 1; m = u * 128 + (c.wave & 1) * 64 + c.lane; e = TOPE[m * 2 + k];
            const unsigned long long below = (c.lane == 0) ? 0ull : (~0ull >> (64 - c.lane));
#pragma unroll
            for (int e2 = 0; e2 < 8; ++e2) { const unsigned long long mk = __ballot(e == e2); if (e == e2) rank = __builtin_popcountll(mk & below); if (c.lane == 0) sh[64 + c.wave * 8 + e2] = __builtin_popcountll(mk); } }
        __syncthreads();
        if (c.wave < 4) { if (c.wave & 1) rank += sh[64 + (c.wave - 1) * 8 + e];
            const int gi = 8 * k + e, s2 = sh[16 + gi] + sh[32 + gi] + rank;
            SLOT_TOK[s2] = m; SLOT_G[s2] = TOPG[m * 2 + k] * (1.f / (W8_SCALE * ACT8_SCALE)); SLOT_RS[s2] = row_rs(c.SSP, stage, m) * (1.f / (W8_SCALE * X8_SCALE)); }
    }
}
constexpr int N_IN_PAD = 2560;
constexpr int TR_BUF = 8 * 264;
template <class AF>
__device__ __forceinline__ void tr_issue(AF ap, int k0, int n0, LAS float* buf, int lane) {
    const int r8 = lane >> 3, c4 = 4 * (lane & 7);
#pragma unroll
    for (int i = 0; i < 8; ++i) __builtin_amdgcn_global_load_lds((const unsigned*)ap(k0 + 8 * i + r8, n0 + c4), (LAS unsigned*)(buf + i * 264), 16, 0, 0);
}
#define TR_RD(dst, off) asm volatile("ds_read_b32 %0, %1 offset:" #off : "=v"(dst) : "v"(la))
template <bool F8, class CF>
__device__ __forceinline__ void tr_finish(const f32x4 g0, const f32x4 g1, CF cm, bf16* WT, int ldt, int k0, int n0, const LAS float* buf, int lane) {
    const int cch = lane & 7, nr = lane >> 3;
    const unsigned la = (unsigned)(size_t)(buf + cch * 264 + nr);
    float v[4][8];
    TR_RD(v[0][0], 0);  TR_RD(v[0][1], 128);  TR_RD(v[0][2], 256);  TR_RD(v[0][3], 384);  TR_RD(v[0][4], 512);  TR_RD(v[0][5], 640);  TR_RD(v[0][6], 768);  TR_RD(v[0][7], 896);
    TR_RD(v[1][0], 32); TR_RD(v[1][1], 160);  TR_RD(v[1][2], 288);  TR_RD(v[1][3], 416);  TR_RD(v[1][4], 544);  TR_RD(v[1][5], 672);  TR_RD(v[1][6], 800);  TR_RD(v[1][7], 928);
    TR_RD(v[2][0], 64); TR_RD(v[2][1], 192);  TR_RD(v[2][2], 320);  TR_RD(v[2][3], 448);  TR_RD(v[2][4], 576);  TR_RD(v[2][5], 704);  TR_RD(v[2][6], 832);  TR_RD(v[2][7], 960);
    TR_RD(v[3][0], 96); TR_RD(v[3][1], 224);  TR_RD(v[3][2], 352);  TR_RD(v[3][3], 480);  TR_RD(v[3][4], 608);  TR_RD(v[3][5], 736);  TR_RD(v[3][6], 864);  TR_RD(v[3][7], 992);
    asm volatile("s_waitcnt lgkmcnt(0)" ::: "memory"); __builtin_amdgcn_sched_barrier(0);
#pragma unroll
    for (int j = 0; j < 4; ++j) { const int n = nr + 8 * j; const float m = cm(n0 + n);
        if constexpr (F8) { int w0 = 0, w1 = 0;
            w0 = __builtin_amdgcn_cvt_pk_fp8_f32(g0.x * v[j][0] * m, g0.y * v[j][1] * m, w0, false); w0 = __builtin_amdgcn_cvt_pk_fp8_f32(g0.z * v[j][2] * m, g0.w * v[j][3] * m, w0, true);
            w1 = __builtin_amdgcn_cvt_pk_fp8_f32(g1.x * v[j][4] * m, g1.y * v[j][5] * m, w1, false); w1 = __builtin_amdgcn_cvt_pk_fp8_f32(g1.z * v[j][6] * m, g1.w * v[j][7] * m, w1, true);
            *(u32x2*)((unsigned char*)WT + (size_t)(n0 + n) * ldt + k0 + 8 * cch) = (u32x2){(unsigned)w0, (unsigned)w1}; }
        else {
        u32x4 o; o.x = pk2(g0.x * v[j][0] * m, g0.y * v[j][1] * m); o.y = pk2(g0.z * v[j][2] * m, g0.w * v[j][3] * m); o.z = pk2(g1.x * v[j][4] * m, g1.y * v[j][5] * m); o.w = pk2(g1.z * v[j][6] * m, g1.w * v[j][7] * m);
        *(u32x4*)(WT + (size_t)(n0 + n) * ldt + k0 + 8 * cch) = o; } }
}
#undef TR_RD
template <bool F8 = false, class AF, class GF, class CF>
__device__ __forceinline__ void transpose_matrix(Ctx& c, AF ap, GF gk, CF cm, bf16* WT, int K, int Nd, int& it0) {
    const int gw = c.bid * NWAVES + c.wave, NGW = c.nblk * NWAVES, nnb = Nd / 32, nkb = K / 64, nit = nkb * nnb;
    const bool grouped = (nnb % 8) == 0, kconst = grouped && (256 % nkb) == 0 && (NGW % 2048) == 0;
    LAS float* scr = c.lds + c.wave * (2 * TR_BUF);
    int it = (gw - it0 % NGW + NGW) % NGW, pb = 0; bool fst = true;
#define TR_DECODE(it_, k0_, n0_) do { if (grouped) { const int grp_ = (it_) >> 3; k0_ = 64 * (grp_ % nkb); n0_ = 32 * ((grp_ / nkb) * 8 + ((it_) & 7)); } else { k0_ = 64 * ((it_) / nnb); n0_ = 32 * ((it_) % nnb); } } while (0)
    f32x4 g0 = (f32x4){1.f, 1.f, 1.f, 1.f}, g1 = g0;
    if (it < nit) { int k0, n0; TR_DECODE(it, k0, n0);
        const float* gptr = gk(k0 + 8 * (c.lane & 7));
        if (gptr && kconst) { asm volatile("global_load_dwordx4 %0, %1, off" : "=v"(g0) : "v"(gptr)); asm volatile("global_load_dwordx4 %0, %1, off offset:16" : "=v"(g1) : "v"(gptr)); }
        tr_issue(ap, k0, n0, scr, c.lane); }
    while (it < nit) {
        int k0, n0; TR_DECODE(it, k0, n0); const int nx = it + NGW;
        if (nx < nit) { int k1, n1; TR_DECODE(nx, k1, n1); tr_issue(ap, k1, n1, scr + (pb ^ 1) * TR_BUF, c.lane);
            if (fst) asm volatile("s_waitcnt vmcnt(8)" ::: "memory"); else asm volatile("s_waitcnt vmcnt(12)" ::: "memory"); }
        else { if (fst) asm volatile("s_waitcnt vmcnt(0)" ::: "memory"); else asm volatile("s_waitcnt vmcnt(4)" ::: "memory"); }
        if (!kconst) { const float* gptr = gk(k0 + 8 * (c.lane & 7));
            if (gptr) { asm volatile("global_load_dwordx4 %0, %1, off" : "=v"(g0) : "v"(gptr)); asm volatile("global_load_dwordx4 %0, %1, off offset:16" : "=v"(g1) : "v"(gptr)); asm volatile("s_waitcnt vmcnt(0)" ::: "memory"); } }
        tr_finish<F8>(g0, g1, cm, WT, K, k0, n0, scr + pb * TR_BUF, c.lane);
        fst = false; it = nx; pb ^= 1;
    }
#undef TR_DECODE
    it0 += nit;
}
template <int PART>
__device__ __forceinline__ void phase_convert(Ctx c) {
    KArgs ka = kargs(); unsigned char* ws = CA_WS; int it0 = 0;
    auto one = [](int) { return 1.f; }; auto nog = [](int) { return (const float*)nullptr; };
    for (int L = 0; L < DEPTH; ++L) {
        if ((L == 0) == (PART == 0))
        { const float* W = CA_IN(I_W_IN) + (size_t)L * D_ * IN_COLS; const float* gn = CA_IN(I_ATTN_NORM) + L * D_;
          auto scol = [](int n) { return n < 1280 ? n : (n < 1792 ? C_XR + (n - 1280) : (n < 2304 ? C_YG + (n - 1792) : (n < 2328 ? C_G + (n - 2304) : -1))); };
          transpose_matrix(c, [=](int k, int n) { const int sc = scol(n); return W + (size_t)k * IN_COLS + (sc < 0 ? 0 : sc); }, [=](int k) { return gn + k; }, [=](int n) { return scol(n) < 0 ? 0.f : 1.f; },
                           (bf16*)(ws + WB_IN) + (size_t)L * N_IN_PAD * D_, D_, N_IN_PAD, it0); }
        if (PART == 1) {
        { const float* W = CA_IN(I_W_OUT) + (size_t)L * D_ * D_; const float* ga = CA_IN(I_OUT_NORM_ATTN) + L * 512; const float* gr = CA_IN(I_OUT_NORM_REC) + L * 512;
          transpose_matrix(c, [=](int k, int n) { return W + (size_t)k * D_ + n; }, [=](int k) { return k < 512 ? ga + k : gr + (k - 512); }, one, (bf16*)(ws + WB_OUT) + (size_t)L * D_ * D_, D_, D_, it0); }
        { const float* W = CA_IN(I_PLE_WG) + (size_t)L * D_ * D_; const float* gn = CA_IN(I_PLE_NORM) + L * D_;
          transpose_matrix(c, [=](int k, int n) { return W + (size_t)k * D_ + n; }, [=](int k) { return gn + k; }, one, (bf16*)(ws + WB_PLEG) + (size_t)L * D_ * D_, D_, D_, it0); }
        { const float* W = CA_IN(I_PLE_WP) + (size_t)L * PLE_DIM * D_;
          transpose_matrix(c, [=](int k, int n) { return W + (size_t)k * D_ + n; }, nog, one, (bf16*)(ws + WB_PLEP) + (size_t)L * D_ * PLE_DIM, PLE_DIM, D_, it0); }
        }
    }
    if (PART == 1) {
    { const float* WG = CA_IN(I_DENSE_WG); const float* WU = CA_IN(I_DENSE_WU); const float* gn = CA_IN(I_FFN_NORM);
      transpose_matrix(c, [=](int k, int n) { const int col = 128 * (n >> 8) + (n & 127); return ((n >> 7) & 1 ? WU : WG) + (size_t)k * D_FF + col; }, [=](int k) { return gn + k; }, one, (bf16*)(ws + WB_GU), D_, 2 * D_FF, it0); }
    { const float* WD = CA_IN(I_DENSE_WD);
      transpose_matrix<true>(c, [=](int k, int n) { return WD + (size_t)k * D_ + n; }, nog, [](int) { return W8_SCALE; }, (bf16*)(ws + WB_DN), D_FF, D_, it0); }
    { const float* WG = CA_IN(I_MOE_WG); const float* WU = CA_IN(I_MOE_WU); const float* gn = CA_IN(I_FFN_NORM) + D_;
      transpose_matrix<true>(c, [=](int k, int n) { const int e = n / (2 * D_FFE), nn = n % (2 * D_FFE), col = 128 * (nn >> 8) + (nn & 127); return ((nn >> 7) & 1 ? WU : WG) + (size_t)e * D_ * D_FFE + (size_t)k * D_FFE + col; },
                       [=](int k) { return gn + k; }, [](int) { return W8_SCALE; }, (bf16*)(ws + WB_MGU), D_, N_EXP * 2 * D_FFE, it0); }
    { const float* WD = CA_IN(I_MOE_WD);
      transpose_matrix<true>(c, [=](int k, int n) { const int e = n / D_, nn = n % D_; return WD + (size_t)e * D_FFE * D_ + (size_t)k * D_ + nn; }, nog, [](int) { return W8_SCALE; }, (bf16*)(ws + WB_MDN), D_FFE, N_EXP * D_, it0); }
    }
    if (PART == 0)
    for (int L = 0; L < DEPTH; ++L) {
        for (int kv = 0; kv < 2; ++kv) {
            const float* W1 = CA_IN(I_CMP_W1) + ((size_t)L * 2 + kv) * (L_CMP * HD) * CMP_HID; const float* W2 = CA_IN(I_CMP_W2) + ((size_t)L * 2 + kv) * CMP_HID * HD;
            transpose_matrix(c, [=](int k, int n) { return W1 + (size_t)k * CMP_HID + n; }, nog, one, (bf16*)(ws + WB_C1T) + ((size_t)L * 2 + kv) * CMP_HID * (L_CMP * HD), L_CMP * HD, CMP_HID, it0);
            transpose_matrix(c, [=](int k, int n) { return W2 + (size_t)k * HD + n; }, nog, one, (bf16*)(ws + WB_C2T) + ((size_t)L * 2 + kv) * HD * CMP_HID, CMP_HID, HD, it0);
        }
        for (int blk = 0; blk < 8; ++blk) {
            const float* WA = CA_IN(I_LRU_WA) + ((size_t)L * 8 + blk) * 4096; const float* WX = CA_IN(I_LRU_WX) + ((size_t)L * 8 + blk) * 4096;
            transpose_matrix(c, [=](int k, int n) { return WA + k * 64 + n; }, nog, one, (bf16*)(ws + WB_LWA) + ((size_t)L * 8 + blk) * 4096, 64, 64, it0);
            transpose_matrix(c, [=](int k, int n) { return WX + k * 64 + n; }, nog, one, (bf16*)(ws + WB_LWX) + ((size_t)L * 8 + blk) * 4096, 64, 64, it0);
        }
    }
    asm volatile("s_waitcnt vmcnt(0) lgkmcnt(0)" ::: "memory");
    if (PART == 0)
    { float* PP = (float*)(ws + WB_POSBP);
      for (int task = c.bid; task < DEPTH * 2 * 32; task += c.nblk) { const int lk = task >> 5, sl = task & 31;
          if (c.tid < CMP_HID) { const float* W1 = CA_IN(I_CMP_W1) + (size_t)lk * (L_CMP * HD) * CMP_HID + (size_t)sl * 64 * CMP_HID + c.tid; const float* POS = CA_IN(I_CMP_POS) + (size_t)lk * (L_CMP * HD) + sl * 64;
              float a = 0.f; for (int k = 0; k < 64; ++k) a = fmaf(POS[k], W1[(size_t)k * CMP_HID], a);
              PP[(size_t)task * CMP_HID + c.tid] = a; } } }
    if (PART == 1)
    { const float* P = CA_IN(I_P); bf16* PB = (bf16*)(ws + WS_PB); const size_t n8 = (size_t)DEPTH * NTOK * PLE_DIM / 8, step = (size_t)c.nblk * NTHR;
      for (size_t i = (size_t)c.bid * NTHR + c.tid; i < n8; i += 4 * step) {
          f32x4 a[4], b[4];
#pragma unroll
          for (int q = 0; q < 4; ++q) { a[q] = ((const f32x4*)P)[2 * (i + q * step)]; b[q] = ((const f32x4*)P)[2 * (i + q * step) + 1]; }
#pragma unroll
          for (int q = 0; q < 4; ++q) { u32x4 o; o.x = pk2(a[q].x, a[q].y); o.y = pk2(a[q].z, a[q].w); o.z = pk2(b[q].x, b[q].y); o.w = pk2(b[q].z, b[q].w); ((u32x4*)PB)[i + q * step] = o; } } }
}
static_assert(((size_t)DEPTH * NTOK * PLE_DIM / 8) % (4 * 256 * NTHR) == 0, "p cast loop");

__device__ __forceinline__ u32x4 pack8(const f32x4 a, const f32x4 b) { u32x4 w; w.x = pg8::cvt_pk_bf16(a[0], a[1]); w.y = pg8::cvt_pk_bf16(a[2], a[3]); w.z = pg8::cvt_pk_bf16(b[0], b[1]); w.w = pg8::cvt_pk_bf16(b[2], b[3]); return w; }
struct EpiInproj {
    static constexpr bool PERM = true, AFTER_DRAIN = false;
    const float* SSPs; unsigned char* ws;
    __device__ __forceinline__ void operator()(const f32x4 (&acc)[2][2][4][2], const pg8::Unit& u, int wr, int wc, int fr, int fq) const {
        const int row0 = u.pm * 256 + wr * 64 + fr, pn = u.pn, cw = wc * 32 + 8 * fq;
#pragma unroll
        for (int ai = 0; ai < 2; ++ai)
#pragma unroll
            for (int m = 0; m < 4; ++m) {
                const int r = row0 + ai * 128 + m * 16;
                const float rs = row_rs(SSPs, 0, r);
#pragma unroll
                for (int bj = 0; bj < 2; ++bj) {
                    f32x4 v0 = acc[ai][bj][m][0] * rs, v1 = acc[ai][bj][m][1] * rs;
                    if (pn < 2) { v0 = v0 * QSCALE; v1 = v1 * QSCALE; *(u32x4*)((bf16*)(ws + WS_Q) + (size_t)r * 512 + pn * 256 + bj * 128 + cw) = pack8(v0, v1); }
                    else if (pn < 5) { const int j = 2 * (pn - 2) + bj, g = cw >> 6, d = cw & 63, b = r / T_, t = r % T_;
                        *(u32x4*)((bf16*)(ws + WS_KV + j * KV_STRIDE) + (((size_t)b * NG + g) * T_ + t) * 64 + d) = pack8(v0, v1); }
                    else if (pn < 7) *(u32x4*)((bf16*)(ws + WS_XR) + (size_t)r * 512 + (pn - 5) * 256 + bj * 128 + cw) = pack8(v0, v1);
                    else if (pn < 9) *(u32x4*)((bf16*)(ws + WS_YG) + (size_t)r * 512 + (pn - 7) * 256 + bj * 128 + cw) = pack8(v0, v1);
                    else if (bj == 0 && cw < 24) { float* gp = (float*)(ws + WS_GATE) + (size_t)r * 24 + cw;
                        *(f32x4*)gp = (f32x4){sigmoidf_(v0[0]), sigmoidf_(v0[1]), sigmoidf_(v0[2]), sigmoidf_(v0[3])}; *(f32x4*)(gp + 4) = (f32x4){sigmoidf_(v1[0]), sigmoidf_(v1[1]), sigmoidf_(v1[2]), sigmoidf_(v1[3])}; }
                }
                asm volatile("" ::: "memory");
            }
    }
};
#define UNPK_LO(v_) ((f32x4){blo((v_).x), bhi((v_).x), blo((v_).y), bhi((v_).y)})
#define UNPK_HI(v_) ((f32x4){blo((v_).z), bhi((v_).z), blo((v_).w), bhi((v_).w)})
template <int MODE> struct EpiResid {
    static constexpr bool PERM = true, AFTER_DRAIN = false;
    const bf16* RIN; bf16* ROUT; float* SSPo; const float* SSPi; const bf16* PROJ;
    __device__ __forceinline__ void operator()(const f32x4 (&acc)[2][2][4][2], const pg8::Unit& u, int wr, int wc, int fr, int fq) const {
        const int row0 = u.pm * 256 + wr * 64 + fr, col0 = u.pn * 256 + wc * 32 + 8 * fq;
#pragma unroll
        for (int ai = 0; ai < 2; ++ai)
#pragma unroll
            for (int m = 0; m < 4; ++m) {
                const int r = row0 + ai * 128 + m * 16; float ss = 0.f; float rs = 1.f;
                if (MODE == 1) rs = row_rs(SSPi, 0, r);
#pragma unroll
                for (int bj = 0; bj < 2; ++bj) {
                    const size_t off = (size_t)r * D_ + col0 + bj * 128;
                    f32x4 a0 = acc[ai][bj][m][0], a1 = acc[ai][bj][m][1];
                    if (MODE == 1) { const u32x4 pw = *(const u32x4*)(PROJ + off);
                        a0 = (f32x4){sigmoidf_(a0[0] * rs) * __uint_as_float(pw.x << 16), sigmoidf_(a0[1] * rs) * __uint_as_float(pw.x & 0xffff0000u), sigmoidf_(a0[2] * rs) * __uint_as_float(pw.y << 16), sigmoidf_(a0[3] * rs) * __uint_as_float(pw.y & 0xffff0000u)};
                        a1 = (f32x4){sigmoidf_(a1[0] * rs) * __uint_as_float(pw.z << 16), sigmoidf_(a1[1] * rs) * __uint_as_float(pw.z & 0xffff0000u), sigmoidf_(a1[2] * rs) * __uint_as_float(pw.w << 16), sigmoidf_(a1[3] * rs) * __uint_as_float(pw.w & 0xffff0000u)}; }
                    const u32x4 xw = *(const u32x4*)(RIN + off);
                    const f32x4 x0 = UNPK_LO(xw) + a0, x1 = UNPK_HI(xw) + a1;
                    *(u32x4*)(ROUT + off) = pack8(x0, x1);
                    ss += ((x0[0] * x0[0] + x0[1] * x0[1]) + (x0[2] * x0[2] + x0[3] * x0[3])) + ((x1[0] * x1[0] + x1[1] * x1[1]) + (x1[2] * x1[2] + x1[3] * x1[3]));
                }
                { const int ln = fq * 16 + fr; ss += shx(ss, 16, ln); ss += shx(ss, 32, ln); }
                if (fq == 0) SSPo[(size_t)r * 16 + u.pn * 4 + wc] = ss;
                asm volatile("" ::: "memory");
            }
    }
};
template <> struct EpiResid<0> {
    static constexpr bool PERM = true, AFTER_DRAIN = false;
    const bf16* RIN; bf16* ROUT; float* SSPo; const float* SSPi; const bf16* PROJ; unsigned char* X8; float post;
    __device__ __forceinline__ void operator()(const f32x4 (&acc)[2][2][4][2], const pg8::Unit& u, int wr, int wc, int fr, int fq) const {
        const int row0 = u.pm * 256 + wr * 64 + fr, col0 = u.pn * 256 + wc * 32 + 8 * fq;
        u32x4 xb[2][2];
#pragma unroll
        for (int bj = 0; bj < 2; ++bj) xb[0][bj] = *(const u32x4*)(RIN + (size_t)row0 * D_ + col0 + bj * 128);
#pragma unroll
        for (int it = 0; it < 8; ++it) {
            const int ai = it >> 2, m = it & 3, r = row0 + ai * 128 + m * 16;
            if (it + 1 < 8) { const int rn = row0 + ((it + 1) >> 2) * 128 + ((it + 1) & 3) * 16;
#pragma unroll
                for (int bj = 0; bj < 2; ++bj) xb[(it + 1) & 1][bj] = *(const u32x4*)(RIN + (size_t)rn * D_ + col0 + bj * 128); }
            float ss = 0.f;
#pragma unroll
            for (int bj = 0; bj < 2; ++bj) {
                const size_t off = (size_t)r * D_ + col0 + bj * 128;
                const f32x4 x0 = UNPK_LO(xb[it & 1][bj]) + acc[ai][bj][m][0] * post, x1 = UNPK_HI(xb[it & 1][bj]) + acc[ai][bj][m][1] * post;
                *(u32x4*)(ROUT + off) = pack8(x0, x1);
                if (X8) { int w0 = 0, w1 = 0;
                    w0 = __builtin_amdgcn_cvt_pk_fp8_f32(x0[0] * X8_SCALE, x0[1] * X8_SCALE, w0, false); w0 = __builtin_amdgcn_cvt_pk_fp8_f32(x0[2] * X8_SCALE, x0[3] * X8_SCALE, w0, true);
                    w1 = __builtin_amdgcn_cvt_pk_fp8_f32(x1[0] * X8_SCALE, x1[1] * X8_SCALE, w1, false); w1 = __builtin_amdgcn_cvt_pk_fp8_f32(x1[2] * X8_SCALE, x1[3] * X8_SCALE, w1, true);
                    *(u32x2*)(X8 + off) = (u32x2){(unsigned)w0, (unsigned)w1}; }
                ss += ((x0[0] * x0[0] + x0[1] * x0[1]) + (x0[2] * x0[2] + x0[3] * x0[3])) + ((x1[0] * x1[0] + x1[1] * x1[1]) + (x1[2] * x1[2] + x1[3] * x1[3]));
            }
            { const int ln = fq * 16 + fr; ss += shx(ss, 16, ln); ss += shx(ss, 32, ln); }
            if (fq == 0) SSPo[(size_t)r * 16 + u.pn * 4 + wc] = ss;
            asm volatile("" ::: "memory");
        }
    }
};
template <bool F8> struct EpiSwiglu {
    static constexpr bool PERM = true, AFTER_DRAIN = false;
    bf16* ACT; int ldc; const float* SSPi; const float* ROWRS; float post;
    __device__ __forceinline__ void operator()(const f32x4 (&acc)[2][2][4][2], const pg8::Unit& u, int wr, int wc, int fr, int fq) const {
        const int row0 = u.pm * 256 + wr * 64 + fr, col0 = u.pn * 128 + wc * 32 + 8 * fq;
#pragma unroll
        for (int ai = 0; ai < 2; ++ai)
#pragma unroll
            for (int m = 0; m < 4; ++m) {
                const int r = row0 + ai * 128 + m * 16; const float rs = ROWRS ? ROWRS[r] : row_rs(SSPi, 0, r) * post;
                f32x4 o[2];
#pragma unroll
                for (int n = 0; n < 2; ++n) { const f32x4 g = acc[ai][0][m][n] * rs, up = acc[ai][1][m][n] * rs; o[n] = (f32x4){silu_(g[0]) * up[0], silu_(g[1]) * up[1], silu_(g[2]) * up[2], silu_(g[3]) * up[3]}; }
                if constexpr (F8) { int w0 = 0, w1 = 0;
#pragma unroll
                    for (int n = 0; n < 2; ++n)
#pragma unroll
                        for (int i = 0; i < 4; ++i) o[n][i] = __builtin_amdgcn_fmed3f(o[n][i] * ACT8_SCALE, -448.f, 448.f);
                    w0 = __builtin_amdgcn_cvt_pk_fp8_f32(o[0][0], o[0][1], w0, false); w0 = __builtin_amdgcn_cvt_pk_fp8_f32(o[0][2], o[0][3], w0, true);
                    w1 = __builtin_amdgcn_cvt_pk_fp8_f32(o[1][0], o[1][1], w1, false); w1 = __builtin_amdgcn_cvt_pk_fp8_f32(o[1][2], o[1][3], w1, true);
                    *(u32x2*)((unsigned char*)ACT + (size_t)r * ldc + col0) = (u32x2){(unsigned)w0, (unsigned)w1}; }
                else *(u32x4*)(ACT + (size_t)r * ldc + col0) = pack8(o[0], o[1]);
                asm volatile("" ::: "memory");
            }
    }
};
struct EpiPlain {
    static constexpr bool PERM = true, AFTER_DRAIN = false;
    bf16* O; int ldc;
    __device__ __forceinline__ void operator()(const f32x4 (&acc)[2][2][4][2], const pg8::Unit& u, int wr, int wc, int fr, int fq) const {
        const int row0 = u.pm * 256 + wr * 64 + fr, col0 = u.pn * 256 + wc * 32 + 8 * fq;
#pragma unroll
        for (int ai = 0; ai < 2; ++ai)
#pragma unroll
            for (int m = 0; m < 4; ++m)
#pragma unroll
                for (int bj = 0; bj < 2; ++bj) { *(u32x4*)(O + (size_t)(row0 + ai * 128 + m * 16) * ldc + col0 + bj * 128) = pack8(acc[ai][bj][m][0], acc[ai][bj][m][1]); asm volatile("" ::: "memory"); }
    }
};
#define GEMM_LDS(c) ((PG8_LAS unsigned char*)(c).lds)
struct SubOrder {
    pg8::StaticOrder S; int lo, hi;
    __device__ __forceinline__ bool next(int i, pg8::Unit& u) const { return (lo + i < hi) && S.next(lo + i, u); }
    __device__ __forceinline__ void a_ready(const pg8::Unit&) const {}
    __device__ __forceinline__ void done(const pg8::Unit&) const {}
};
__device__ __forceinline__ void phase_inproj_mfma(Ctx c, int L, int stage, int ulo = 0, int uhi = 1 << 20) {
    KArgs ka = kargs(); unsigned char* ws = CA_WS;
    pg8::Gemm g{(const pg8::bf16_t*)(L == 0 ? c.XB : c.XO),
 (const pg8::bf16_t*)((bf16*)(ws + WB_IN) + (size_t)L * N_IN_PAD * D_), NTOK, N_IN_PAD, D_, nullptr, 0, 0, 0}; pg8::StaticOrder S; S.init(NTOK, N_IN_PAD, c.nblk, c.bid);
    EpiInproj E{c.SSP + (size_t)stage * NTOK * 16, ws};
    SubOrder SS{S, ulo, uhi};
    pg8::gemm_phase<EpiInproj, SubOrder, true, true>(GEMM_LDS(c), g, SS, E, c.tid);
}
__device__ __forceinline__ void phase_outproj_mfma(Ctx c, int L, int stage_out) {
    KArgs ka = kargs(); unsigned char* ws = CA_WS;
    pg8::Gemm g{(const pg8::bf16_t*)(ws + WS_MIXED), (const pg8::bf16_t*)((bf16*)(ws + WB_OUT) + (size_t)L * D_ * D_), NTOK, D_, D_, nullptr, 0, 0, 0}; pg8::StaticOrder S; S.init(NTOK, D_, c.nblk, c.bid);
    EpiResid<0> E{(L == 0) ? c.XB : c.XO, c.XB, c.SSP + (size_t)stage_out * NTOK * 16, nullptr, nullptr, (L == 1) ? (unsigned char*)ka->out + X8_OFF : (unsigned char*)nullptr, 1.f};
    pg8::gemm_phase<EpiResid<0>, pg8::StaticOrder, true, true>(GEMM_LDS(c), g, S, E, c.tid);
}
__device__ __forceinline__ void phase_ffn_gu_mfma(Ctx c, int stage) {
    KArgs ka = kargs(); unsigned char* ws = CA_WS;
    pg8::Gemm g{(const pg8::bf16_t*)c.XB, (const pg8::bf16_t*)(ws + WB_GU), NTOK, 2 * D_FF, D_, nullptr, 0, 0, 0}; pg8::StaticOrder S; S.init(NTOK, 2 * D_FF, c.nblk, c.bid);
    EpiSwiglu<true> E{(bf16*)(ws + WS_ACT), D_FF, c.SSP + (size_t)stage * NTOK * 16, nullptr, 1.f};
    pg8::gemm_phase<EpiSwiglu<true>, pg8::StaticOrder, true, true>(GEMM_LDS(c), g, S, E, c.tid);
}
__device__ __forceinline__ void phase_ffn_dn_mfma(Ctx c, int stage_out) {
    KArgs ka = kargs(); unsigned char* ws = CA_WS;
    pg8::Gemm g{(const pg8::bf16_t*)(ws + WS_ACT), (const pg8::bf16_t*)(ws + WB_DN), NTOK, D_, D_FF / 2, nullptr, 0, 0, 0}; pg8::StaticOrder S; S.init(NTOK, D_, c.nblk, c.bid);
    EpiResid<0> E{c.XB, c.XB, c.SSP + (size_t)stage_out * NTOK * 16, nullptr, nullptr, nullptr, 1.f / (W8_SCALE * ACT8_SCALE)};
    pg8::gemm_phase<EpiResid<0>, pg8::StaticOrder, true, true, pg8::RowsIdent, true>(GEMM_LDS(c), g, S, E, c.tid);
}
__device__ __forceinline__ void phase_ple_proj_mfma(Ctx c, int L) {
    KArgs ka = kargs(); unsigned char* ws = CA_WS;
    pg8::Gemm g{(const pg8::bf16_t*)((bf16*)(ws + WS_PB) + (size_t)L * NTOK * PLE_DIM), (const pg8::bf16_t*)((bf16*)(ws + WB_PLEP) + (size_t)L * D_ * PLE_DIM), NTOK, D_, PLE_DIM, nullptr, 0, 0, 0}; pg8::StaticOrder S; S.init(NTOK, D_, c.nblk, c.bid);
    EpiPlain E{(bf16*)(ws + WS_PROJ), D_};
    pg8::gemm_phase<EpiPlain, pg8::StaticOrder, true, true>(GEMM_LDS(c), g, S, E, c.tid);
}
__device__ __forceinline__ void phase_ple_mfma(Ctx c, int L, int stage_in, int stage_out) {
    KArgs ka = kargs(); unsigned char* ws = CA_WS;
    pg8::Gemm g{(const pg8::bf16_t*)c.XB, (const pg8::bf16_t*)((bf16*)(ws + WB_PLEG) + (size_t)L * D_ * D_), NTOK, D_, D_, nullptr, 0, 0, 0}; pg8::StaticOrder S; S.init(NTOK, D_, c.nblk, c.bid);
    EpiResid<1> E{c.XB, (L + 1 < DEPTH) ? c.XO : (bf16*)(ws + WS_MIXED), c.SSP + (size_t)stage_out * NTOK * 16, c.SSP + (size_t)stage_in * NTOK * 16, (const bf16*)(ws + WS_PROJ)};
    pg8::gemm_phase<EpiResid<1>, pg8::StaticOrder, true, true>(GEMM_LDS(c), g, S, E, c.tid);
}

struct MoeOrder {
    pg8::StaticOrder S; int p_lo;
    __device__ __forceinline__ MoeOrder(int p_lo_, int np, int nN, int G, int c) : p_lo(p_lo_) { S.init(np * 256, nN * 256, G, c); }
    __device__ __forceinline__ bool next(int i, pg8::Unit& u) const { if (!S.next(i, u)) return false; u.pm += p_lo; return true; }
    __device__ __forceinline__ void a_ready(const pg8::Unit&) const {}
    __device__ __forceinline__ void done(const pg8::Unit&) const {}
};
template <bool LAST> struct EpiMoeDn {
    static constexpr bool PERM = true, AFTER_DRAIN = false;
    const bf16* RIN; bf16* ROUT; float* SSPo; const int* SLOT_TOK; const float* SLOT_G;
    __device__ __forceinline__ void operator()(const f32x4 (&acc)[2][2][4][2], const pg8::Unit& u, int wr, int wc, int fr, int fq) const {
        const int row0 = u.pm * 256 + wr * 64 + fr, col0 = u.pn * 256 + wc * 32 + 8 * fq, ln = fq * 16 + fr;
#pragma unroll
        for (int ai = 0; ai < 2; ++ai)
#pragma unroll
            for (int m = 0; m < 4; ++m) {
                const int r = row0 + ai * 128 + m * 16; const int tok = SLOT_TOK[r]; const float g = SLOT_G[r]; float ss = 0.f;
                if (tok >= 0) {
#pragma unroll
                    for (int bj = 0; bj < 2; ++bj) {
                        const size_t off = (size_t)tok * D_ + col0 + bj * 128;
                        const u32x4 xw = *(const u32x4*)(RIN + off);
                        const f32x4 x0 = UNPK_LO(xw) + acc[ai][bj][m][0] * g, x1 = UNPK_HI(xw) + acc[ai][bj][m][1] * g;
                        *(u32x4*)(ROUT + off) = pack8(x0, x1);
                        if (LAST) ss += ((x0[0] * x0[0] + x0[1] * x0[1]) + (x0[2] * x0[2] + x0[3] * x0[3])) + ((x1[0] * x1[0] + x1[1] * x1[1]) + (x1[2] * x1[2] + x1[3] * x1[3]));
                    }
                }
                if (LAST) { ss += shx(ss, 16, ln); ss += shx(ss, 32, ln); if (fq == 0 && tok >= 0) SSPo[(size_t)tok * 16 + u.pn * 4 + wc] = ss; }
                asm volatile("" ::: "memory");
            }
    }
};
__device__ __forceinline__ void phase_moe_gu_mfma(Ctx c, int k) {
    KArgs ka = kargs(); unsigned char* ws = CA_WS; const int* PANEL_E = (const int*)(ws + MS_PANELE);
    const int P0 = PANEL_E[300], PT = PANEL_E[301], p_lo = k ? P0 : 0, np = k ? PT - P0 : P0;
    pg8::Gemm g{(const pg8::bf16_t*)((unsigned char*)ka->out + X8_OFF), (const pg8::bf16_t*)(ws + WB_MGU), NSLOT, 2 * D_FFE, D_ / 2, PANEL_E, (size_t)2 * D_FFE * (D_ / 2), 0, 0};
    MoeOrder S(p_lo, np, 2 * D_FFE / 256, c.nblk, c.bid);
    EpiSwiglu<true> E{(bf16*)(ws + WS_ACT - (size_t)p_lo * 256 * D_FFE), D_FFE, nullptr, (const float*)(ws + MS_SLOTRS), 1.f};
    pg8::gemm_phase<EpiSwiglu<true>, MoeOrder, true, true, pg8::RowsGather, true>(GEMM_LDS(c), g, S, E, c.tid, pg8::RowsGather{(const int*)(ws + MS_SLOTTOK)});
}
struct TailOrder {
    int p_first, nunits, G, c;
    __device__ __forceinline__ bool next(int i, pg8::Unit& u) const { const int L = i * G + c; if (L >= nunits) return false; u.pm = p_first + L / (4 * DN_KSPLIT); u.pn = (L / DN_KSPLIT) & 3; u.kofs = (L % DN_KSPLIT) * DN_KSLICE_P; return true; }
    __device__ __forceinline__ void a_ready(const pg8::Unit&) const {}
    __device__ __forceinline__ void done(const pg8::Unit&) const {}
};
struct EpiPartial {
    static constexpr bool PERM = true, AFTER_DRAIN = false;
    float* PART; int p_first;
    __device__ __forceinline__ void operator()(const f32x4 (&acc)[2][2][4][2], const pg8::Unit& u, int wr, int wc, int fr, int fq) const {
        float* T = PART + (size_t)((((u.pm - p_first) * 4 + u.pn) * DN_KSPLIT) + u.kofs / DN_KSLICE_P) * 65536;
#pragma unroll
        for (int ai = 0; ai < 2; ++ai)
#pragma unroll
            for (int m = 0; m < 4; ++m)
#pragma unroll
                for (int bj = 0; bj < 2; ++bj) { float* p = T + (size_t)(ai * 128 + wr * 64 + m * 16 + fr) * 256 + bj * 128 + wc * 32 + 8 * fq; *(f32x4*)p = acc[ai][bj][m][0]; *(f32x4*)(p + 4) = acc[ai][bj][m][1]; asm volatile("" ::: "memory"); }
    }
};
template <bool LAST>
__device__ __forceinline__ void phase_moe_dn_mfma(Ctx c, int k, int stage_out) {
    KArgs ka = kargs(); unsigned char* ws = CA_WS; const int* PANEL_E = (const int*)(ws + MS_PANELE);
    const int P0 = PANEL_E[300], PT = PANEL_E[301], p_lo = k ? P0 : 0, np = k ? PT - P0 : P0;
    const int nmain = np < DN_MAIN_PANELS ? np : DN_MAIN_PANELS, ntail = np - nmain;
    const pg8::bf16_t* A = (const pg8::bf16_t*)(ws + WS_ACT - (size_t)p_lo * 256 * D_FFE);
    { pg8::Gemm g{A, (const pg8::bf16_t*)(ws + WB_MDN), NSLOT, D_, D_FFE / 2, PANEL_E, (size_t)D_ * (D_FFE / 2), 0, 0};
      MoeOrder S(p_lo, nmain, D_ / 256, c.nblk, c.bid);
      EpiMoeDn<LAST> E{LAST ? c.XO : c.XB, LAST ? c.XB : c.XO, c.SSP + (size_t)stage_out * NTOK * 16, (const int*)(ws + MS_SLOTTOK), (const float*)(ws + MS_SLOTG)};
      pg8::gemm_phase<EpiMoeDn<LAST>, MoeOrder, true, true, pg8::RowsIdent, true>(GEMM_LDS(c), g, S, E, c.tid); }
    if (ntail > 0) {
      pg8::Gemm g{A, (const pg8::bf16_t*)(ws + WB_MDN), NSLOT, D_, DN_KSLICE_P, PANEL_E, (size_t)D_ * (D_FFE / 2), D_FFE / 2, D_FFE / 2};
      TailOrder S{p_lo + nmain, ntail * 4 * DN_KSPLIT, c.nblk, c.bid};
      EpiPartial E{(float*)(ws + WS_PART), p_lo + nmain};
      pg8::gemm_phase<EpiPartial, TailOrder, true, true, pg8::RowsIdent, true>(GEMM_LDS(c), g, S, E, c.tid); }
}
template <bool LAST>
__device__ __forceinline__ void phase_moe_dn_reduce(Ctx c, int k, int stage_out) {
    KArgs ka = kargs(); unsigned char* ws = CA_WS; const int* PANEL_E = (const int*)(ws + MS_PANELE);
    const int P0 = PANEL_E[300], PT = PANEL_E[301], p_lo = k ? P0 : 0, np = k ? PT - P0 : P0;
    const int nmain = np < DN_MAIN_PANELS ? np : DN_MAIN_PANELS, ntail = np - nmain;
    const float* PART = (const float*)(ws + WS_PART); const int* SLOT_TOK = (const int*)(ws + MS_SLOTTOK); const float* SLOT_G = (const float*)(ws + MS_SLOTG);
    float* SSPo = c.SSP + (size_t)stage_out * NTOK * 16;
    const int gw = c.bid * NWAVES + c.wave, NGW = c.nblk * NWAVES, nitem = ntail * 4 * 256;
    for (int it = gw; it < nitem; it += NGW) {
        const int tt = it >> 8, r = it & 255, tp = tt >> 2, pn = tt & 3; const int slot = (p_lo + nmain + tp) * 256 + r; const int tok = SLOT_TOK[slot];
        if (tok < 0) continue;
        const float g = SLOT_G[slot];
        f32x4 y = (f32x4){0.f, 0.f, 0.f, 0.f};
#pragma unroll
        for (int ks = 0; ks < DN_KSPLIT; ++ks) y += *(const f32x4*)(PART + ((size_t)(tt * DN_KSPLIT + ks) * 256 + r) * 256 + 4 * c.lane);
        const size_t off = (size_t)tok * D_ + pn * 256 + 4 * c.lane;
        const u32x2 xw = *(const u32x2*)((LAST ? c.XO : c.XB) + off);
        const f32x4 x = (f32x4){blo(xw.x), bhi(xw.x), blo(xw.y), bhi(xw.y)} + y * g;
        { u32x2 w; w.x = pk2(x[0], x[1]); w.y = pk2(x[2], x[3]); *(u32x2*)((LAST ? c.XB : c.XO) + off) = w; }
        if (LAST) {
            float ss = (x[0] * x[0] + x[1] * x[1]) + (x[2] * x[2] + x[3] * x[3]);
            ss += shx(ss, 1, c.lane); ss += shx(ss, 2, c.lane); ss += shx(ss, 4, c.lane); ss += shx(ss, 8, c.lane);
            if ((c.lane & 15) == 0) SSPo[(size_t)tok * 16 + pn * 4 + (c.lane >> 4)] = ss; }
    }
}

__global__ void __launch_bounds__(NTHR, 2) fwd_kernel(Args args) {
    extern __shared__ __attribute__((aligned(16))) unsigned char lds_raw[];
    Ctx c; c.lds = (LAS float*)lds_raw; c.tid = threadIdx.x; c.lane = c.tid & 63; c.wave = __builtin_amdgcn_readfirstlane(c.tid >> 6); c.bid = blockIdx.x; c.nblk = gridDim.x;
    { KArgs k0 = kargs(); c.XO = (bf16*)k0->out; c.XB = (bf16*)(k0->ws + WS_XB); c.SSP = (float*)(k0->ws + WS_SSP); }
    volatile LAS unsigned* MISC = (volatile LAS unsigned*)((LAS unsigned char*)lds_raw + MISC_OFF);
    for (int u = c.tid; u < (LDS_BYTES - LDSCTL_OFF) / 4; u += NTHR) ((LAS unsigned*)((LAS unsigned char*)lds_raw + LDSCTL_OFF))[u] = 0u;
    __syncthreads();
    KArgs kb = kargs();
    (void)xcd_barrier_post((unsigned*)(kb->ws + WS_CTL) + CW_BAR, MISC + 8, c.tid == 0);
#define BAR() do { KArgs kq = kargs(); xcd_barrier((unsigned*)(kq->ws + WS_CTL) + CW_BAR, MISC + 8, c.wave); } while (0)
    { KArgs k1 = kargs(); phase_fix(fresh(c), k1->in[I_X], 0); phase_convert<0>(fresh(c)); } BAR();
    { constexpr int L = 0;

        constexpr int s0 = 3 * L;
        { const int kgap = c.bid % 6;
          phase_inproj_mfma(fresh(c), L, s0, 0, kgap); __syncthreads(); phase_convert<1>(fresh(c)); __syncthreads(); phase_inproj_mfma(fresh(c), L, s0, kgap, 1 << 20); } BAR();
        phase_cmp_mfma(fresh(c), L); __syncthreads(); phase_lru<false>(fresh(c), L); BAR();
        phase_attn_mfma(fresh(c)); __syncthreads(); phase_lru<true>(fresh(c), L); BAR();
        phase_outproj_mfma(fresh(c), L, s0 + 1); BAR();
        if (L == 0) {
            phase_ffn_gu_mfma(fresh(c), s0 + 1); BAR();
            phase_ffn_dn_mfma(fresh(c), s0 + 2); BAR();
        } else {
            phase_moe_route(fresh(c), s0 + 1); BAR(); phase_moe_slots(fresh(c), s0 + 1); BAR();
            phase_moe_gu_mfma(fresh(c), 0); BAR();
            phase_moe_dn_mfma<false>(fresh(c), 0, s0 + 2); BAR();
            phase_moe_dn_reduce<false>(fresh(c), 0, s0 + 2); phase_moe_gu_mfma(fresh(c), 1); BAR();
            phase_moe_dn_mfma<true>(fresh(c), 1, s0 + 2); BAR();
        }
        if (L == 1) phase_moe_dn_reduce<true>(fresh(c), 1, s0 + 2);
        phase_ple_proj_mfma(fresh(c), L); BAR();
        phase_ple_mfma(fresh(c), L, s0 + 2, s0 + 3); BAR();
    }
    { constexpr int L = 1;

        constexpr int s0 = 3 * L;
        phase_inproj_mfma(fresh(c), L, s0); BAR();
        phase_cmp_mfma(fresh(c), L); __syncthreads(); phase_lru<false>(fresh(c), L); BAR();
        phase_attn_mfma(fresh(c)); __syncthreads(); phase_lru<true>(fresh(c), L); BAR();
        phase_outproj_mfma(fresh(c), L, s0 + 1); BAR();
        if (L == 0) {
            phase_ffn_gu_mfma(fresh(c), s0 + 1); BAR();
            phase_ffn_dn_mfma(fresh(c), s0 + 2); BAR();
        } else {
            phase_moe_route(fresh(c), s0 + 1); BAR(); phase_moe_slots(fresh(c), s0 + 1); BAR();
            phase_moe_gu_mfma(fresh(c), 0); BAR();
            phase_moe_dn_mfma<false>(fresh(c), 0, s0 + 2); BAR();
            phase_moe_dn_reduce<false>(fresh(c), 0, s0 + 2); phase_moe_gu_mfma(fresh(c), 1); BAR();
            phase_moe_dn_mfma<true>(fresh(c), 1, s0 + 2); BAR();
        }
        if (L == 1) phase_moe_dn_reduce<true>(fresh(c), 1, s0 + 2);
        phase_ple_proj_mfma(fresh(c), L); BAR();
        phase_ple_mfma(fresh(c), L, s0 + 2, s0 + 3); BAR();
    }
    phase_final(fresh(c), 3 * DEPTH);
#undef BAR
}

extern "C" void kernel_launch(void* const* d_in, const int* in_sizes, int n_in, void* d_out, int out_size, void* d_ws, size_t ws_size, hipStream_t stream) {
    static int grid = 0;
    if (grid == 0) {
        if (n_in != N_IN || out_size != NTOK * D_ || ws_size < WS_NEED2) { fprintf(stderr, "kernel_launch: unexpected arguments (n_in %d, out %d, ws %zu < %zu)\n", n_in, out_size, ws_size, (size_t)WS_NEED2); grid = -1; return; }
        int dev = 0, cus = 0;
        if (hipGetDevice(&dev) != hipSuccess || hipDeviceGetAttribute(&cus, hipDeviceAttributeMultiprocessorCount, dev) != hipSuccess) { grid = -1; return; }
        if (hipFuncSetAttribute((const void*)fwd_kernel, hipFuncAttributeMaxDynamicSharedMemorySize, LDS_BYTES) != hipSuccess) { grid = -1; return; }
        int per_cu = 0;
        (void)hipOccupancyMaxActiveBlocksPerMultiprocessor(&per_cu, (const void*)fwd_kernel, NTHR, LDS_BYTES);
        (void)hipGetLastError();
        grid = cus;
    }
    if (grid < 0) return;
    (void)hipMemsetAsync((char*)d_ws + WS_CTL, 0, CTL_ZERO_BYTES, stream);
    Args a{};
    for (int i = 0; i < N_IN; ++i) a.in[i] = (const float*)d_in[i];
    a.out = (float*)d_out; a.ws = (unsigned char*)d_ws; a.li = 0; a.pad = 0;
    a.ph_lo = 0; a.ph_hi = 0;
    hipLaunchKernelGGL(fwd_kernel, dim3(grid), dim3(NTHR), LDS_BYTES, stream, a);
}
```

```cpp
#include <hip/hip_runtime.h>
#include <cstdio>
#include <cstdint>


#define GAS __attribute__((address_space(1)))
#define LAS __attribute__((address_space(3)))
typedef unsigned short bf16;
typedef float f32x4 __attribute__((ext_vector_type(4)));
typedef unsigned u32x4 __attribute__((ext_vector_type(4)));
typedef unsigned u32x2 __attribute__((ext_vector_type(2)));
typedef float f32x16 __attribute__((ext_vector_type(16)));
typedef short s16x8 __attribute__((ext_vector_type(8)));
typedef short s16x4 __attribute__((ext_vector_type(4)));

constexpr int NB_ = 4, T_ = 8192, D_ = 1024, NTOK = NB_ * T_;
constexpr int DEPTH = 2;
constexpr int NH = 8, HD = 64, NG = 2, HG = 4;
constexpr int D_ATTN = 512, D_REC = 512;
constexpr int L_CMP = 32, STRIDE = 16, L_SLC = 64, N_SEL = 16, W_WIN = 512;
constexpr int N_CMP = T_ / STRIDE - 1;
constexpr int N_SLC = T_ / L_SLC;
constexpr int CMP_HID = 128;
constexpr int IN_COLS = 2328;
constexpr int C_Q = 0, C_KC = 512, C_VC = 640, C_KS = 768, C_VS = 896, C_KW = 1024, C_VW = 1152, C_G = 1280, C_XR = 1304, C_YG = 1816;
constexpr int D_FF = 2816, N_EXP = 8, D_FFE = 3584;
constexpr int MOE_BLOCK = 256, N_PANEL = NTOK * 2 / MOE_BLOCK + 2 * N_EXP, NSLOT = N_PANEL * MOE_BLOCK;
constexpr int KPANEL_MAX = NTOK / MOE_BLOCK + N_EXP;
constexpr int PLE_DIM = 256;
constexpr float RMS_EPS = 1e-6f;
constexpr float LOG2E = 1.4426950408889634f;
constexpr float QSCALE = 0.125f * LOG2E;
constexpr int LRU_CHUNK = 128, LRU_NCH = T_ / LRU_CHUNK;
constexpr float W8_SCALE = 256.f, X8_SCALE = 8.f, ACT8_SCALE = 8.f;

constexpr size_t MiB = 1u << 20;
constexpr size_t WS_CTL = 0, CTL_ZERO_BYTES = 64 * 1024;
constexpr size_t WS_SSP = 1 * MiB;
constexpr size_t WS_MISC = 15 * MiB;
constexpr size_t WS_XB = 20 * MiB;
constexpr size_t WS_BIG = 84 * MiB;
constexpr size_t WS_Q = WS_BIG;
constexpr size_t WS_KV = WS_Q + 32 * MiB;
constexpr size_t KV_STRIDE = (size_t)NTOK * 128 * 2;
constexpr size_t WS_XR = WS_KV + 48 * MiB;
constexpr size_t WS_YG = WS_XR + 32 * MiB;
constexpr size_t WS_GATE = WS_YG + 32 * MiB;
constexpr size_t WS_MIXED = WS_GATE + 4 * MiB;
constexpr size_t WS_MIX_END = WS_MIXED + 64 * MiB;
constexpr size_t WS_ACT = WS_BIG;
constexpr size_t WS_PROJ = WS_BIG;
constexpr size_t MS_KCMP = WS_MISC;
constexpr size_t MS_VCMP = MS_KCMP + 512 * 1024;
constexpr size_t MS_LRUA = MS_VCMP + 512 * 1024;
constexpr size_t MS_LRUB = MS_LRUA + 512 * 1024;
constexpr size_t MS_TOPE = MS_LRUB + 512 * 1024;
constexpr size_t MS_TOPG = MS_TOPE + 256 * 1024;
constexpr size_t MS_UCNT = MS_TOPG + 256 * 1024;
constexpr size_t MS_SLOTTOK = MS_UCNT + 16 * 1024;
constexpr size_t MS_SLOTG = MS_SLOTTOK + 272 * 1024;
constexpr size_t MS_SLOTRS = MS_SLOTG + 272 * 1024;
constexpr size_t MS_PANELE = MS_SLOTRS + 272 * 1024;
constexpr size_t MS_END = MS_PANELE + 4096;
static_assert(MS_END <= WS_XB, "ws map");

constexpr size_t WS_W = 364 * MiB;
constexpr size_t WB_IN = WS_W, WB_OUT = WS_W + 10 * MiB, WB_GU = WS_W + 14 * MiB, WB_DN = WS_W + 25 * MiB, WB_PLEG = WS_W + 31 * MiB, WB_PLEP = WS_W + 35 * MiB, WB_END = WS_W + 36 * MiB;
constexpr size_t WS_PB = WB_END;
constexpr size_t WB_MGU = WS_PB + 32 * MiB;
constexpr size_t WB_MDN = WB_MGU + 112 * MiB;
constexpr size_t WS_NEED2 = WB_MDN + 56 * MiB;
constexpr size_t WS_SMALL = 324 * MiB;
constexpr size_t WB_C1T = WS_SMALL;
constexpr size_t WB_C2T = WB_C1T + 2 * MiB;
constexpr size_t WB_POSBP = WB_C2T + 64 * 1024;
constexpr size_t WB_LWA = WB_POSBP + 64 * 1024;
constexpr size_t WB_LWX = WB_LWA + 128 * 1024;
constexpr size_t WS_PART = 212 * MiB;
constexpr size_t X8_OFF = 64 * MiB;
constexpr int DN_MAIN_PANELS = 128, DN_KSPLIT = 7, DN_KSLICE = D_FFE / DN_KSPLIT, DN_KSLICE_P = DN_KSLICE / 2;
static_assert(WS_MIX_END <= WS_W, "BIG region vs weights");

constexpr int CW_BAR = 4096;

constexpr int LDS_BYTES = 161792;
constexpr int LDS_WORK = 160768;
constexpr int LDSCTL_OFF = LDS_WORK, MISC_OFF = LDSCTL_OFF + 320;
constexpr int NWAVES = 8, NTHR = 512;

__device__ __forceinline__ float bf2f(bf16 v) { return __uint_as_float(((unsigned)v) << 16); }
__device__ __forceinline__ unsigned pk2(float lo, float hi) { unsigned r; asm("v_cvt_pk_bf16_f32 %0, %1, %2" : "=v"(r) : "v"(lo), "v"(hi)); return r; }
__device__ __forceinline__ bf16 f2bf(float f) { return (bf16)pk2(f, f); }
__device__ __forceinline__ float blo(unsigned w) { return __uint_as_float(w << 16); }
__device__ __forceinline__ float bhi(unsigned w) { return __uint_as_float(w & 0xffff0000u); }
__device__ __forceinline__ float shx(float v, int o, int lane) { return __int_as_float(__builtin_amdgcn_ds_bpermute((lane ^ o) << 2, __float_as_int(v))); }
__device__ __forceinline__ int shxi(int v, int o, int lane) { return __builtin_amdgcn_ds_bpermute((lane ^ o) << 2, v); }
__device__ __forceinline__ float wave_sum(float v, int lane) {
#pragma unroll
    for (int o = 1; o < 64; o <<= 1) v += shx(v, o, lane);
    return v;
}
__device__ __forceinline__ float wave_max(float v, int lane) {
#pragma unroll
    for (int o = 1; o < 64; o <<= 1) v = fmaxf(v, shx(v, o, lane));
    return v;
}
__device__ __forceinline__ float sigmoidf_(float x) { return __builtin_amdgcn_rcpf(1.f + __expf(-x)); }
__device__ __forceinline__ float gelu_tanh(float x) { const float u = 0.7978845608028654f * (x + 0.044715f * x * x * x); return x * sigmoidf_(2.f * u); }
__device__ __forceinline__ float silu_(float x) { return x * sigmoidf_(x); }

#define XB_TMO      128
#define XB_XCNT(j)  (256  + 64 * (j))
#define XB_XSUB(j)  (1280 + 64 * (j))
#define XB_XGEN(j)  (2304 + 64 * (j))
#define XB_TOP      3328
#define XB_TOPGEN   3392
#define XCD_BAR_WORDS 3456
#define XB_SPIN_CAP (1u << 22)
__device__ __forceinline__ unsigned xb_ld(unsigned* p)              { return __hip_atomic_load(p, __ATOMIC_RELAXED, __HIP_MEMORY_SCOPE_AGENT); }
__device__ __forceinline__ unsigned xb_add(unsigned* p, unsigned v) { return __hip_atomic_fetch_add(p, v, __ATOMIC_RELAXED, __HIP_MEMORY_SCOPE_AGENT); }
__device__ __forceinline__ unsigned xb_xcc_id() { return (unsigned)__builtin_amdgcn_s_getreg((3 << 11) | 20) & 0xFu; }
#define XB_SPIN(cond, bar) do { unsigned _sp = 0; while (cond) { __builtin_amdgcn_s_sleep(1); \
    if ((++_sp & 255u) == 0u) { if (xb_ld(&(bar)[XB_TMO])) break; if (_sp > XB_SPIN_CAP) { atomicAdd(&(bar)[XB_TMO], 1u); break; } } } } while (0)
struct XcdBarrier { unsigned* bar; unsigned x; volatile LAS unsigned* st; };
__device__ __forceinline__ XcdBarrier xcd_barrier_post(unsigned* bar, volatile LAS unsigned* st, bool leader) {
    XcdBarrier b; b.bar = bar; b.x = (unsigned)__builtin_amdgcn_readfirstlane((int)xb_xcc_id()); b.st = st;
    if (leader) (void)xb_add(&bar[XB_XCNT(b.x)], 1u);
    return b;
}
__device__ __forceinline__ void xcd_barrier_complete(unsigned* bar, unsigned x, unsigned& nloc, unsigned& nx) {
    const unsigned G = gridDim.x * gridDim.y * gridDim.z;
    unsigned sum, cnt, mine, sp = 0u;
    for (;;) {
        sum = 0u; cnt = 0u; mine = 0u;
#pragma unroll
        for (unsigned j = 0; j < 16; ++j) { const unsigned c = xb_ld(&bar[XB_XCNT(j)]); sum += c; cnt += (c > 0u) ? 1u : 0u; mine = (j == x) ? c : mine; }
        if (sum == G) break;
        __builtin_amdgcn_s_sleep(1);
        if ((++sp & 255u) == 0u) { if (xb_ld(&bar[XB_TMO])) break; if (sp > XB_SPIN_CAP) { atomicAdd(&bar[XB_TMO], 1u); break; } }
    }
    nloc = mine > 0u ? mine : 1u; nx = cnt > 0u ? cnt : 1u;
}
__device__ __forceinline__ void xcd_barrier(unsigned* bar_in, volatile LAS unsigned* st_in, int wave) {
    XcdBarrier b; b.bar = bar_in; b.st = st_in; b.x = (unsigned)__builtin_amdgcn_readfirstlane((int)xb_xcc_id());
    asm volatile("s_waitcnt vmcnt(0)" ::: "memory");
    __syncthreads();
    if (wave == 0 && __builtin_amdgcn_mbcnt_hi(~0u, __builtin_amdgcn_mbcnt_lo(~0u, 0u)) == 0u) {
        unsigned* bar = b.bar;
        __builtin_amdgcn_s_waitcnt(0);
        unsigned nloc = b.st[0], nx = b.st[1];
        if (nloc == 0u) { xcd_barrier_complete(bar, b.x, nloc, nx); b.st[0] = nloc; b.st[1] = nx; }
        const unsigned old = xb_add(&bar[XB_XSUB(b.x)], 1u);
        const unsigned gen = old / nloc;
        if (old + 1u == (gen + 1u) * nloc) {
            __builtin_amdgcn_fence(__ATOMIC_RELEASE, "agent");
            asm volatile("s_waitcnt vmcnt(0)" ::: "memory");
            const unsigned og = xb_add(&bar[XB_TOP], 1u);
            const unsigned tg = og / nx;
            if (og + 1u == (tg + 1u) * nx) xb_add(&bar[XB_TOPGEN], 1u);
            else XB_SPIN(xb_ld(&bar[XB_TOPGEN]) == tg, bar);
            __builtin_amdgcn_fence(__ATOMIC_ACQUIRE, "agent");
            xb_add(&bar[XB_XGEN(b.x)], 1u);
            asm volatile("s_waitcnt vmcnt(0)" ::: "memory");
        } else {
            XB_SPIN(xb_ld(&bar[XB_XGEN(b.x)]) == gen, bar);
            __builtin_amdgcn_fence(__ATOMIC_ACQUIRE, "agent");
            asm volatile("s_waitcnt vmcnt(0)" ::: "memory");
        }
    }
    __syncthreads();
}

namespace pg8 {
#define PG8_LAS __attribute__((address_space(3)))
typedef unsigned short bf16_t;
typedef short bf16x8 __attribute__((ext_vector_type(8)));
typedef float f32x4 __attribute__((ext_vector_type(4)));
typedef unsigned u32x4 __attribute__((ext_vector_type(4)));
constexpr int BM = 256, BK = 64, HALF = 128, HTB = HALF * BK * 2  , STAGE_BYTES = 8 * HTB, NXCD = 8, WGM = 8;

__host__ __device__ __forceinline__ int lds_byte(int r, int c) { const int st = (r >> 4) * 2 + (c >> 5), rr = r & 15, cc = c & 31, ob = rr * 64 + cc * 2; return st * 1024 + (ob ^ (((ob >> 9) & 1) << 5)); }
__host__ __device__ __forceinline__ void stage_rc(int b, int& R, int& C) { const int st = b / 1024, sb = b % 1024, swz = sb ^ (((sb >> 9) & 1) << 5); R = (st >> 1) * 16 + swz / 64; C = (st & 1) * 32 + (swz % 64) / 2; }
__host__ __device__ __forceinline__ int perm32(int rho) { const int n = rho >> 4, i = rho & 15; return 8 * (i >> 2) + 4 * n + (i & 3); }

struct Unit { int pm, pn, kofs; };
struct Gemm { const bf16_t* A; const bf16_t* Bt; int M, N, K; const int* panel_e; size_t e_stride; int lda, ldb; };
struct RowsIdent { static constexpr bool GATHER = false; __device__ __forceinline__ unsigned row(int r) const { return (unsigned)r; } };
struct RowsGather { const int* map; static constexpr bool GATHER = true; __device__ __forceinline__ unsigned row(int r) const { const int t = map[r]; return (unsigned)(t < 0 ? 0 : t); } };

struct StaticOrder {
    int nM, nN, nwg, G, c;
    __host__ __device__ void init(int M, int N, int G_, int c_) { nM = M / BM; nN = N / BM; nwg = nM * nN; G = G_; c = c_; }
    __host__ __device__ bool next(int i, Unit& u) const {
        const long L = (long)i * G + c; if (L >= nwg) return false;
        int wgid = (int)L; { const int q = nwg / NXCD, r = nwg % NXCD, xcd = wgid % NXCD, off = wgid / NXCD; wgid = (xcd < r ? xcd * (q + 1) : r * (q + 1) + (xcd - r) * q) + off; }
        const int nig = WGM * nN, gid = wgid / nig, fm = gid * WGM, gsz = (nM - fm) < WGM ? (nM - fm) : WGM;
        u.pm = fm + ((wgid % nig) % gsz); u.pn = (wgid % nig) / gsz; u.kofs = 0; return true;
    }
    __device__ __forceinline__ void a_ready(const Unit&) const {}
    __device__ __forceinline__ void done(const Unit&) const {}
};

typedef int i32x8 __attribute__((ext_vector_type(8)));
typedef int i32x4 __attribute__((ext_vector_type(4)));
__device__ __forceinline__ unsigned cvt_pk_bf16(float lo, float hi) { unsigned r; asm volatile("v_cvt_pk_bf16_f32 %0, %1, %2" : "=v"(r) : "v"(lo), "v"(hi)); return r; }
template <class Epi, class Sched, bool ALIGN_EPI = false, bool SP2 = false, class AMap = RowsIdent, bool FP8 = false>
__device__ __forceinline__ void gemm_phase(PG8_LAS unsigned char* lds, const Gemm g, const Sched& S, const Epi& E, int tid_in, const AMap AM = AMap()) {
    int tid_ = tid_in; asm volatile("" : "+v"(tid_));
    const int tid = tid_, wid = __builtin_amdgcn_readfirstlane(tid >> 6), lane = tid & 63, wr = wid >> 2, wc = wid & 3, fr = lane & 15, fq = lane >> 4;
    int K_ = g.K; asm volatile("" : "+s"(K_));
    const int K = K_, nt = K / BK, lda = g.lda ? g.lda : K_, ldb = g.ldb ? g.ldb : K_;
    unsigned voffB[2]; int RA[2], CA2[2];
#pragma unroll
    for (int i = 0; i < 2; ++i) { int R, C; stage_rc(tid * 16 + i * 8192, R, C); const int Rb = Epi::PERM ? ((R & ~31) + perm32(R & 31)) : R;
        RA[i] = R; CA2[i] = C * 2; voffB[i] = (unsigned)(Rb * ldb + C) * 2u; }
    unsigned voC[2][2], voN[2][2];
#define PG8_CALCA(vo, pm_, ko_) do { _Pragma("unroll") for (int h_ = 0; h_ < 2; ++h_) _Pragma("unroll") for (int i_ = 0; i_ < 2; ++i_) \
        vo[h_][i_] = AM.row((pm_) * BM + h_ * HALF + RA[i_]) * (unsigned)(lda * 2) + (unsigned)(CA2[i_] + 2 * (ko_)); } while (0)
    const size_t kstep = (size_t)(BK * 2);
    const size_t hstep = (size_t)HALF * ldb * 2;
    const size_t tstep = 2 * hstep;
    const unsigned ldsw = (unsigned)wid * 1024u;
    const int aoff = lds_byte(wr * 64 + fr, fq * 8), boff = lds_byte(wc * 32 + fr, fq * 8);
#define PG8_SA(b, h) (((b) * 2 + (h)) * HTB)
#define PG8_SB(b, h) ((4 + (b) * 2 + (h)) * HTB)
#define PG8_STAGE(bufoff, gbase, voff) do { _Pragma("unroll") for (int _i = 0; _i < 2; ++_i) \
        __builtin_amdgcn_global_load_lds((const unsigned*)((const char*)(gbase) + (voff)[_i]), (PG8_LAS unsigned*)(lds + (bufoff) + ldsw + _i * 8192), 16, 0, 0); } while (0)
#define PG8_LDA(dst, b, h) do { _Pragma("unroll") for (int m = 0; m < 4; ++m) { if constexpr (FP8) { dst##8[m].lo = *(const PG8_LAS i32x4*)(lds + PG8_SA(b, h) + aoff + m * 2048); dst##8[m].hi = *(const PG8_LAS i32x4*)(lds + PG8_SA(b, h) + aoff + m * 2048 + 1024); } \
        else { _Pragma("unroll") for (int k = 0; k < 2; ++k) dst[m][k] = *(const PG8_LAS bf16x8*)(lds + PG8_SA(b, h) + aoff + m * 2048 + k * 1024); } } } while (0)
#define PG8_LDB(dst, b, h) do { _Pragma("unroll") for (int n = 0; n < 2; ++n) { if constexpr (FP8) { dst##8[n].lo = *(const PG8_LAS i32x4*)(lds + PG8_SB(b, h) + boff + n * 2048); dst##8[n].hi = *(const PG8_LAS i32x4*)(lds + PG8_SB(b, h) + boff + n * 2048 + 1024); } \
        else { _Pragma("unroll") for (int k = 0; k < 2; ++k) dst[n][k] = *(const PG8_LAS bf16x8*)(lds + PG8_SB(b, h) + boff + n * 2048 + k * 1024); } } } while (0)
#define PG8_MMA(ai, bj, At, Bt) do { __builtin_amdgcn_s_setprio(1); _Pragma("unroll") for (int m = 0; m < 4; ++m) _Pragma("unroll") for (int n = 0; n < 2; ++n) { \
        if constexpr (FP8) asm volatile("v_mfma_f32_16x16x128_f8f6f4 %0, %1, %2, %0" : "+v"(acc[ai][bj][m][n]) : "v"(Bt##8[n]), "v"(At##8[m]));   \
        else { _Pragma("unroll") for (int k = 0; k < 2; ++k) acc[ai][bj][m][n] = __builtin_amdgcn_mfma_f32_16x16x32_bf16(Bt[n][k], At[m][k], acc[ai][bj][m][n], 0, 0, 0); } } __builtin_amdgcn_s_setprio(0); } while (0)
#define PG8_WAIT_V(n) asm volatile("s_waitcnt vmcnt(" #n ")" ::: "memory")
#define PG8_WAIT_L(n) asm volatile("s_waitcnt lgkmcnt(" #n ")" ::: "memory")
#define PG8_BAR __builtin_amdgcn_s_barrier()
#define PG8_SCHED __builtin_amdgcn_sched_barrier(0)
    Unit cur, nxt; int ui = 0;
    if (!S.next(0, cur)) return;
    f32x4 acc[2][2][4][2];
#pragma unroll
    for (int a = 0; a < 2; ++a)
#pragma unroll
        for (int b = 0; b < 2; ++b)
#pragma unroll
            for (int m = 0; m < 4; ++m)
#pragma unroll
                for (int n = 0; n < 2; ++n) acc[a][b][m][n] = (f32x4){0.f, 0.f, 0.f, 0.f};
    bf16x8 At[4][2], B0[2][2], B1[2][2];
    i32x8 At8[4], B08[2], B18[2];
    const char* const Ab = (const char*)g.A;
#define PG8_BBASE(u_) ((const char*)g.Bt + (g.panel_e ? (size_t)g.panel_e[(u_).pm] * g.e_stride * 2 : (size_t)0) + (size_t)(u_).pn * tstep + (size_t)(u_).kofs * 2)
    const char* cB = PG8_BBASE(cur); PG8_CALCA(voC, cur.pm, cur.kofs);
    S.a_ready(cur);
    if constexpr (SP2) {
        PG8_STAGE(PG8_SB(0, 0), cB, voffB); PG8_STAGE(PG8_SB(0, 1), cB + hstep, voffB); PG8_STAGE(PG8_SA(0, 0), Ab, voC[0]); PG8_STAGE(PG8_SA(0, 1), Ab, voC[1]);
        if (wr == 1) PG8_BAR;
        PG8_WAIT_V(2); PG8_BAR;
        PG8_STAGE(PG8_SB(1, 0), cB + kstep, voffB); PG8_STAGE(PG8_SA(1, 0), Ab + kstep, voC[0]); PG8_STAGE(PG8_SB(1, 1), cB + hstep + kstep, voffB);
        PG8_WAIT_V(6); PG8_BAR;
    } else {
        PG8_STAGE(PG8_SB(0, 0), cB, voffB); PG8_STAGE(PG8_SA(0, 0), Ab, voC[0]); PG8_STAGE(PG8_SB(0, 1), cB + hstep, voffB); PG8_STAGE(PG8_SA(0, 1), Ab, voC[1]);
        if (wr == 1) PG8_BAR;
        PG8_WAIT_V(4); PG8_BAR;
        PG8_STAGE(PG8_SB(1, 0), cB + kstep, voffB); PG8_STAGE(PG8_SA(1, 0), Ab + kstep, voC[0]); PG8_STAGE(PG8_SB(1, 1), cB + hstep + kstep, voffB);
        PG8_WAIT_V(6); PG8_BAR;
    }
    for (;;) {
        const bool has_next = S.next(ui + 1, nxt);
        const char* nB = has_next ? PG8_BBASE(nxt) : cB;
        if (has_next) { PG8_CALCA(voN, nxt.pm, nxt.kofs); } else {
#pragma unroll
            for (int h_ = 0; h_ < 2; ++h_)
#pragma unroll
                for (int i_ = 0; i_ < 2; ++i_) voN[h_][i_] = voC[h_][i_]; }
        for (int t = 0; t < nt; t += 2) {
            const bool last = (t == nt - 2);
            const char* a1 = Ab + (size_t)(t + 1) * kstep;
            const char* a2 = last ? Ab : Ab + (size_t)(t + 2) * kstep; const char* b2 = last ? nB : cB + (size_t)(t + 2) * kstep;
            const char* a3 = a2 + kstep; const char* b3 = b2 + kstep;
            unsigned vo2[2][2];
#pragma unroll
            for (int h_ = 0; h_ < 2; ++h_)
#pragma unroll
                for (int i_ = 0; i_ < 2; ++i_) vo2[h_][i_] = last ? voN[h_][i_] : voC[h_][i_];
            if (last && has_next) S.a_ready(nxt);
            if constexpr (SP2) {
            PG8_LDB(B0, 0, 0); PG8_LDB(B1, 0, 1); PG8_SCHED; PG8_LDA(At, 0, 0); PG8_STAGE(PG8_SA(1, 1), a1, voC[1]);
            PG8_WAIT_V(8); PG8_WAIT_L(0); PG8_BAR; PG8_MMA(0, 0, At, B0); PG8_MMA(0, 1, At, B1); PG8_BAR; PG8_SCHED;
            PG8_LDA(At, 0, 1); PG8_STAGE(PG8_SB(0, 0), b2, voffB); PG8_STAGE(PG8_SB(0, 1), b2 + hstep, voffB); PG8_STAGE(PG8_SA(0, 0), a2, vo2[0]);
            PG8_WAIT_V(8); PG8_WAIT_L(0); PG8_BAR; PG8_MMA(1, 0, At, B0); PG8_MMA(1, 1, At, B1); PG8_BAR; PG8_SCHED;
            PG8_LDB(B0, 1, 0); PG8_LDB(B1, 1, 1); PG8_SCHED; PG8_LDA(At, 1, 0); PG8_STAGE(PG8_SA(0, 1), a2, vo2[1]);
            PG8_WAIT_V(8); PG8_WAIT_L(0); PG8_BAR; PG8_MMA(0, 0, At, B0); PG8_MMA(0, 1, At, B1); PG8_BAR; PG8_SCHED;
            PG8_LDA(At, 1, 1); PG8_STAGE(PG8_SB(1, 0), b3, voffB); PG8_STAGE(PG8_SB(1, 1), b3 + hstep, voffB); PG8_STAGE(PG8_SA(1, 0), a3, vo2[0]);
            PG8_WAIT_V(8); PG8_WAIT_L(0); PG8_BAR; PG8_MMA(1, 0, At, B0); PG8_MMA(1, 1, At, B1); PG8_BAR; PG8_SCHED;
            } else {
            PG8_LDB(B0, 0, 0); PG8_SCHED; PG8_LDA(At, 0, 0); PG8_STAGE(PG8_SA(1, 1), a1, voC[1]);
            PG8_WAIT_L(8); PG8_BAR; PG8_WAIT_L(0); PG8_MMA(0, 0, At, B0); PG8_BAR; PG8_SCHED;
            PG8_LDB(B1, 0, 1); PG8_STAGE(PG8_SB(0, 0), b2, voffB);
            PG8_BAR; PG8_WAIT_L(0); PG8_MMA(0, 1, At, B1); PG8_BAR;
            PG8_LDA(At, 0, 1); PG8_STAGE(PG8_SA(0, 0), a2, vo2[0]);
            PG8_BAR; PG8_WAIT_L(0); PG8_MMA(1, 0, At, B0); PG8_BAR; PG8_SCHED;
            PG8_STAGE(PG8_SB(0, 1), b2 + hstep, voffB);
            PG8_WAIT_V(6); PG8_BAR; PG8_MMA(1, 1, At, B1); PG8_BAR;
            PG8_LDB(B0, 1, 0); PG8_SCHED; PG8_LDA(At, 1, 0); PG8_STAGE(PG8_SA(0, 1), a2, vo2[1]);
            PG8_WAIT_L(8); PG8_BAR; PG8_WAIT_L(0); PG8_MMA(0, 0, At, B0); PG8_BAR; PG8_SCHED;
            PG8_LDB(B1, 1, 1); PG8_STAGE(PG8_SB(1, 0), b3, voffB);
            PG8_BAR; PG8_WAIT_L(0); PG8_MMA(0, 1, At, B1); PG8_BAR;
            PG8_LDA(At, 1, 1); PG8_STAGE(PG8_SA(1, 0), a3, vo2[0]);
            PG8_BAR; PG8_WAIT_L(0); PG8_MMA(1, 0, At, B0); PG8_BAR; PG8_SCHED;
            PG8_STAGE(PG8_SB(1, 1), b3 + hstep, voffB);
            PG8_WAIT_V(6); PG8_BAR; PG8_MMA(1, 1, At, B1); PG8_BAR;
            }
        }
        if constexpr (FP8) asm volatile("s_nop 15\n\ts_nop 15" ::: "memory");
        if constexpr (ALIGN_EPI) { if (wr == 0) PG8_BAR; }
        if constexpr (!Epi::AFTER_DRAIN) { E(acc, cur, wr, wc, fr, fq); S.done(cur); }
        if (!has_next) break;
#pragma unroll
        for (int a = 0; a < 2; ++a)
#pragma unroll
            for (int b = 0; b < 2; ++b)
#pragma unroll
                for (int m = 0; m < 4; ++m)
#pragma unroll
                    for (int n = 0; n < 2; ++n) acc[a][b][m][n] = (f32x4){0.f, 0.f, 0.f, 0.f};
        cur = nxt; cB = nB; ++ui;
#pragma unroll
        for (int h_ = 0; h_ < 2; ++h_)
#pragma unroll
            for (int i_ = 0; i_ < 2; ++i_) voC[h_][i_] = voN[h_][i_];
        if constexpr (ALIGN_EPI) { if (wr == 1) PG8_BAR; }
    }
    PG8_WAIT_V(0);
    if constexpr (!ALIGN_EPI) { if (wr == 0) PG8_BAR; }
    PG8_BAR;
    if constexpr (Epi::AFTER_DRAIN) { E.fused(acc, cur, wr, wc, fr, fq, lds, wid, lane); S.done(cur); }
#undef PG8_CALCA
#undef PG8_BBASE
#undef PG8_SA
#undef PG8_SB
#undef PG8_STAGE
#undef PG8_LDA
#undef PG8_LDB
#undef PG8_MMA
#undef PG8_WAIT_V
#undef PG8_WAIT_L
#undef PG8_BAR
#undef PG8_SCHED
}
}

enum { I_X = 0, I_P, I_ATTN_NORM, I_W_IN, I_CMP_POS, I_CMP_W1, I_CMP_W2, I_CONV_W, I_CONV_B, I_LRU_WA, I_LRU_BA, I_LRU_WX, I_LRU_BX, I_LRU_LAMBDA,
       I_OUT_NORM_ATTN, I_OUT_NORM_REC, I_W_OUT, I_FFN_NORM, I_DENSE_WG, I_DENSE_WU, I_DENSE_WD, I_ROUTER_W, I_MOE_WG, I_MOE_WU, I_MOE_WD,
       I_PLE_NORM, I_PLE_WG, I_PLE_WP, I_FINAL_NORM, N_IN };
struct Args { const float* in[N_IN]; float* out; unsigned char* ws; int ph_lo, ph_hi, li, pad; };

typedef const __attribute__((address_space(4))) Args* KArgs;
__device__ __forceinline__ KArgs kargs() { KArgs p = (KArgs)__builtin_amdgcn_kernarg_segment_ptr(); asm volatile("" : "+s"(p)); return p; }
struct Ctx {
    LAS float* lds; int tid, lane, wave, bid, nblk;
    bf16* XO; bf16* XB; float* SSP;
};
__device__ __forceinline__ Ctx fresh(const Ctx& c) {
    Ctx f = c;
    asm volatile("" : "+s"(f.wave), "+s"(f.bid), "+s"(f.nblk));
    f.lane = (int)__builtin_amdgcn_mbcnt_hi(~0u, __builtin_amdgcn_mbcnt_lo(~0u, 0u)); f.tid = f.wave * 64 + f.lane;
    asm volatile("" : "+v"(f.tid), "+v"(f.lane));
    asm volatile("" : "+s"(f.XO), "+s"(f.XB), "+s"(f.SSP));
    return f;
}
#define CA_IN(i) (ka->in[i])
#define CA_WS (ka->ws)

__device__ __forceinline__ float row_rs(const float* SSP, int stage, int row) {
    const f32x4* p = (const f32x4*)(SSP + ((size_t)stage * NTOK + row) * 16);
    f32x4 a = p[0], b = p[1], c = p[2], d = p[3];
    float s = ((a.x + a.y) + (a.z + a.w)) + ((b.x + b.y) + (b.z + b.w)) + ((c.x + c.y) + (c.z + c.w)) + ((d.x + d.y) + (d.z + d.w));
    return __builtin_amdgcn_rsqf(s * (1.f / D_) + RMS_EPS);
}

__device__ __forceinline__ void phase_fix(Ctx c, const float* src, int stage) {
    const int gw = c.bid * NWAVES + c.wave, NGW = c.nblk * NWAVES;
    for (int m = gw; m < NTOK; m += NGW) {
        const f32x4* xr = (const f32x4*)(src + (size_t)m * D_) + c.lane;
        f32x4 v[4]; float s = 0.f;
#pragma unroll
        for (int j = 0; j < 4; ++j) { v[j] = xr[64 * j]; s += (v[j].x * v[j].x + v[j].y * v[j].y) + (v[j].z * v[j].z + v[j].w * v[j].w); }
        s = wave_sum(s, c.lane);
        u32x2* o8 = (u32x2*)(c.XB + (size_t)m * D_) + c.lane;
#pragma unroll
        for (int j = 0; j < 4; ++j) { u32x2 w; w.x = pk2(v[j].x, v[j].y); w.y = pk2(v[j].z, v[j].w); o8[64 * j] = w; }
        if (c.lane < 16) c.SSP[((size_t)stage * NTOK + m) * 16 + c.lane] = (c.lane == 0) ? s : 0.f;
    }
}
__device__ __forceinline__ void phase_final(Ctx c, int stage) {
    KArgs ka = kargs();
    const float* gn = CA_IN(I_FINAL_NORM); const bf16* RIN = (const bf16*)(CA_WS + WS_MIXED); float* out = ka->out;
    const int gw = c.bid * NWAVES + c.wave, NGW = c.nblk * NWAVES;
    for (int m = gw; m < NTOK; m += NGW) {
        const u32x2* xr = (const u32x2*)(RIN + (size_t)m * D_) + c.lane; f32x4* orow = (f32x4*)(out + (size_t)m * D_) + c.lane;
        const float rs = row_rs(c.SSP, stage, m);
#pragma unroll
        for (int j = 0; j < 4; ++j) { const u32x2 w = xr[64 * j]; const f32x4 g = ((const f32x4*)gn)[64 * j + c.lane];
            orow[64 * j] = (f32x4){blo(w.x) * rs * g.x, bhi(w.x) * rs * g.y, blo(w.y) * rs * g.z, bhi(w.y) * rs * g.w}; }
    }
}

template <bool FINAL>
__device__ __forceinline__ void phase_lru(Ctx c, int L) {
    KArgs ka = kargs();
    unsigned char* ws = CA_WS;
    const bf16* XR = (const bf16*)(ws + WS_XR); const bf16* YG = (const bf16*)(ws + WS_YG); bf16* MIXED = (bf16*)(ws + WS_MIXED);
    float* SA = (float*)(ws + MS_LRUA); float* SB = (float*)(ws + MS_LRUB);
    const float* conv_w = CA_IN(I_CONV_W) + L * 4 * D_REC; const float* conv_b = CA_IN(I_CONV_B) + L * D_REC;
    const float* ba = CA_IN(I_LRU_BA) + L * D_REC; const float* bx = CA_IN(I_LRU_BX) + L * D_REC; const float* lam = CA_IN(I_LRU_LAMBDA) + L * D_REC;
    const int ch = c.tid, blk = c.wave, lane = c.lane, fr = lane & 15, fq = lane >> 4;
    LAS char* lds = (LAS char*)c.lds;
    LAS unsigned short* xcb = (LAS unsigned short*)lds;
    LAS float* pre = (LAS float*)(lds + 16640);
    LAS float* red = (LAS float*)(lds + 16640 + 65536);
    const float cw0 = conv_w[0 * D_REC + ch], cw1 = conv_w[1 * D_REC + ch], cw2 = conv_w[2 * D_REC + ch], cw3 = conv_w[3 * D_REC + ch], cb = conv_b[ch];
    const float b_a = ba[ch], b_x = bx[ch];
    const float lmb = lam[ch]; const float sp = (lmb > 0.f) ? __logf(1.f + __expf(-lmb)) : (-lmb + __logf(1.f + __expf(lmb)));
    s16x8 wfa[4][2], wfx[4][2];
    { const bf16* WA = (const bf16*)(ws + WB_LWA) + ((size_t)L * 8 + blk) * 4096; const bf16* WX = (const bf16*)(ws + WB_LWX) + ((size_t)L * 8 + blk) * 4096;
#pragma unroll
      for (int ct = 0; ct < 4; ++ct)
#pragma unroll
          for (int ks = 0; ks < 2; ++ks) { wfa[ct][ks] = *(const s16x8*)(WA + (16 * ct + fr) * 64 + 32 * ks + 8 * fq); wfx[ct][ks] = *(const s16x8*)(WX + (16 * ct + fr) * 64 + 32 * ks + 8 * fq); } }
#define LRU_BAR() asm volatile("s_waitcnt lgkmcnt(0)\n\ts_barrier" ::: "memory")
    for (int u = c.bid; u < NB_ * LRU_NCH; u += c.nblk) {
        const int b = u / LRU_NCH, cki = u % LRU_NCH, t0 = cki * LRU_CHUNK;
        float h = 0.f, Aprod = 1.f;
        const bf16* xrp = XR + ((size_t)b * T_) * D_REC + ch; const bf16* ygp = YG + ((size_t)b * T_) * D_REC + ch;
        unsigned short xn[16], yn[16];
#pragma unroll
        for (int i = 0; i < 16; ++i) { xn[i] = xrp[(size_t)(t0 + i) * D_REC]; if (FINAL) yn[i] = ygp[(size_t)(t0 + i) * D_REC]; }
        float x1 = (t0 >= 1) ? bf2f(xrp[(size_t)(t0 - 1) * D_REC]) : 0.f, x2 = (t0 >= 2) ? bf2f(xrp[(size_t)(t0 - 2) * D_REC]) : 0.f, x3 = (t0 >= 3) ? bf2f(xrp[(size_t)(t0 - 3) * D_REC]) : 0.f;
        if (FINAL) {
            for (int j0 = 0; j0 < cki; j0 += 16) { float aa[16], bq[16];
#pragma unroll
                for (int k = 0; k < 16; ++k) { const bool v = j0 + k < cki; aa[k] = v ? SA[((size_t)b * LRU_NCH + j0 + k) * D_REC + ch] : 1.f; bq[k] = v ? SB[((size_t)b * LRU_NCH + j0 + k) * D_REC + ch] : 0.f; }
#pragma unroll
                for (int k = 0; k < 16; ++k) h = aa[k] * h + bq[k]; } }
        __syncthreads();
        for (int s = 0; s < LRU_CHUNK; s += 16) {
            float xc[16], yv[16];
#pragma unroll
            for (int i = 0; i < 16; ++i) { const float x0 = bf2f(xn[i]); if (FINAL) yv[i] = bf2f(yn[i]); xc[i] = cw0 * x3 + cw1 * x2 + cw2 * x1 + cw3 * x0 + cb; x3 = x2; x2 = x1; x1 = x0; xcb[i * 520 + ch] = f2bf(xc[i]); }
            if (s + 16 < LRU_CHUNK) {
#pragma unroll
                for (int i = 0; i < 16; ++i) { xn[i] = xrp[(size_t)(t0 + s + 16 + i) * D_REC]; if (FINAL) yn[i] = ygp[(size_t)(t0 + s + 16 + i) * D_REC]; } }
            LRU_BAR();
            { s16x8 af[2];
#pragma unroll
              for (int ks = 0; ks < 2; ++ks) af[ks] = *(const LAS s16x8*)(xcb + fr * 520 + blk * 64 + 32 * ks + 8 * fq);
#pragma unroll
              for (int ct = 0; ct < 4; ++ct) { f32x4 ra = (f32x4){0.f, 0.f, 0.f, 0.f}, rx = ra;
#pragma unroll
                  for (int ks = 0; ks < 2; ++ks) { ra = __builtin_amdgcn_mfma_f32_16x16x32_bf16(af[ks], wfa[ct][ks], ra, 0, 0, 0); rx = __builtin_amdgcn_mfma_f32_16x16x32_bf16(af[ks], wfx[ct][ks], rx, 0, 0, 0); }
#pragma unroll
                  for (int i = 0; i < 4; ++i) { pre[(4 * fq + i) * 512 + blk * 64 + 16 * ct + fr] = ra[i]; pre[8192 + (4 * fq + i) * 512 + blk * 64 + 16 * ct + fr] = rx[i]; } } }
            LRU_BAR();
            float o[16];
            typedef float f32x2 __attribute__((ext_vector_type(2)));
            const float ca = -8.f * sp * LOG2E;
#pragma unroll
            for (int i = 0; i < 16; i += 2) {
                const f32x2 pa = (f32x2){pre[i * 512 + ch], pre[(i + 1) * 512 + ch]} + b_a, px = (f32x2){pre[8192 + i * 512 + ch], pre[8192 + (i + 1) * 512 + ch]} + b_x;
                const f32x2 ta = pa * (-LOG2E), tx = px * (-LOG2E);
                const f32x2 da = (f32x2){__builtin_amdgcn_exp2f(ta.x), __builtin_amdgcn_exp2f(ta.y)} + 1.f, dx = (f32x2){__builtin_amdgcn_exp2f(tx.x), __builtin_amdgcn_exp2f(tx.y)} + 1.f;
                const f32x2 r = (f32x2){__builtin_amdgcn_rcpf(da.x), __builtin_amdgcn_rcpf(da.y)}, ig = (f32x2){__builtin_amdgcn_rcpf(dx.x), __builtin_amdgcn_rcpf(dx.y)};
                const f32x2 la2 = r * ca; const f32x2 av = (f32x2){__builtin_amdgcn_exp2f(la2.x), __builtin_amdgcn_exp2f(la2.y)};
                const f32x2 om = 1.f - av * av; const f32x2 sq = (f32x2){__builtin_amdgcn_sqrtf(fmaxf(om.x, 0.f)), __builtin_amdgcn_sqrtf(fmaxf(om.y, 0.f))};
                const f32x2 bb = sq * ig * (f32x2){xc[i], xc[i + 1]};
                h = av.x * h + bb.x; o[i] = h; h = av.y * h + bb.y; o[i + 1] = h; Aprod *= av.x * av.y; }
            if (FINAL) {
                float v8[8], v4[4], v2[2], v1;
#pragma unroll
                for (int i = 0; i < 16; i += 2) {
                    const f32x2 y = (f32x2){yv[i], yv[i + 1]}; const f32x2 t = (y * y * 0.044715f + 1.f) * y * (-2.f * 0.7978845608028654f * LOG2E);
                    const f32x2 d = (f32x2){__builtin_amdgcn_exp2f(t.x), __builtin_amdgcn_exp2f(t.y)} + 1.f;
                    const f32x2 gl = y * (f32x2){__builtin_amdgcn_rcpf(d.x), __builtin_amdgcn_rcpf(d.y)};
                    o[i] *= gl.x; o[i + 1] *= gl.y; }
                { const bool up = (lane & 32) != 0;
#pragma unroll
                  for (int i = 0; i < 8; ++i) { const float lo = o[i] * o[i], hi2 = o[i + 8] * o[i + 8]; const float keep = up ? hi2 : lo, send = up ? lo : hi2; v8[i] = keep + shx(send, 32, lane); } }
                { const bool up = (lane & 16) != 0;
#pragma unroll
                  for (int i = 0; i < 4; ++i) { const float keep = up ? v8[i + 4] : v8[i], send = up ? v8[i] : v8[i + 4]; v4[i] = keep + shx(send, 16, lane); } }
                { const bool up = (lane & 8) != 0;
#pragma unroll
                  for (int i = 0; i < 2; ++i) { const float keep = up ? v4[i + 2] : v4[i], send = up ? v4[i] : v4[i + 2]; v2[i] = keep + shx(send, 8, lane); } }
                { const bool up = (lane & 4) != 0; const float keep = up ? v2[1] : v2[0], send = up ? v2[0] : v2[1]; v1 = keep + shx(send, 4, lane); }
                v1 += shx(v1, 2, lane); v1 += shx(v1, 1, lane);
                if ((lane & 3) == 0) red[(((lane >> 5) & 1) * 8 + ((lane >> 4) & 1) * 4 + ((lane >> 3) & 1) * 2 + ((lane >> 2) & 1)) * 8 + c.wave] = v1;
                LRU_BAR();
                float rsl = 0.f;
                if ((lane & 3) == 0) { float q = 0.f;
#pragma unroll
                    for (int w = 0; w < 8; ++w) q += red[(lane >> 2) * 8 + w];
                    rsl = __builtin_amdgcn_rsqf(q * (1.f / D_REC) + RMS_EPS); }
#pragma unroll
                for (int i = 0; i < 16; ++i) { const float rs = __builtin_bit_cast(float, __builtin_amdgcn_readlane(__builtin_bit_cast(int, rsl), 4 * i)); MIXED[((size_t)b * T_ + t0 + s + i) * D_ + 512 + ch] = f2bf(o[i] * rs); }
            }
            LRU_BAR();
        }
        if (!FINAL) { SA[((size_t)b * LRU_NCH + cki) * D_REC + ch] = Aprod; SB[((size_t)b * LRU_NCH + cki) * D_REC + ch] = h; }
    }
    __syncthreads();
}

constexpr int AT_K = 0, AT_V = 24576, AT_PSLC = 57344, AT_PSLC_LD = 132, AT_SEL = AT_PSLC + 64 * AT_PSLC_LD * 4, AT_MISC = AT_SEL + 1024, AT_OST = AT_MISC + 2560, AT_END = AT_OST + 65536;
constexpr float NEG_BIG = -INFINITY;
__device__ __forceinline__ unsigned cvtpk(float lo, float hi) { unsigned r; asm("v_cvt_pk_bf16_f32 %0, %1, %2" : "=v"(r) : "v"(lo), "v"(hi)); return r; }
__device__ __forceinline__ s16x4 vtr(const LAS char* p) { return __builtin_bit_cast(s16x4, __builtin_amdgcn_ds_read_tr16_b64_v4i16((LAS s16x4*)p)); }
__device__ __forceinline__ void dma16(const void* g, LAS char* l) { __builtin_amdgcn_global_load_lds((const unsigned*)g, (LAS unsigned*)l, 16, 0, 0); }

struct AttnW {
    LAS char* lds; int lane, wave, r32, hi, hl, qh;
};
__device__ __forceinline__ void at_load_tile(const AttnW& w, const bf16* Kt, const bf16* Vt, int tile) {
    dma16((const char*)Kt + (8 * w.wave + (w.lane >> 3)) * 128 + (((w.lane & 7) ^ (w.lane >> 3)) * 16), w.lds + AT_K + (tile % 3) * 8192 + w.wave * 1024);
    dma16((const char*)Vt + (16 * (w.wave & 3) + (w.lane >> 2)) * 128 + (w.wave >> 2) * 64 + (w.lane & 3) * 16, w.lds + AT_V + (tile & 3) * 8192 + w.wave * 1024);
}
__device__ __forceinline__ void at_ldk(const AttnW& w, int tile, s16x8 (&kf)[8]) {
    const unsigned ka = (unsigned)(uintptr_t)w.lds + (unsigned)(AT_K + (tile % 3) * 8192 + w.r32 * 128);
#pragma unroll
    for (int d0 = 0; d0 < 4; ++d0) { const unsigned kd = ka + (unsigned)((((2 * d0 + w.hi) ^ (w.r32 & 7))) * 16);
        asm volatile("ds_read_b128 %0, %1 offset:0" : "=v"(kf[2 * d0]) : "v"(kd) : "memory");
        asm volatile("ds_read_b128 %0, %1 offset:4096" : "=v"(kf[2 * d0 + 1]) : "v"(kd) : "memory"); }
}
__device__ __forceinline__ void at_ldv(const AttnW& w, int tile, s16x4 (&vl)[8], s16x4 (&vh)[8]) {
    const unsigned va = (unsigned)(uintptr_t)w.lds + (unsigned)(AT_V + (tile & 3) * 8192 + ((w.lane >> 4) & 1) * 32 + (w.lane & 3) * 8 + (4 * w.hi + ((w.lane & 15) >> 2)) * 64);
#pragma unroll
    for (int i = 0; i < 8; ++i) {
        asm volatile("ds_read_b64_tr_b16 %0, %1 offset:%2" : "=v"(vl[i]) : "v"(va), "n"((i >> 2) * 4096 + (i & 3) * 1024) : "memory");
        asm volatile("ds_read_b64_tr_b16 %0, %1 offset:%2" : "=v"(vh[i]) : "v"(va), "n"((i >> 2) * 4096 + (i & 3) * 1024 + 512) : "memory"); }
}
#define AT_LGKM0() do { asm volatile("s_waitcnt lgkmcnt(0)" ::: "memory"); __builtin_amdgcn_sched_barrier(0); } while (0)
__device__ __forceinline__ void at_bias(const AttnW& w, float ks, float lb, f32x16& p0, f32x16& p1) {
    float bb = lb + ks * (float)(4 * w.hi); const float k32 = 32.f * ks, k5 = 5.f * ks;
#pragma unroll
    for (int r = 0; r < 16; ++r) { p0[r] = bb; p1[r] = bb + k32; bb += ((r & 3) == 3) ? k5 : ks; }
}
template <int MASK>
__device__ __forceinline__ void at_bias_m(const AttnW& w, float ks, float lb, int lim, f32x16& p0, f32x16& p1) {
    float bb = lb + ks * (float)(4 * w.hi); const float k32 = 32.f * ks, k5 = 5.f * ks;
    int l0 = lim - 4 * w.hi; asm volatile("" : "+v"(l0));
#pragma unroll
    for (int r = 0; r < 16; ++r) { const int kc = (r & 3) + 8 * (r >> 2);
        const bool k0 = (MASK == 1) ? (kc <= l0) : (kc > l0), k1 = (MASK == 1) ? (kc + 32 <= l0) : (kc + 32 > l0);
        p0[r] = k0 ? bb : NEG_BIG; p1[r] = k1 ? bb + k32 : NEG_BIG; bb += ((r & 3) == 3) ? k5 : ks; }
}
__device__ __forceinline__ void at_qk(const s16x8 (&kf)[8], const s16x8 (&qr)[4], f32x16& p0, f32x16& p1) {
#pragma unroll
    for (int d0 = 0; d0 < 4; ++d0) { p0 = __builtin_amdgcn_mfma_f32_32x32x16_bf16(kf[2 * d0], qr[d0], p0, 0, 0, 0); p1 = __builtin_amdgcn_mfma_f32_32x32x16_bf16(kf[2 * d0 + 1], qr[d0], p1, 0, 0, 0); }
}
template <int MASK>
__device__ __forceinline__ void at_mask(const AttnW& w, f32x16& p0, f32x16& p1, int lim) {
    int l0 = lim - 4 * w.hi; asm volatile("" : "+v"(l0));
#pragma unroll
    for (int r = 0; r < 16; ++r) { const int kc = (r & 3) + 8 * (r >> 2);
        if (MASK == 1) { if (!(kc <= l0)) p0[r] = NEG_BIG; if (!(kc + 32 <= l0)) p1[r] = NEG_BIG; }
        if (MASK == 2) { if (!(kc > l0)) p0[r] = NEG_BIG; if (!(kc + 32 > l0)) p1[r] = NEG_BIG; } }
}
__device__ __forceinline__ void at_softmax(f32x16& p0, f32x16& p1, float& l, u32x4 (&pw)[4]) {
    float ls = 0.f;
#pragma unroll
    for (int r = 0; r < 16; ++r) { p0[r] = __builtin_amdgcn_exp2f(p0[r]); p1[r] = __builtin_amdgcn_exp2f(p1[r]); ls += p0[r] + p1[r]; }
    l += ls;
#pragma unroll
    for (int k = 0; k < 2; ++k) { pw[k] = (u32x4){cvtpk(p0[8 * k], p0[8 * k + 1]), cvtpk(p0[8 * k + 2], p0[8 * k + 3]), cvtpk(p0[8 * k + 4], p0[8 * k + 5]), cvtpk(p0[8 * k + 6], p0[8 * k + 7])};
        pw[2 + k] = (u32x4){cvtpk(p1[8 * k], p1[8 * k + 1]), cvtpk(p1[8 * k + 2], p1[8 * k + 3]), cvtpk(p1[8 * k + 4], p1[8 * k + 5]), cvtpk(p1[8 * k + 6], p1[8 * k + 7])}; }
}
__device__ __forceinline__ void at_pv(const s16x4 (&vl)[8], const s16x4 (&vh)[8], const u32x4 (&pw)[4], f32x16 (&o)[2]) {
#pragma unroll
    for (int dh = 0; dh < 2; ++dh)
#pragma unroll
        for (int k = 0; k < 4; ++k) { const s16x4 a = vl[dh * 4 + k], b = vh[dh * 4 + k];
            o[dh] = __builtin_amdgcn_mfma_f32_32x32x16_bf16((s16x8){a[0], a[1], a[2], a[3], b[0], b[1], b[2], b[3]}, __builtin_bit_cast(s16x8, pw[k]), o[dh], 0, 0, 0); }
}
#define AT_STEP(t, n, ACT_, BIASSTMT) AT_STEPM(t, n, ACT_, BIASSTMT, (void)0)
#define AT_STEPM(t, n, ACT_, BIASSTMT, MASKSTMT) do { \
        if (w.wave >= 4 && (t) > 0 && pend) { s16x4 vl[8], vh[8]; at_ldv(w, (t) - 1, vl, vh); AT_LGKM0(); at_pv(vl, vh, pw, o); } \
        pend = false; \
        if ((t) < (n) && (ACT_)) { f32x16 p0, p1; { s16x8 kf[8]; at_ldk(w, (t), kf); BIASSTMT; AT_LGKM0(); at_qk(kf, qr, p0, p1); } MASKSTMT; at_softmax(p0, p1, l, pw); pend = true; \
            if (w.wave < 4) { s16x4 vl[8], vh[8]; at_ldv(w, (t), vl, vh); AT_LGKM0(); at_pv(vl, vh, pw, o); } } } while (0)
#define AT_NEGL 60.f
#define AT_WAITBAR(newer) do { if (newer) asm volatile("s_waitcnt vmcnt(2) lgkmcnt(0)\n\ts_barrier" ::: "memory"); else asm volatile("s_waitcnt vmcnt(0) lgkmcnt(0)\n\ts_barrier" ::: "memory"); } while (0)

__device__ __forceinline__ void phase_attn_mfma(Ctx c) {
    KArgs ka = kargs(); unsigned char* ws = CA_WS;
    const bf16* Q = (const bf16*)(ws + WS_Q); const float* GATE = (const float*)(ws + WS_GATE); bf16* MIXED = (bf16*)(ws + WS_MIXED);
    AttnW w; w.lds = (LAS char*)c.lds; w.lane = c.lane; w.wave = c.wave; w.r32 = c.lane & 31; w.hi = c.lane >> 5; w.hl = (c.wave < 4) ? (c.wave >> 1) : 3 - ((c.wave - 4) >> 1); w.qh = c.wave & 1;
    LAS float* pslc = (LAS float*)(w.lds + AT_PSLC); LAS unsigned* selm = (LAS unsigned*)(w.lds + AT_SEL);
    LAS unsigned* uni = (LAS unsigned*)(w.lds + AT_MISC); LAS float* ssq = (LAS float*)(w.lds + AT_MISC + 256); LAS unsigned short* ost = (LAS unsigned short*)(w.lds + AT_OST);
    const f32x16 zero16 = (f32x16){0,0,0,0,0,0,0,0,0,0,0,0,0,0,0,0};
    for (int uu = c.bid; uu < NB_ * 128; uu += c.nblk) {
        const int b = (uu >> 6) & 3, i = (uu < 256) ? (uu & 63) : 127 - (uu & 63);
        const int s0 = i * 64;
        for (int g = 0; g < NG; ++g) {
            { int ln = c.lane; asm volatile("" : "+v"(ln)); w.lane = ln; w.r32 = ln & 31; w.hi = ln >> 5; c.lane = ln; c.tid = c.wave * 64 + ln; }
            const int qq = 32 * w.qh + w.r32, t = s0 + qq; const size_t row = (size_t)b * T_ + t;
            const size_t bg = (size_t)b * NG + g; const int h = g * 4 + w.hl;
            const float slope2 = __builtin_amdgcn_exp2f(-(float)(h + 1)) * LOG2E;
            const bf16* KC = (const bf16*)(ws + MS_KCMP) + bg * 512 * 64; const bf16* VC = (const bf16*)(ws + MS_VCMP) + bg * 512 * 64;
            const bf16* KS = (const bf16*)(ws + WS_KV + 2 * KV_STRIDE) + bg * T_ * 64; const bf16* VS = (const bf16*)(ws + WS_KV + 3 * KV_STRIDE) + bg * T_ * 64;
            const bf16* KW = (const bf16*)(ws + WS_KV + 4 * KV_STRIDE) + bg * T_ * 64; const bf16* VW = (const bf16*)(ws + WS_KV + 5 * KV_STRIDE) + bg * T_ * 64;
            s16x8 qr[4];
#pragma unroll
            for (int d0 = 0; d0 < 4; ++d0) qr[d0] = *(const s16x8*)(Q + row * 512 + h * 64 + 16 * d0 + 8 * w.hi);
            const float g0 = GATE[row * 24 + h * 3 + 0], g1 = GATE[row * 24 + h * 3 + 1], g2 = GATE[row * 24 + h * 3 + 2];
            f32x16 oacc[2]; oacc[0] = zero16; oacc[1] = zero16;
            for (int e = c.tid; e < 64 * AT_PSLC_LD; e += NTHR) pslc[e] = 0.f;
            const int ntc = ((4 * i + 2) >> 6) + 1;
            const int limc = (t - 31) >> 4;
            const float lbc = slope2 * (float)(31 - t);
            float l = 0.f; f32x16 o[2]; o[0] = zero16; o[1] = zero16;
            u32x4 pw[4]; bool pend = false;
            const int tmin = s0 + 32 * w.qh;
            {
            __syncthreads();
            at_load_tile(w, KC, VC, 0); if (ntc > 1) at_load_tile(w, KC + 4096, VC + 4096, 1);
            for (int j = 0; j <= ntc; ++j) {
                AT_WAITBAR(j + 1 < ntc);
                if (j + 2 < ntc) at_load_tile(w, KC + (size_t)(j + 2) * 4096, VC + (size_t)(j + 2) * 4096, j + 2);
                const int dmc = tmin - (1024 * j + 1039);
                AT_STEP(j, ntc, (dmc <= 0 || slope2 * (float)dmc < AT_NEGL), at_bias_m<1>(w, slope2 * 16.f, lbc + slope2 * (float)(1024 * j), limc - 64 * j, p0, p1));
            }
            }
            float lt = l + shx(l, 32, w.lane); float il = lt > 0.f ? 1.f / lt : 0.f;
#pragma unroll
            for (int r = 0; r < 16; ++r) { oacc[0][r] += o[0][r] * (g0 * il); oacc[1][r] += o[1][r] * (g0 * il); }
            if (i >= 16) {
                LAS float* ilbuf = (LAS float*)selm;
                if (w.hi == 0) ilbuf[w.hl * 64 + qq] = il;
                const int hd = w.r32 >> 3, q2 = 8 * w.wave + (w.r32 & 7), t2 = s0 + q2; const size_t row2 = (size_t)b * T_ + t2;
                s16x8 qr2[4];
#pragma unroll
                for (int d0 = 0; d0 < 4; ++d0) qr2[d0] = *(const s16x8*)(Q + row2 * 512 + (g * 4 + hd) * 64 + 16 * d0 + 8 * w.hi);
                const float sl2 = __builtin_amdgcn_exp2f(-(float)(g * 4 + hd + 1)) * LOG2E, lbc2 = sl2 * (float)(31 - t2); const int limc2 = (t2 - 31) >> 4;
                __syncthreads();
                const float il2 = ilbuf[hd * 64 + q2];
                at_load_tile(w, KC, VC, 0); if (ntc > 1) at_load_tile(w, KC + 4096, VC + 4096, 1);
                for (int j = 0; j < ntc; ++j) {
                    AT_WAITBAR(j + 1 < ntc);
                    if (j + 2 < ntc) at_load_tile(w, KC + (size_t)(j + 2) * 4096, VC + (size_t)(j + 2) * 4096, j + 2);
                    f32x16 p0, p1; { s16x8 kf[8]; at_ldk(w, j, kf); at_bias_m<1>(w, sl2 * 16.f, lbc2 + sl2 * (float)(1024 * j), limc2 - 64 * j, p0, p1); AT_LGKM0(); at_qk(kf, qr2, p0, p1); }
                    float av[8], bv[8];
#pragma unroll
                    for (int q4 = 0; q4 < 4; ++q4) {
                        const float a0 = __builtin_amdgcn_exp2f(p0[4 * q4]) * il2, a1 = __builtin_amdgcn_exp2f(p0[4 * q4 + 1]) * il2, a2 = __builtin_amdgcn_exp2f(p0[4 * q4 + 2]) * il2, a3 = __builtin_amdgcn_exp2f(p0[4 * q4 + 3]) * il2;
                        av[q4] = 2.f * ((a0 + a1) + a2) + a3; bv[q4] = a3;
                        const float c0 = __builtin_amdgcn_exp2f(p1[4 * q4]) * il2, c1 = __builtin_amdgcn_exp2f(p1[4 * q4 + 1]) * il2, c2 = __builtin_amdgcn_exp2f(p1[4 * q4 + 2]) * il2, c3 = __builtin_amdgcn_exp2f(p1[4 * q4 + 3]) * il2;
                        av[4 + q4] = 2.f * ((c0 + c1) + c2) + c3; bv[4 + q4] = c3; }
#pragma unroll
                    for (int e = 0; e < 8; ++e) { av[e] += shx(av[e], 8, w.lane); av[e] += shx(av[e], 16, w.lane); bv[e] += shx(bv[e], 8, w.lane); bv[e] += shx(bv[e], 16, w.lane); }
                    if (hd == 0) {
                        LAS float* prow = pslc + q2 * AT_PSLC_LD + 16 * j + w.hi;
#pragma unroll
                        for (int e = 0; e < 8; ++e) { LAS float* p = prow + 8 * (e >> 2) + 2 * (e & 3); *p += av[e]; }
                        asm volatile("s_waitcnt lgkmcnt(0)" ::: "memory");
#pragma unroll
                        for (int e = 0; e < 8; ++e) { LAS float* p = prow + 8 * (e >> 2) + 2 * (e & 3) + 1; *p += bv[e]; }
                        asm volatile("s_waitcnt lgkmcnt(0)" ::: "memory");
                    }
                }
            }
            __syncthreads();
            if (i < 16) { if (c.tid < 64) { selm[c.tid * 4] = (1u << (i + 1)) - 1u; selm[c.tid * 4 + 1] = 0u; selm[c.tid * 4 + 2] = 0u; selm[c.tid * 4 + 3] = 0u; }
                if (c.tid < 4) uni[c.tid] = (c.tid == 0) ? ((1u << (i + 1)) - 1u) : 0u; }
            else {
                unsigned uw0 = 0u, uw1 = 0u, uw2 = 0u, uw3 = 0u;
                for (int qi = 0; qi < 8; ++qi) {
                    const int q = w.wave * 8 + qi; const int n0 = w.lane, n1 = w.lane + 64;
                    const bool c0 = (n0 >= 1 && n0 <= i - 2), c1 = (n1 <= i - 2);
                    const unsigned v0 = c0 ? __float_as_uint(pslc[q * AT_PSLC_LD + n0]) : 0u, v1 = c1 ? __float_as_uint(pslc[q * AT_PSLC_LD + n1]) : 0u;
                    unsigned T = 0u;
                    for (int bit = 30; bit >= 0; --bit) { const unsigned cand = T | (1u << bit);
                        const int cnt = __builtin_popcountll(__ballot(c0 && v0 >= cand)) + __builtin_popcountll(__ballot(c1 && v1 >= cand));
                        if (cnt >= 13) { T = cand; if (cnt == 13) break; } }
                    const unsigned long long gt0 = __ballot(c0 && v0 > T), gt1 = __ballot(c1 && v1 > T), eq0 = __ballot(c0 && v0 == T), eq1 = __ballot(c1 && v1 == T);
                    const int need = 13 - (__builtin_popcountll(gt0) + __builtin_popcountll(gt1));
                    const unsigned long long below = (w.lane == 0) ? 0ull : (~0ull >> (64 - w.lane));
                    const bool s0b = (c0 && v0 > T) || (c0 && v0 == T && __builtin_popcountll(eq0 & below) < need);
                    const bool s1b = (c1 && v1 > T) || (c1 && v1 == T && (__builtin_popcountll(eq0) + __builtin_popcountll(eq1 & below)) < need);
                    unsigned long long m0 = __ballot(s0b), m1 = __ballot(s1b);
                    m0 |= 1ull; { const int f1 = i - 1, f2 = i; if (f1 < 64) m0 |= 1ull << f1; else m1 |= 1ull << (f1 - 64); if (f2 < 64) m0 |= 1ull << f2; else m1 |= 1ull << (f2 - 64); }
                    if (w.lane == 0) { selm[q * 4] = (unsigned)m0; selm[q * 4 + 1] = (unsigned)(m0 >> 32); selm[q * 4 + 2] = (unsigned)m1; selm[q * 4 + 3] = (unsigned)(m1 >> 32); }
                    uw0 |= (unsigned)m0; uw1 |= (unsigned)(m0 >> 32); uw2 |= (unsigned)m1; uw3 |= (unsigned)(m1 >> 32);
                }
                if (w.lane == 0) { uni[4 + w.wave * 4] = uw0; uni[4 + w.wave * 4 + 1] = uw1; uni[4 + w.wave * 4 + 2] = uw2; uni[4 + w.wave * 4 + 3] = uw3; }
                __syncthreads();
                if (c.tid < 4) { unsigned u = 0u; for (int k = 0; k < 8; ++k) u |= uni[4 + k * 4 + c.tid]; uni[c.tid] = u; }
            }
            __syncthreads();
            unsigned um[4]; um[0] = uni[0]; um[1] = uni[1]; um[2] = uni[2]; um[3] = uni[3];
            const unsigned sm0 = selm[qq * 4], sm1 = selm[qq * 4 + 1], sm2 = selm[qq * 4 + 2], sm3 = selm[qq * 4 + 3];
            {
                l = 0.f; o[0] = zero16; o[1] = zero16;
                um[0] = __builtin_amdgcn_readfirstlane(um[0]); um[1] = __builtin_amdgcn_readfirstlane(um[1]); um[2] = __builtin_amdgcn_readfirstlane(um[2]); um[3] = __builtin_amdgcn_readfirstlane(um[3]);
                int wsel = 0; unsigned cur = um[0];
                auto next_blk = [&]() -> int { while (cur == 0u && wsel < 3) { ++wsel; cur = (wsel == 1) ? um[1] : (wsel == 2) ? um[2] : um[3]; }
                    if (cur == 0u) return -1; const int bpos = __builtin_ctz(cur); cur &= cur - 1u; return wsel * 32 + bpos; };
                int nb = next_blk(), nb1 = next_blk(), it = 0;
                __syncthreads();
                at_load_tile(w, KS + (size_t)nb * 4096, VS + (size_t)nb * 4096, 0);
                if (nb1 >= 0) at_load_tile(w, KS + (size_t)nb1 * 4096, VS + (size_t)nb1 * 4096, 1);
                for (;;) {
                    const int nb2 = (nb1 >= 0) ? next_blk() : -1;
                    AT_WAITBAR(nb1 >= 0);
                    if (nb2 >= 0) at_load_tile(w, KS + (size_t)nb2 * 4096, VS + (size_t)nb2 * 4096, it + 2);
                    const int nbc = nb < 0 ? 0 : nb;
                    const unsigned smw = (nbc < 32) ? sm0 : (nbc < 64) ? sm1 : (nbc < 96) ? sm2 : sm3;
                    const bool en = (smw >> (nbc & 31)) & 1u;
                    const float lb = en ? slope2 * (float)(64 * nbc - t) : NEG_BIG;
                    const int dms = tmin - (64 * nbc + 63);
                    AT_STEP(it, (nb >= 0 ? it + 1 : it), (dms <= 0 || slope2 * (float)dms < AT_NEGL), if (nb == i) at_bias_m<1>(w, slope2, lb, qq, p0, p1); else at_bias(w, slope2, lb, p0, p1));
                    if (nb < 0) break;
                    nb = nb1; nb1 = nb2; ++it;
                }
                lt = l + shx(l, 32, w.lane); il = lt > 0.f ? 1.f / lt : 0.f;
#pragma unroll
                for (int r = 0; r < 16; ++r) { oacc[0][r] += o[0][r] * (g1 * il); oacc[1][r] += o[1][r] * (g1 * il); }
            }
            {
                l = 0.f; o[0] = zero16; o[1] = zero16;
                const int j0 = (i >= 8) ? 0 : 8 - i;
                const bf16* KW0 = KW + (ptrdiff_t)(s0 - 512) * 64; const bf16* VW0 = VW + (ptrdiff_t)(s0 - 512) * 64;
                __syncthreads();
                at_load_tile(w, KW0 + (ptrdiff_t)j0 * 4096, VW0 + (ptrdiff_t)j0 * 4096, 0); if (j0 < 8) at_load_tile(w, KW0 + (ptrdiff_t)(j0 + 1) * 4096, VW0 + (ptrdiff_t)(j0 + 1) * 4096, 1);
                for (int j = j0; j <= 9; ++j) {
                    AT_WAITBAR(j < 8);
                    if (j + 2 <= 8) at_load_tile(w, KW0 + (ptrdiff_t)(j + 2) * 4096, VW0 + (ptrdiff_t)(j + 2) * 4096, j - j0 + 2);
                    const int dmw = 32 * w.qh + 449 - 64 * j;
                    AT_STEPM(j - j0, 9 - j0, (dmw <= 0 || slope2 * (float)dmw < AT_NEGL), at_bias(w, slope2, slope2 * (float)(64 * j - 512 - qq), p0, p1), if (j == 0) at_mask<2>(w, p0, p1, qq); else if (j == 8) at_mask<1>(w, p0, p1, qq));
                }
                lt = l + shx(l, 32, w.lane); il = lt > 0.f ? 1.f / lt : 0.f;
#pragma unroll
                for (int r = 0; r < 16; ++r) { oacc[0][r] += o[0][r] * (g2 * il); oacc[1][r] += o[1][r] * (g2 * il); }
            }
            {
                float sq = 0.f;
#pragma unroll
                for (int dh = 0; dh < 2; ++dh)
#pragma unroll
                    for (int r4 = 0; r4 < 4; ++r4) { const float x0 = oacc[dh][4 * r4], x1 = oacc[dh][4 * r4 + 1], x2 = oacc[dh][4 * r4 + 2], x3 = oacc[dh][4 * r4 + 3];
                        sq += (x0 * x0 + x1 * x1) + (x2 * x2 + x3 * x3);
                        u32x2 pk; pk.x = cvtpk(x0, x1); pk.y = cvtpk(x2, x3);
                        *(LAS u32x2*)(ost + qq * 512 + h * 64 + 32 * dh + 8 * r4 + 4 * w.hi) = pk; }
                sq += shx(sq, 32, w.lane);
                if (w.hi == 0) ssq[(g * 4 + w.hl) * 64 + qq] = sq;
            }
            __syncthreads();
        }
        {
            const int q = c.tid >> 3, part = c.tid & 7;
            float ss = 0.f;
#pragma unroll
            for (int k = 0; k < 8; ++k) ss += ssq[k * 64 + q];
            const float rs = __builtin_amdgcn_rsqf(ss * (1.f / 512.f) + RMS_EPS);
            bf16* orow = MIXED + ((size_t)b * T_ + s0 + q) * D_ + part * 64;
#pragma unroll
            for (int k = 0; k < 8; ++k) { const u32x4 v = *(const LAS u32x4*)(ost + q * 512 + part * 64 + 8 * k);
                u32x4 o4; o4.x = cvtpk(__uint_as_float(v.x << 16) * rs, __uint_as_float(v.x & 0xffff0000u) * rs); o4.y = cvtpk(__uint_as_float(v.y << 16) * rs, __uint_as_float(v.y & 0xffff0000u) * rs);
                o4.z = cvtpk(__uint_as_float(v.z << 16) * rs, __uint_as_float(v.z & 0xffff0000u) * rs); o4.w = cvtpk(__uint_as_float(v.w << 16) * rs, __uint_as_float(v.w & 0xffff0000u) * rs);
                *(u32x4*)(orow + 8 * k) = o4; }
        }
        __syncthreads();
    }
}

static_assert(AT_END <= LDS_WORK, "attention LDS map");
typedef float f32x4v __attribute__((ext_vector_type(4)));
__device__ __forceinline__ void phase_cmp_mfma(Ctx c, int L) {
    KArgs ka = kargs(); unsigned char* ws = CA_WS;
    LAS char* lds = (LAS char*)c.lds; LAS char* hidl = lds + 69632;
    LAS float* pbl = (LAS float*)(lds + 69632 + 8704);
    const int lane = c.lane, wv = c.wave, fr = lane & 15, fq = lane >> 4;
    for (int u = c.bid; u < 2 * NB_ * NG * 16; u += c.nblk) {
        const int kv = u >> 7, bg = (u >> 4) & 7, c0 = (u & 15) * 32;
        const bf16* RAW = (const bf16*)(ws + WS_KV + kv * KV_STRIDE) + ((size_t)bg * T_ + 16 * c0) * 64;
        const bf16* W1T = (const bf16*)(ws + WB_C1T) + ((size_t)L * 2 + kv) * CMP_HID * (L_CMP * HD); const bf16* W2T = (const bf16*)(ws + WB_C2T) + ((size_t)L * 2 + kv) * HD * CMP_HID;
        const float* PP = (const float*)(ws + WB_POSBP) + ((size_t)L * 2 + kv) * 32 * CMP_HID;
        bf16* OUT = (bf16*)(ws + (kv ? MS_VCMP : MS_KCMP)) + (size_t)bg * 512 * 64;
        __syncthreads();
        for (int e = c.tid; e < 528 * 8; e += NTHR) { const int tk = e >> 3, ch = e & 7; *(LAS u32x4*)(lds + tk * 128 + (tk >> 4) * 16 + ch * 16) = *(const u32x4*)(RAW + (size_t)tk * 64 + ch * 8); }
        if (c.tid < CMP_HID) { float a = 0.f; for (int k = 0; k < 32; ++k) a += PP[k * CMP_HID + c.tid]; pbl[c.tid] = a; }
        __syncthreads();
        f32x4v acc[2]; acc[0] = (f32x4v){0.f, 0.f, 0.f, 0.f}; acc[1] = acc[0];
        const bf16* wrow = W1T + (size_t)(16 * wv + fr) * (L_CMP * HD) + 8 * fq;
#pragma unroll 4
        for (int st = 0; st < 64; ++st) {
            const s16x8 bfr = *(const s16x8*)(wrow + 32 * st);
            const int tk = st >> 1, off = tk * 128 + (tk >> 4) * 16 + (32 * (st & 1) + 8 * fq) * 2;
#pragma unroll
            for (int rt = 0; rt < 2; ++rt) { const s16x8 afr = *(const LAS s16x8*)(lds + (16 * rt + fr) * 2064 + off);
                acc[rt] = __builtin_amdgcn_mfma_f32_16x16x32_bf16(afr, bfr, acc[rt], 0, 0, 0); }
        }
        { const float pb = pbl[16 * wv + fr];
#pragma unroll
          for (int rt = 0; rt < 2; ++rt)
#pragma unroll
              for (int i = 0; i < 4; ++i) *(LAS unsigned short*)(hidl + ((16 * rt + 4 * fq + i) * 136 + 16 * wv + fr) * 2) = f2bf(gelu_tanh(acc[rt][i] + pb)); }
        __syncthreads();
        { const int rt = wv & 1, ct = wv >> 1; f32x4v o = (f32x4v){0.f, 0.f, 0.f, 0.f};
#pragma unroll
          for (int st = 0; st < 4; ++st) { const s16x8 afr = *(const LAS s16x8*)(hidl + ((16 * rt + fr) * 136 + 32 * st + 8 * fq) * 2); const s16x8 bfr = *(const s16x8*)(W2T + (size_t)(16 * ct + fr) * CMP_HID + 32 * st + 8 * fq);
              o = __builtin_amdgcn_mfma_f32_16x16x32_bf16(afr, bfr, o, 0, 0, 0); }
#pragma unroll
          for (int i = 0; i < 4; ++i) { const int cr = c0 + 16 * rt + 4 * fq + i; OUT[(size_t)cr * 64 + 16 * ct + fr] = (cr < N_CMP) ? f2bf(o[i]) : (bf16)0; } }
    }
}

__device__ __forceinline__ void phase_moe_route(Ctx c, int stage) {
    KArgs ka = kargs();
    unsigned char* ws = CA_WS; int* TOPE = (int*)(ws + MS_TOPE); float* TOPG = (float*)(ws + MS_TOPG); int* UCNT = (int*)(ws + MS_UCNT);
    const float* RW = CA_IN(I_ROUTER_W); const float* gn = CA_IN(I_FFN_NORM) + 1 * D_;
    LAS int* cnt = (LAS int*)c.lds;
    for (int u = c.bid; u < 256; u += c.nblk) {
        if (c.tid < 16) cnt[c.tid] = 0;
        __syncthreads();
        for (int i = 0; i < 16; ++i) {
            const int m = u * 128 + c.wave * 16 + i;
            const float rs = row_rs(c.SSP, stage, m);
            float lg[8] = {0, 0, 0, 0, 0, 0, 0, 0};
            for (int j = 0; j < 16; ++j) { const int k = c.lane + 64 * j; const float hv = bf2f(c.XB[(size_t)m * D_ + k]) * rs * gn[k]; const f32x4 w0 = *(const f32x4*)(RW + (size_t)k * 8), w1 = *(const f32x4*)(RW + (size_t)k * 8 + 4);
                lg[0] = fmaf(hv, w0.x, lg[0]); lg[1] = fmaf(hv, w0.y, lg[1]); lg[2] = fmaf(hv, w0.z, lg[2]); lg[3] = fmaf(hv, w0.w, lg[3]);
                lg[4] = fmaf(hv, w1.x, lg[4]); lg[5] = fmaf(hv, w1.y, lg[5]); lg[6] = fmaf(hv, w1.z, lg[6]); lg[7] = fmaf(hv, w1.w, lg[7]); }
#pragma unroll
            for (int e = 0; e < 8; ++e) lg[e] = wave_sum(lg[e], c.lane);
            int e0 = 0; float l0 = lg[0];
#pragma unroll
            for (int e = 1; e < 8; ++e) if (lg[e] > l0) { l0 = lg[e]; e0 = e; }
            int e1 = -1; float l1 = -INFINITY;
#pragma unroll
            for (int e = 0; e < 8; ++e) if (e != e0 && lg[e] > l1) { l1 = lg[e]; e1 = e; }
            const float z = __expf(l1 - l0), g0 = 1.f / (1.f + z), g1 = z / (1.f + z);
            if (c.lane == 0) { TOPE[m * 2] = e0; TOPE[m * 2 + 1] = e1; TOPG[m * 2] = g0; TOPG[m * 2 + 1] = g1; __hip_atomic_fetch_add(&cnt[e0], 1, __ATOMIC_RELAXED, __HIP_MEMORY_SCOPE_WORKGROUP); __hip_atomic_fetch_add(&cnt[8 + e1], 1, __ATOMIC_RELAXED, __HIP_MEMORY_SCOPE_WORKGROUP); }
        }
        __syncthreads();
        if (c.tid < 16) UCNT[c.tid * 256 + u] = cnt[c.tid];
        __syncthreads();
    }
}
__device__ __forceinline__ int wave_sum_i(int v, int lane) {
#pragma unroll
    for (int o = 1; o < 64; o <<= 1) v += shxi(v, o, lane);
    return v;
}
__device__ __forceinline__ void phase_moe_slots(Ctx c, int stage) {
    KArgs ka = kargs();
    unsigned char* ws = CA_WS; const int* TOPE = (const int*)(ws + MS_TOPE); const float* TOPG = (const float*)(ws + MS_TOPG); const int* UCNT = (const int*)(ws + MS_UCNT);
    int* SLOT_TOK = (int*)(ws + MS_SLOTTOK); float* SLOT_G = (float*)(ws + MS_SLOTG); float* SLOT_RS = (float*)(ws + MS_SLOTRS); int* PANEL_E = (int*)(ws + MS_PANELE);
    LAS int* sh = (LAS int*)c.lds;
    typedef int i32x4 __attribute__((ext_vector_type(4)));
    i32x4 cv[2];
#pragma unroll
    for (int j = 0; j < 2; ++j) { cv[j] = *(const i32x4*)(UCNT + (c.wave + 8 * j) * 256 + 4 * c.lane); const int t = wave_sum_i((cv[j].x + cv[j].y) + (cv[j].z + cv[j].w), c.lane); if (c.lane == 0) sh[c.wave + 8 * j] = t; }
    __syncthreads();
    if (c.tid == 0) { int ps = 0; for (int e = 0; e < 16; ++e) { sh[16 + e] = ps; ps += (sh[e] + 255) / 256 * 256; } sh[48] = ps; }
    __syncthreads();
    for (int s2 = c.bid * NTHR + c.tid; s2 < NSLOT; s2 += c.nblk * NTHR) {
        int gi = 15; for (int k = 0; k < 16; ++k) { if (s2 >= sh[16 + k] && s2 < sh[16 + k] + (sh[k] + 255) / 256 * 256) { gi = k; break; } }
        const bool used = s2 < sh[48];
        const bool real = used && (s2 - sh[16 + gi]) < sh[gi];
        if (!real) { SLOT_TOK[s2] = -1; SLOT_G[s2] = 0.f; SLOT_RS[s2] = 0.f; }
        if ((s2 & 255) == 0) PANEL_E[s2 >> 8] = used ? (gi & 7) : -1;
    }
    if (c.bid == 0 && c.tid == 0) { PANEL_E[300] = sh[16 + 8] >> 8; PANEL_E[301] = sh[48] >> 8; }
    for (int u = c.bid; u < 256; u += c.nblk) {
        __syncthreads();
#pragma unroll
        for (int j = 0; j < 2; ++j) { const int u4 = 4 * c.lane; const int bsum = (u4 < u ? cv[j].x : 0) + (u4 + 1 < u ? cv[j].y : 0) + (u4 + 2 < u ? cv[j].z : 0) + (u4 + 3 < u ? cv[j].w : 0);
            const int t = wave_sum_i(bsum, c.lane); if (c.lane == 0) sh[32 + c.wave + 8 * j] = t; }
        int rank = 0, e = -1, k = 0, m = 0;
        if (c.wave < 4) { k = c.wave >> 1; m = u * 128 + (c.wave & 1) * 64 + c.lane; e = TOPE[m * 2 + k];
            const unsigned long long below = (c.lane == 0) ? 0ull : (~0ull >> (64 - c.lane));
#pragma unroll
            for (int e2 = 0; e2 < 8; ++e2) { const unsigned long long mk = __ballot(e == e2); if (e == e2) rank = __builtin_popcountll(mk & below); if (c.lane == 0) sh[64 + c.wave * 8 + e2] = __builtin_popcountll(mk); } }
        __syncthreads();
        if (c.wave < 4) { if (c.wave & 1) rank += sh[64 + (c.wave - 1) * 8 + e];
            const int gi = 8 * k + e, s2 = sh[16 + gi] + sh[32 + gi] + rank;
            SLOT_TOK[s2] = m; SLOT_G[s2] = TOPG[m * 2 + k] * (1.f / (W8_SCALE * ACT8_SCALE)); SLOT_RS[s2] = row_rs(c.SSP, stage, m) * (1.f / (W8_SCALE * X8_SCALE)); }
    }
}
constexpr int N_IN_PAD = 2560;
constexpr int TR_BUF = 8 * 264;
template <class AF>
__device__ __forceinline__ void tr_issue(AF ap, int k0, int n0, LAS float* buf, int lane) {
    const int r8 = lane >> 3, c4 = 4 * (lane & 7);
#pragma unroll
    for (int i = 0; i < 8; ++i) __builtin_amdgcn_global_load_lds((const unsigned*)ap(k0 + 8 * i + r8, n0 + c4), (LAS unsigned*)(buf + i * 264), 16, 0, 0);
}
#define TR_RD(dst, off) asm volatile("ds_read_b32 %0, %1 offset:" #off : "=v"(dst) : "v"(la))
template <bool F8, class CF>
__device__ __forceinline__ void tr_finish(f32x4 g0, f32x4 g1, const LAS float* gl, CF cm, bf16* WT, int ldt, int k0, int n0, const LAS float* buf, int lane) {
    const int cch = lane & 7, nr = lane >> 3;
    const unsigned la = (unsigned)(size_t)(buf + cch * 264 + nr);
    float v[4][8];
    TR_RD(v[0][0], 0);  TR_RD(v[0][1], 128);  TR_RD(v[0][2], 256);  TR_RD(v[0][3], 384);  TR_RD(v[0][4], 512);  TR_RD(v[0][5], 640);  TR_RD(v[0][6], 768);  TR_RD(v[0][7], 896);
    TR_RD(v[1][0], 32); TR_RD(v[1][1], 160);  TR_RD(v[1][2], 288);  TR_RD(v[1][3], 416);  TR_RD(v[1][4], 544);  TR_RD(v[1][5], 672);  TR_RD(v[1][6], 800);  TR_RD(v[1][7], 928);
    TR_RD(v[2][0], 64); TR_RD(v[2][1], 192);  TR_RD(v[2][2], 320);  TR_RD(v[2][3], 448);  TR_RD(v[2][4], 576);  TR_RD(v[2][5], 704);  TR_RD(v[2][6], 832);  TR_RD(v[2][7], 960);
    TR_RD(v[3][0], 96); TR_RD(v[3][1], 224);  TR_RD(v[3][2], 352);  TR_RD(v[3][3], 480);  TR_RD(v[3][4], 608);  TR_RD(v[3][5], 736);  TR_RD(v[3][6], 864);  TR_RD(v[3][7], 992);
    if (gl) { const unsigned ga = (unsigned)(size_t)(gl + k0 + 8 * cch); asm volatile("ds_read_b128 %0, %1" : "=v"(g0) : "v"(ga)); asm volatile("ds_read_b128 %0, %1 offset:16" : "=v"(g1) : "v"(ga)); }
    asm volatile("s_waitcnt lgkmcnt(0)" ::: "memory"); __builtin_amdgcn_sched_barrier(0);
#pragma unroll
    for (int j = 0; j < 4; ++j) { const int n = nr + 8 * j; const float m = cm(n0 + n);
        if constexpr (F8) { int w0 = 0, w1 = 0;
            w0 = __builtin_amdgcn_cvt_pk_fp8_f32(g0.x * v[j][0] * m, g0.y * v[j][1] * m, w0, false); w0 = __builtin_amdgcn_cvt_pk_fp8_f32(g0.z * v[j][2] * m, g0.w * v[j][3] * m, w0, true);
            w1 = __builtin_amdgcn_cvt_pk_fp8_f32(g1.x * v[j][4] * m, g1.y * v[j][5] * m, w1, false); w1 = __builtin_amdgcn_cvt_pk_fp8_f32(g1.z * v[j][6] * m, g1.w * v[j][7] * m, w1, true);
            *(u32x2*)((unsigned char*)WT + (size_t)(n0 + n) * ldt + k0 + 8 * cch) = (u32x2){(unsigned)w0, (unsigned)w1}; }
        else {
        u32x4 o; o.x = pk2(g0.x * v[j][0] * m, g0.y * v[j][1] * m); o.y = pk2(g0.z * v[j][2] * m, g0.w * v[j][3] * m); o.z = pk2(g1.x * v[j][4] * m, g1.y * v[j][5] * m); o.w = pk2(g1.z * v[j][6] * m, g1.w * v[j][7] * m);
        *(u32x4*)(WT + (size_t)(n0 + n) * ldt + k0 + 8 * cch) = o; } }
}
#undef TR_RD
constexpr int TR_GAIN_OFF = NWAVES * 2 * TR_BUF;
static_assert((TR_GAIN_OFF + 1024) * 4 <= LDS_WORK, "conversion LDS map");
template <bool F8 = false, class AF, class GF, class CF>
__device__ __forceinline__ void transpose_matrix(Ctx& c, AF ap, GF gk, CF cm, bf16* WT, int K, int Nd, int& it0) {
    const int gw = c.bid * NWAVES + c.wave, NGW = c.nblk * NWAVES, nnb = Nd / 32, nkb = K / 64, nit = nkb * nnb;
    const bool grouped = (nnb % 8) == 0;
    const int NG8 = nnb >> 3, G = nkb * NG8, CH = (G + c.nblk - 1) / c.nblk;
    const int cu = (c.bid + c.nblk - (it0 >> 3) % c.nblk) % c.nblk, base = cu * CH;
    const int first = (gw - it0 % NGW + NGW) % NGW;
    const int cnt = grouped ? (base >= G ? 0 : (G - base < CH ? G - base : CH)) : (first < nit ? (nit - 1 - first) / NGW + 1 : 0);
    LAS float* scr = c.lds + c.wave * (2 * TR_BUF);
    const LAS float* gl = nullptr;
    if (gk(0) != nullptr) {
        LAS float* gw_ = c.lds + TR_GAIN_OFF;
        __syncthreads();
        if (c.tid < K / 4 && K <= 1024) *(LAS f32x4*)(gw_ + 4 * c.tid) = *(const f32x4*)gk(4 * c.tid);
        __syncthreads();
        gl = gw_;
    }
    int sq = 0, pb = 0; bool fst = true;
#define TR_DECODE(s_, k0_, n0_) do { if (grouped) { const int L_ = base + (s_); k0_ = 64 * (L_ % nkb); n0_ = 32 * ((L_ / nkb) * 8 + c.wave); } else { const int it_ = first + (s_) * NGW; k0_ = 64 * (it_ / nnb); n0_ = 32 * (it_ % nnb); } } while (0)
    const f32x4 one4 = (f32x4){1.f, 1.f, 1.f, 1.f};
    if (cnt > 0) { int k0, n0; TR_DECODE(0, k0, n0); tr_issue(ap, k0, n0, scr, c.lane); }
    while (sq < cnt) {
        int k0, n0; TR_DECODE(sq, k0, n0);
        if (sq + 1 < cnt) { int k1, n1; TR_DECODE(sq + 1, k1, n1); tr_issue(ap, k1, n1, scr + (pb ^ 1) * TR_BUF, c.lane);
            if (fst) asm volatile("s_waitcnt vmcnt(8)" ::: "memory"); else asm volatile("s_waitcnt vmcnt(12)" ::: "memory"); }
        else { if (fst) asm volatile("s_waitcnt vmcnt(0)" ::: "memory"); else asm volatile("s_waitcnt vmcnt(4)" ::: "memory"); }
        tr_finish<F8>(one4, one4, gl, cm, WT, K, k0, n0, scr + pb * TR_BUF, c.lane);
        fst = false; ++sq; pb ^= 1;
    }
#undef TR_DECODE
    it0 += grouped ? 8 * ((G + CH - 1) / CH) : nit;
}
template <int PART>
__device__ __forceinline__ void phase_convert(Ctx c) {
    KArgs ka = kargs(); unsigned char* ws = CA_WS; int it0 = 0;
    auto one = [](int) { return 1.f; }; auto nog = [](int) { return (const float*)nullptr; };
    for (int L = 0; L < DEPTH; ++L) {
        if ((L == 0) == (PART == 0))
        { const float* W = CA_IN(I_W_IN) + (size_t)L * D_ * IN_COLS; const float* gn = CA_IN(I_ATTN_NORM) + L * D_;
          auto scol = [](int n) { return n < 1280 ? n : (n < 1792 ? C_XR + (n - 1280) : (n < 2304 ? C_YG + (n - 1792) : (n < 2328 ? C_G + (n - 2304) : -1))); };
          transpose_matrix(c, [=](int k, int n) { const int sc = scol(n); return W + (size_t)k * IN_COLS + (sc < 0 ? 0 : sc); }, [=](int k) { return gn + k; }, [=](int n) { return scol(n) < 0 ? 0.f : 1.f; },
                           (bf16*)(ws + WB_IN) + (size_t)L * N_IN_PAD * D_, D_, N_IN_PAD, it0); }
        if (PART == 1) {
        { const float* W = CA_IN(I_W_OUT) + (size_t)L * D_ * D_; const float* ga = CA_IN(I_OUT_NORM_ATTN) + L * 512; const float* gr = CA_IN(I_OUT_NORM_REC) + L * 512;
          transpose_matrix(c, [=](int k, int n) { return W + (size_t)k * D_ + n; }, [=](int k) { return k < 512 ? ga + k : gr + (k - 512); }, one, (bf16*)(ws + WB_OUT) + (size_t)L * D_ * D_, D_, D_, it0); }
        { const float* W = CA_IN(I_PLE_WG) + (size_t)L * D_ * D_; const float* gn = CA_IN(I_PLE_NORM) + L * D_;
          transpose_matrix(c, [=](int k, int n) { return W + (size_t)k * D_ + n; }, [=](int k) { return gn + k; }, one, (bf16*)(ws + WB_PLEG) + (size_t)L * D_ * D_, D_, D_, it0); }
        { const float* W = CA_IN(I_PLE_WP) + (size_t)L * PLE_DIM * D_;
          transpose_matrix(c, [=](int k, int n) { return W + (size_t)k * D_ + n; }, nog, one, (bf16*)(ws + WB_PLEP) + (size_t)L * D_ * PLE_DIM, PLE_DIM, D_, it0); }
        }
    }
    if (PART == 1) {
    { const float* WG = CA_IN(I_DENSE_WG); const float* WU = CA_IN(I_DENSE_WU); const float* gn = CA_IN(I_FFN_NORM);
      transpose_matrix(c, [=](int k, int n) { const int col = 128 * (n >> 8) + (n & 127); return ((n >> 7) & 1 ? WU : WG) + (size_t)k * D_FF + col; }, [=](int k) { return gn + k; }, one, (bf16*)(ws + WB_GU), D_, 2 * D_FF, it0); }
    { const float* WD = CA_IN(I_DENSE_WD);
      transpose_matrix<true>(c, [=](int k, int n) { return WD + (size_t)k * D_ + n; }, nog, [](int) { return W8_SCALE; }, (bf16*)(ws + WB_DN), D_FF, D_, it0); }
    { const float* WG = CA_IN(I_MOE_WG); const float* WU = CA_IN(I_MOE_WU); const float* gn = CA_IN(I_FFN_NORM) + D_;
      transpose_matrix<true>(c, [=](int k, int n) { const int e = n / (2 * D_FFE), nn = n % (2 * D_FFE), col = 128 * (nn >> 8) + (nn & 127); return ((nn >> 7) & 1 ? WU : WG) + (size_t)e * D_ * D_FFE + (size_t)k * D_FFE + col; },
                       [=](int k) { return gn + k; }, [](int) { return W8_SCALE; }, (bf16*)(ws + WB_MGU), D_, N_EXP * 2 * D_FFE, it0); }
    { const float* WD = CA_IN(I_MOE_WD);
      transpose_matrix<true>(c, [=](int k, int n) { const int e = n / D_, nn = n % D_; return WD + (size_t)e * D_FFE * D_ + (size_t)k * D_ + nn; }, nog, [](int) { return W8_SCALE; }, (bf16*)(ws + WB_MDN), D_FFE, N_EXP * D_, it0); }
    }
    if (PART == 0)
    for (int L = 0; L < DEPTH; ++L) {
        for (int kv = 0; kv < 2; ++kv) {
            const float* W1 = CA_IN(I_CMP_W1) + ((size_t)L * 2 + kv) * (L_CMP * HD) * CMP_HID; const float* W2 = CA_IN(I_CMP_W2) + ((size_t)L * 2 + kv) * CMP_HID * HD;
            transpose_matrix(c, [=](int k, int n) { return W1 + (size_t)k * CMP_HID + n; }, nog, one, (bf16*)(ws + WB_C1T) + ((size_t)L * 2 + kv) * CMP_HID * (L_CMP * HD), L_CMP * HD, CMP_HID, it0);
            transpose_matrix(c, [=](int k, int n) { return W2 + (size_t)k * HD + n; }, nog, one, (bf16*)(ws + WB_C2T) + ((size_t)L * 2 + kv) * HD * CMP_HID, CMP_HID, HD, it0);
        }
        for (int blk = 0; blk < 8; ++blk) {
            const float* WA = CA_IN(I_LRU_WA) + ((size_t)L * 8 + blk) * 4096; const float* WX = CA_IN(I_LRU_WX) + ((size_t)L * 8 + blk) * 4096;
            transpose_matrix(c, [=](int k, int n) { return WA + k * 64 + n; }, nog, one, (bf16*)(ws + WB_LWA) + ((size_t)L * 8 + blk) * 4096, 64, 64, it0);
            transpose_matrix(c, [=](int k, int n) { return WX + k * 64 + n; }, nog, one, (bf16*)(ws + WB_LWX) + ((size_t)L * 8 + blk) * 4096, 64, 64, it0);
        }
    }
    asm volatile("s_waitcnt vmcnt(0) lgkmcnt(0)" ::: "memory");
    if (PART == 0)
    { float* PP = (float*)(ws + WB_POSBP);
      for (int task = c.bid; task < DEPTH * 2 * 32; task += c.nblk) { const int lk = task >> 5, sl = task & 31;
          if (c.tid < CMP_HID) { const float* W1 = CA_IN(I_CMP_W1) + (size_t)lk * (L_CMP * HD) * CMP_HID + (size_t)sl * 64 * CMP_HID + c.tid; const float* POS = CA_IN(I_CMP_POS) + (size_t)lk * (L_CMP * HD) + sl * 64;
              float a = 0.f; for (int k = 0; k < 64; ++k) a = fmaf(POS[k], W1[(size_t)k * CMP_HID], a);
              PP[(size_t)task * CMP_HID + c.tid] = a; } } }
    if (PART == 1)
    { const float* P = CA_IN(I_P); bf16* PB = (bf16*)(ws + WS_PB); const size_t n8 = (size_t)DEPTH * NTOK * PLE_DIM / 8, step = (size_t)c.nblk * NTHR;
      for (size_t i = (size_t)c.bid * NTHR + c.tid; i < n8; i += 4 * step) {
          f32x4 a[4], b[4];
#pragma unroll
          for (int q = 0; q < 4; ++q) { a[q] = ((const f32x4*)P)[2 * (i + q * step)]; b[q] = ((const f32x4*)P)[2 * (i + q * step) + 1]; }
#pragma unroll
          for (int q = 0; q < 4; ++q) { u32x4 o; o.x = pk2(a[q].x, a[q].y); o.y = pk2(a[q].z, a[q].w); o.z = pk2(b[q].x, b[q].y); o.w = pk2(b[q].z, b[q].w); ((u32x4*)PB)[i + q * step] = o; } } }
}
static_assert(((size_t)DEPTH * NTOK * PLE_DIM / 8) % (4 * 256 * NTHR) == 0, "p cast loop");

__device__ __forceinline__ u32x4 pack8(const f32x4 a, const f32x4 b) { u32x4 w; w.x = pg8::cvt_pk_bf16(a[0], a[1]); w.y = pg8::cvt_pk_bf16(a[2], a[3]); w.z = pg8::cvt_pk_bf16(b[0], b[1]); w.w = pg8::cvt_pk_bf16(b[2], b[3]); return w; }
struct EpiInproj {
    static constexpr bool PERM = true, AFTER_DRAIN = false;
    const float* SSPs; unsigned char* ws;
    __device__ __forceinline__ void operator()(const f32x4 (&acc)[2][2][4][2], const pg8::Unit& u, int wr, int wc, int fr, int fq) const {
        const int row0 = u.pm * 256 + wr * 64 + fr, pn = u.pn, cw = wc * 32 + 8 * fq;
#pragma unroll
        for (int ai = 0; ai < 2; ++ai)
#pragma unroll
            for (int m = 0; m < 4; ++m) {
                const int r = row0 + ai * 128 + m * 16;
                const float rs = row_rs(SSPs, 0, r);
#pragma unroll
                for (int bj = 0; bj < 2; ++bj) {
                    f32x4 v0 = acc[ai][bj][m][0] * rs, v1 = acc[ai][bj][m][1] * rs;
                    if (pn < 2) { v0 = v0 * QSCALE; v1 = v1 * QSCALE; *(u32x4*)((bf16*)(ws + WS_Q) + (size_t)r * 512 + pn * 256 + bj * 128 + cw) = pack8(v0, v1); }
                    else if (pn < 5) { const int j = 2 * (pn - 2) + bj, g = cw >> 6, d = cw & 63, b = r / T_, t = r % T_;
                        *(u32x4*)((bf16*)(ws + WS_KV + j * KV_STRIDE) + (((size_t)b * NG + g) * T_ + t) * 64 + d) = pack8(v0, v1); }
                    else if (pn < 7) *(u32x4*)((bf16*)(ws + WS_XR) + (size_t)r * 512 + (pn - 5) * 256 + bj * 128 + cw) = pack8(v0, v1);
                    else if (pn < 9) *(u32x4*)((bf16*)(ws + WS_YG) + (size_t)r * 512 + (pn - 7) * 256 + bj * 128 + cw) = pack8(v0, v1);
                    else if (bj == 0 && cw < 24) { float* gp = (float*)(ws + WS_GATE) + (size_t)r * 24 + cw;
                        *(f32x4*)gp = (f32x4){sigmoidf_(v0[0]), sigmoidf_(v0[1]), sigmoidf_(v0[2]), sigmoidf_(v0[3])}; *(f32x4*)(gp + 4) = (f32x4){sigmoidf_(v1[0]), sigmoidf_(v1[1]), sigmoidf_(v1[2]), sigmoidf_(v1[3])}; }
                }
                asm volatile("" ::: "memory");
            }
    }
};
#define UNPK_LO(v_) ((f32x4){blo((v_).x), bhi((v_).x), blo((v_).y), bhi((v_).y)})
#define UNPK_HI(v_) ((f32x4){blo((v_).z), bhi((v_).z), blo((v_).w), bhi((v_).w)})
template <int MODE> struct EpiResid {
    static constexpr bool PERM = true, AFTER_DRAIN = false;
    const bf16* RIN; bf16* ROUT; float* SSPo; const float* SSPi; const bf16* PROJ;
    __device__ __forceinline__ void operator()(const f32x4 (&acc)[2][2][4][2], const pg8::Unit& u, int wr, int wc, int fr, int fq) const {
        const int row0 = u.pm * 256 + wr * 64 + fr, col0 = u.pn * 256 + wc * 32 + 8 * fq;
#pragma unroll
        for (int ai = 0; ai < 2; ++ai)
#pragma unroll
            for (int m = 0; m < 4; ++m) {
                const int r = row0 + ai * 128 + m * 16; float ss = 0.f; float rs = 1.f;
                if (MODE == 1) rs = row_rs(SSPi, 0, r);
#pragma unroll
                for (int bj = 0; bj < 2; ++bj) {
                    const size_t off = (size_t)r * D_ + col0 + bj * 128;
                    f32x4 a0 = acc[ai][bj][m][0], a1 = acc[ai][bj][m][1];
                    if (MODE == 1) { const u32x4 pw = *(const u32x4*)(PROJ + off);
                        a0 = (f32x4){sigmoidf_(a0[0] * rs) * __uint_as_float(pw.x << 16), sigmoidf_(a0[1] * rs) * __uint_as_float(pw.x & 0xffff0000u), sigmoidf_(a0[2] * rs) * __uint_as_float(pw.y << 16), sigmoidf_(a0[3] * rs) * __uint_as_float(pw.y & 0xffff0000u)};
                        a1 = (f32x4){sigmoidf_(a1[0] * rs) * __uint_as_float(pw.z << 16), sigmoidf_(a1[1] * rs) * __uint_as_float(pw.z & 0xffff0000u), sigmoidf_(a1[2] * rs) * __uint_as_float(pw.w << 16), sigmoidf_(a1[3] * rs) * __uint_as_float(pw.w & 0xffff0000u)}; }
                    const u32x4 xw = *(const u32x4*)(RIN + off);
                    const f32x4 x0 = UNPK_LO(xw) + a0, x1 = UNPK_HI(xw) + a1;
                    *(u32x4*)(ROUT + off) = pack8(x0, x1);
                    ss += ((x0[0] * x0[0] + x0[1] * x0[1]) + (x0[2] * x0[2] + x0[3] * x0[3])) + ((x1[0] * x1[0] + x1[1] * x1[1]) + (x1[2] * x1[2] + x1[3] * x1[3]));
                }
                { const int ln = fq * 16 + fr; ss += shx(ss, 16, ln); ss += shx(ss, 32, ln); }
                if (fq == 0) SSPo[(size_t)r * 16 + u.pn * 4 + wc] = ss;
                asm volatile("" ::: "memory");
            }
    }
};
template <> struct EpiResid<0> {
    static constexpr bool PERM = true, AFTER_DRAIN = false;
    const bf16* RIN; bf16* ROUT; float* SSPo; const float* SSPi; const bf16* PROJ; unsigned char* X8; float post;
    __device__ __forceinline__ void operator()(const f32x4 (&acc)[2][2][4][2], const pg8::Unit& u, int wr, int wc, int fr, int fq) const {
        const int row0 = u.pm * 256 + wr * 64 + fr, col0 = u.pn * 256 + wc * 32 + 8 * fq;
        u32x4 xb[2][2];
#pragma unroll
        for (int bj = 0; bj < 2; ++bj) xb[0][bj] = *(const u32x4*)(RIN + (size_t)row0 * D_ + col0 + bj * 128);
#pragma unroll
        for (int it = 0; it < 8; ++it) {
            const int ai = it >> 2, m = it & 3, r = row0 + ai * 128 + m * 16;
            if (it + 1 < 8) { const int rn = row0 + ((it + 1) >> 2) * 128 + ((it + 1) & 3) * 16;
#pragma unroll
                for (int bj = 0; bj < 2; ++bj) xb[(it + 1) & 1][bj] = *(const u32x4*)(RIN + (size_t)rn * D_ + col0 + bj * 128); }
            float ss = 0.f;
#pragma unroll
            for (int bj = 0; bj < 2; ++bj) {
                const size_t off = (size_t)r * D_ + col0 + bj * 128;
                const f32x4 x0 = UNPK_LO(xb[it & 1][bj]) + acc[ai][bj][m][0] * post, x1 = UNPK_HI(xb[it & 1][bj]) + acc[ai][bj][m][1] * post;
                *(u32x4*)(ROUT + off) = pack8(x0, x1);
                if (X8) { int w0 = 0, w1 = 0;
                    w0 = __builtin_amdgcn_cvt_pk_fp8_f32(x0[0] * X8_SCALE, x0[1] * X8_SCALE, w0, false); w0 = __builtin_amdgcn_cvt_pk_fp8_f32(x0[2] * X8_SCALE, x0[3] * X8_SCALE, w0, true);
                    w1 = __builtin_amdgcn_cvt_pk_fp8_f32(x1[0] * X8_SCALE, x1[1] * X8_SCALE, w1, false); w1 = __builtin_amdgcn_cvt_pk_fp8_f32(x1[2] * X8_SCALE, x1[3] * X8_SCALE, w1, true);
                    *(u32x2*)(X8 + off) = (u32x2){(unsigned)w0, (unsigned)w1}; }
                ss += ((x0[0] * x0[0] + x0[1] * x0[1]) + (x0[2] * x0[2] + x0[3] * x0[3])) + ((x1[0] * x1[0] + x1[1] * x1[1]) + (x1[2] * x1[2] + x1[3] * x1[3]));
            }
            { const int ln = fq * 16 + fr; ss += shx(ss, 16, ln); ss += shx(ss, 32, ln); }
            if (fq == 0) SSPo[(size_t)r * 16 + u.pn * 4 + wc] = ss;
            asm volatile("" ::: "memory");
        }
    }
};
template <bool F8> struct EpiSwiglu {
    static constexpr bool PERM = true, AFTER_DRAIN = false;
    bf16* ACT; int ldc; const float* SSPi; const float* ROWRS; float post;
    __device__ __forceinline__ void operator()(const f32x4 (&acc)[2][2][4][2], const pg8::Unit& u, int wr, int wc, int fr, int fq) const {
        const int row0 = u.pm * 256 + wr * 64 + fr, col0 = u.pn * 128 + wc * 32 + 8 * fq;
#pragma unroll
        for (int ai = 0; ai < 2; ++ai)
#pragma unroll
            for (int m = 0; m < 4; ++m) {
                const int r = row0 + ai * 128 + m * 16; const float rs = ROWRS ? ROWRS[r] : row_rs(SSPi, 0, r) * post;
                f32x4 o[2];
#pragma unroll
                for (int n = 0; n < 2; ++n) { const f32x4 g = acc[ai][0][m][n] * rs, up = acc[ai][1][m][n] * rs; o[n] = (f32x4){silu_(g[0]) * up[0], silu_(g[1]) * up[1], silu_(g[2]) * up[2], silu_(g[3]) * up[3]}; }
                if constexpr (F8) { int w0 = 0, w1 = 0;
#pragma unroll
                    for (int n = 0; n < 2; ++n)
#pragma unroll
                        for (int i = 0; i < 4; ++i) o[n][i] = __builtin_amdgcn_fmed3f(o[n][i] * ACT8_SCALE, -448.f, 448.f);
                    w0 = __builtin_amdgcn_cvt_pk_fp8_f32(o[0][0], o[0][1], w0, false); w0 = __builtin_amdgcn_cvt_pk_fp8_f32(o[0][2], o[0][3], w0, true);
                    w1 = __builtin_amdgcn_cvt_pk_fp8_f32(o[1][0], o[1][1], w1, false); w1 = __builtin_amdgcn_cvt_pk_fp8_f32(o[1][2], o[1][3], w1, true);
                    *(u32x2*)((unsigned char*)ACT + (size_t)r * ldc + col0) = (u32x2){(unsigned)w0, (unsigned)w1}; }
                else *(u32x4*)(ACT + (size_t)r * ldc + col0) = pack8(o[0], o[1]);
                asm volatile("" ::: "memory");
            }
    }
};
struct EpiPlain {
    static constexpr bool PERM = true, AFTER_DRAIN = false;
    bf16* O; int ldc;
    __device__ __forceinline__ void operator()(const f32x4 (&acc)[2][2][4][2], const pg8::Unit& u, int wr, int wc, int fr, int fq) const {
        const int row0 = u.pm * 256 + wr * 64 + fr, col0 = u.pn * 256 + wc * 32 + 8 * fq;
#pragma unroll
        for (int ai = 0; ai < 2; ++ai)
#pragma unroll
            for (int m = 0; m < 4; ++m)
#pragma unroll
                for (int bj = 0; bj < 2; ++bj) { *(u32x4*)(O + (size_t)(row0 + ai * 128 + m * 16) * ldc + col0 + bj * 128) = pack8(acc[ai][bj][m][0], acc[ai][bj][m][1]); asm volatile("" ::: "memory"); }
    }
};
#define GEMM_LDS(c) ((PG8_LAS unsigned char*)(c).lds)
struct SubOrder {
    pg8::StaticOrder S; int lo, hi;
    __device__ __forceinline__ bool next(int i, pg8::Unit& u) const { return (lo + i < hi) && S.next(lo + i, u); }
    __device__ __forceinline__ void a_ready(const pg8::Unit&) const {}
    __device__ __forceinline__ void done(const pg8::Unit&) const {}
};
__device__ __forceinline__ void phase_inproj_mfma(Ctx c, int L, int stage, int ulo = 0, int uhi = 1 << 20) {
    KArgs ka = kargs(); unsigned char* ws = CA_WS;
    pg8::Gemm g{(const pg8::bf16_t*)(L == 0 ? c.XB : c.XO),
 (const pg8::bf16_t*)((bf16*)(ws + WB_IN) + (size_t)L * N_IN_PAD * D_), NTOK, N_IN_PAD, D_, nullptr, 0, 0, 0}; pg8::StaticOrder S; S.init(NTOK, N_IN_PAD, c.nblk, c.bid);
    EpiInproj E{c.SSP + (size_t)stage * NTOK * 16, ws};
    SubOrder SS{S, ulo, uhi};
    pg8::gemm_phase<EpiInproj, SubOrder, true, true>(GEMM_LDS(c), g, SS, E, c.tid);
}
__device__ __forceinline__ void phase_outproj_mfma(Ctx c, int L, int stage_out) {
    KArgs ka = kargs(); unsigned char* ws = CA_WS;
    pg8::Gemm g{(const pg8::bf16_t*)(ws + WS_MIXED), (const pg8::bf16_t*)((bf16*)(ws + WB_OUT) + (size_t)L * D_ * D_), NTOK, D_, D_, nullptr, 0, 0, 0}; pg8::StaticOrder S; S.init(NTOK, D_, c.nblk, c.bid);
    EpiResid<0> E{(L == 0) ? c.XB : c.XO, c.XB, c.SSP + (size_t)stage_out * NTOK * 16, nullptr, nullptr, (L == 1) ? (unsigned char*)ka->out + X8_OFF : (unsigned char*)nullptr, 1.f};
    pg8::gemm_phase<EpiResid<0>, pg8::StaticOrder, true, true>(GEMM_LDS(c), g, S, E, c.tid);
}
__device__ __forceinline__ void phase_ffn_gu_mfma(Ctx c, int stage) {
    KArgs ka = kargs(); unsigned char* ws = CA_WS;
    pg8::Gemm g{(const pg8::bf16_t*)c.XB, (const pg8::bf16_t*)(ws + WB_GU), NTOK, 2 * D_FF, D_, nullptr, 0, 0, 0}; pg8::StaticOrder S; S.init(NTOK, 2 * D_FF, c.nblk, c.bid);
    EpiSwiglu<true> E{(bf16*)(ws + WS_ACT), D_FF, c.SSP + (size_t)stage * NTOK * 16, nullptr, 1.f};
    pg8::gemm_phase<EpiSwiglu<true>, pg8::StaticOrder, true, true>(GEMM_LDS(c), g, S, E, c.tid);
}
__device__ __forceinline__ void phase_ffn_dn_mfma(Ctx c, int stage_out) {
    KArgs ka = kargs(); unsigned char* ws = CA_WS;
    pg8::Gemm g{(const pg8::bf16_t*)(ws + WS_ACT), (const pg8::bf16_t*)(ws + WB_DN), NTOK, D_, D_FF / 2, nullptr, 0, 0, 0}; pg8::StaticOrder S; S.init(NTOK, D_, c.nblk, c.bid);
    EpiResid<0> E{c.XB, c.XB, c.SSP + (size_t)stage_out * NTOK * 16, nullptr, nullptr, nullptr, 1.f / (W8_SCALE * ACT8_SCALE)};
    pg8::gemm_phase<EpiResid<0>, pg8::StaticOrder, true, true, pg8::RowsIdent, true>(GEMM_LDS(c), g, S, E, c.tid);
}
__device__ __forceinline__ void phase_ple_proj_mfma(Ctx c, int L) {
    KArgs ka = kargs(); unsigned char* ws = CA_WS;
    pg8::Gemm g{(const pg8::bf16_t*)((bf16*)(ws + WS_PB) + (size_t)L * NTOK * PLE_DIM), (const pg8::bf16_t*)((bf16*)(ws + WB_PLEP) + (size_t)L * D_ * PLE_DIM), NTOK, D_, PLE_DIM, nullptr, 0, 0, 0}; pg8::StaticOrder S; S.init(NTOK, D_, c.nblk, c.bid);
    EpiPlain E{(bf16*)(ws + WS_PROJ), D_};
    pg8::gemm_phase<EpiPlain, pg8::StaticOrder, true, true>(GEMM_LDS(c), g, S, E, c.tid);
}
__device__ __forceinline__ void phase_ple_mfma(Ctx c, int L, int stage_in, int stage_out) {
    KArgs ka = kargs(); unsigned char* ws = CA_WS;
    pg8::Gemm g{(const pg8::bf16_t*)c.XB, (const pg8::bf16_t*)((bf16*)(ws + WB_PLEG) + (size_t)L * D_ * D_), NTOK, D_, D_, nullptr, 0, 0, 0}; pg8::StaticOrder S; S.init(NTOK, D_, c.nblk, c.bid);
    EpiResid<1> E{c.XB, (L + 1 < DEPTH) ? c.XO : (bf16*)(ws + WS_MIXED), c.SSP + (size_t)stage_out * NTOK * 16, c.SSP + (size_t)stage_in * NTOK * 16, (const bf16*)(ws + WS_PROJ)};
    pg8::gemm_phase<EpiResid<1>, pg8::StaticOrder, true, true>(GEMM_LDS(c), g, S, E, c.tid);
}

struct MoeOrder {
    pg8::StaticOrder S; int p_lo;
    __device__ __forceinline__ MoeOrder(int p_lo_, int np, int nN, int G, int c) : p_lo(p_lo_) { S.init(np * 256, nN * 256, G, c); }
    __device__ __forceinline__ bool next(int i, pg8::Unit& u) const { if (!S.next(i, u)) return false; u.pm += p_lo; return true; }
    __device__ __forceinline__ void a_ready(const pg8::Unit&) const {}
    __device__ __forceinline__ void done(const pg8::Unit&) const {}
};
template <bool LAST> struct EpiMoeDn {
    static constexpr bool PERM = true, AFTER_DRAIN = false;
    const bf16* RIN; bf16* ROUT; float* SSPo; const int* SLOT_TOK; const float* SLOT_G;
    __device__ __forceinline__ void operator()(const f32x4 (&acc)[2][2][4][2], const pg8::Unit& u, int wr, int wc, int fr, int fq) const {
        const int row0 = u.pm * 256 + wr * 64 + fr, col0 = u.pn * 256 + wc * 32 + 8 * fq, ln = fq * 16 + fr;
#pragma unroll
        for (int ai = 0; ai < 2; ++ai)
#pragma unroll
            for (int m = 0; m < 4; ++m) {
                const int r = row0 + ai * 128 + m * 16; const int tok = SLOT_TOK[r]; const float g = SLOT_G[r]; float ss = 0.f;
                if (tok >= 0) {
#pragma unroll
                    for (int bj = 0; bj < 2; ++bj) {
                        const size_t off = (size_t)tok * D_ + col0 + bj * 128;
                        const u32x4 xw = *(const u32x4*)(RIN + off);
                        const f32x4 x0 = UNPK_LO(xw) + acc[ai][bj][m][0] * g, x1 = UNPK_HI(xw) + acc[ai][bj][m][1] * g;
                        *(u32x4*)(ROUT + off) = pack8(x0, x1);
                        if (LAST) ss += ((x0[0] * x0[0] + x0[1] * x0[1]) + (x0[2] * x0[2] + x0[3] * x0[3])) + ((x1[0] * x1[0] + x1[1] * x1[1]) + (x1[2] * x1[2] + x1[3] * x1[3]));
                    }
                }
                if (LAST) { ss += shx(ss, 16, ln); ss += shx(ss, 32, ln); if (fq == 0 && tok >= 0) SSPo[(size_t)tok * 16 + u.pn * 4 + wc] = ss; }
                asm volatile("" ::: "memory");
            }
    }
};
__device__ __forceinline__ void phase_moe_gu_mfma(Ctx c, int k) {
    KArgs ka = kargs(); unsigned char* ws = CA_WS; const int* PANEL_E = (const int*)(ws + MS_PANELE);
    const int P0 = PANEL_E[300], PT = PANEL_E[301], p_lo = k ? P0 : 0, np = k ? PT - P0 : P0;
    pg8::Gemm g{(const pg8::bf16_t*)((unsigned char*)ka->out + X8_OFF), (const pg8::bf16_t*)(ws + WB_MGU), NSLOT, 2 * D_FFE, D_ / 2, PANEL_E, (size_t)2 * D_FFE * (D_ / 2), 0, 0};
    MoeOrder S(p_lo, np, 2 * D_FFE / 256, c.nblk, c.bid);
    EpiSwiglu<true> E{(bf16*)(ws + WS_ACT - (size_t)p_lo * 256 * D_FFE), D_FFE, nullptr, (const float*)(ws + MS_SLOTRS), 1.f};
    pg8::gemm_phase<EpiSwiglu<true>, MoeOrder, true, true, pg8::RowsGather, true>(GEMM_LDS(c), g, S, E, c.tid, pg8::RowsGather{(const int*)(ws + MS_SLOTTOK)});
}
struct TailOrder {
    int p_first, nunits, G, c;
    __device__ __forceinline__ bool next(int i, pg8::Unit& u) const { const int L = i * G + c; if (L >= nunits) return false; u.pm = p_first + L / (4 * DN_KSPLIT); u.pn = (L / DN_KSPLIT) & 3; u.kofs = (L % DN_KSPLIT) * DN_KSLICE_P; return true; }
    __device__ __forceinline__ void a_ready(const pg8::Unit&) const {}
    __device__ __forceinline__ void done(const pg8::Unit&) const {}
};
struct EpiPartial {
    static constexpr bool PERM = true, AFTER_DRAIN = false;
    float* PART; int p_first;
    __device__ __forceinline__ void operator()(const f32x4 (&acc)[2][2][4][2], const pg8::Unit& u, int wr, int wc, int fr, int fq) const {
        float* T = PART + (size_t)((((u.pm - p_first) * 4 + u.pn) * DN_KSPLIT) + u.kofs / DN_KSLICE_P) * 65536;
#pragma unroll
        for (int ai = 0; ai < 2; ++ai)
#pragma unroll
            for (int m = 0; m < 4; ++m)
#pragma unroll
                for (int bj = 0; bj < 2; ++bj) { float* p = T + (size_t)(ai * 128 + wr * 64 + m * 16 + fr) * 256 + bj * 128 + wc * 32 + 8 * fq; *(f32x4*)p = acc[ai][bj][m][0]; *(f32x4*)(p + 4) = acc[ai][bj][m][1]; asm volatile("" ::: "memory"); }
    }
};
template <bool LAST>
__device__ __forceinline__ void phase_moe_dn_mfma(Ctx c, int k, int stage_out) {
    KArgs ka = kargs(); unsigned char* ws = CA_WS; const int* PANEL_E = (const int*)(ws + MS_PANELE);
    const int P0 = PANEL_E[300], PT = PANEL_E[301], p_lo = k ? P0 : 0, np = k ? PT - P0 : P0;
    const int nmain = np < DN_MAIN_PANELS ? np : DN_MAIN_PANELS, ntail = np - nmain;
    const pg8::bf16_t* A = (const pg8::bf16_t*)(ws + WS_ACT - (size_t)p_lo * 256 * D_FFE);
    { pg8::Gemm g{A, (const pg8::bf16_t*)(ws + WB_MDN), NSLOT, D_, D_FFE / 2, PANEL_E, (size_t)D_ * (D_FFE / 2), 0, 0};
      MoeOrder S(p_lo, nmain, D_ / 256, c.nblk, c.bid);
      EpiMoeDn<LAST> E{LAST ? c.XO : c.XB, LAST ? c.XB : c.XO, c.SSP + (size_t)stage_out * NTOK * 16, (const int*)(ws + MS_SLOTTOK), (const float*)(ws + MS_SLOTG)};
      pg8::gemm_phase<EpiMoeDn<LAST>, MoeOrder, true, true, pg8::RowsIdent, true>(GEMM_LDS(c), g, S, E, c.tid); }
    if (ntail > 0) {
      pg8::Gemm g{A, (const pg8::bf16_t*)(ws + WB_MDN), NSLOT, D_, DN_KSLICE_P, PANEL_E, (size_t)D_ * (D_FFE / 2), D_FFE / 2, D_FFE / 2};
      TailOrder S{p_lo + nmain, ntail * 4 * DN_KSPLIT, c.nblk, c.bid};
      EpiPartial E{(float*)(ws + WS_PART), p_lo + nmain};
      pg8::gemm_phase<EpiPartial, TailOrder, true, true, pg8::RowsIdent, true>(GEMM_LDS(c), g, S, E, c.tid); }
}
template <bool LAST>
__device__ __forceinline__ void phase_moe_dn_reduce(Ctx c, int k, int stage_out) {
    KArgs ka = kargs(); unsigned char* ws = CA_WS; const int* PANEL_E = (const int*)(ws + MS_PANELE);
    const int P0 = PANEL_E[300], PT = PANEL_E[301], p_lo = k ? P0 : 0, np = k ? PT - P0 : P0;
    const int nmain = np < DN_MAIN_PANELS ? np : DN_MAIN_PANELS, ntail = np - nmain;
    const float* PART = (const float*)(ws + WS_PART); const int* SLOT_TOK = (const int*)(ws + MS_SLOTTOK); const float* SLOT_G = (const float*)(ws + MS_SLOTG);
    float* SSPo = c.SSP + (size_t)stage_out * NTOK * 16;
    const int gw = c.bid * NWAVES + c.wave, NGW = c.nblk * NWAVES, nitem = ntail * 4 * 256;
    for (int it = gw; it < nitem; it += NGW) {
        const int tt = it >> 8, r = it & 255, tp = tt >> 2, pn = tt & 3; const int slot = (p_lo + nmain + tp) * 256 + r; const int tok = SLOT_TOK[slot];
        if (tok < 0) continue;
        const float g = SLOT_G[slot];
        f32x4 y = (f32x4){0.f, 0.f, 0.f, 0.f};
#pragma unroll
        for (int ks = 0; ks < DN_KSPLIT; ++ks) y += *(const f32x4*)(PART + ((size_t)(tt * DN_KSPLIT + ks) * 256 + r) * 256 + 4 * c.lane);
        const size_t off = (size_t)tok * D_ + pn * 256 + 4 * c.lane;
        const u32x2 xw = *(const u32x2*)((LAST ? c.XO : c.XB) + off);
        const f32x4 x = (f32x4){blo(xw.x), bhi(xw.x), blo(xw.y), bhi(xw.y)} + y * g;
        { u32x2 w; w.x = pk2(x[0], x[1]); w.y = pk2(x[2], x[3]); *(u32x2*)((LAST ? c.XB : c.XO) + off) = w; }
        if (LAST) {
            float ss = (x[0] * x[0] + x[1] * x[1]) + (x[2] * x[2] + x[3] * x[3]);
            ss += shx(ss, 1, c.lane); ss += shx(ss, 2, c.lane); ss += shx(ss, 4, c.lane); ss += shx(ss, 8, c.lane);
            if ((c.lane & 15) == 0) SSPo[(size_t)tok * 16 + pn * 4 + (c.lane >> 4)] = ss; }
    }
}

__global__ void __launch_bounds__(NTHR, 2) fwd_kernel(Args args) {
    extern __shared__ __attribute__((aligned(16))) unsigned char lds_raw[];
    Ctx c; c.lds = (LAS float*)lds_raw; c.tid = threadIdx.x; c.lane = c.tid & 63; c.wave = __builtin_amdgcn_readfirstlane(c.tid >> 6); c.bid = blockIdx.x; c.nblk = gridDim.x;
    { KArgs k0 = kargs(); c.XO = (bf16*)k0->out; c.XB = (bf16*)(k0->ws + WS_XB); c.SSP = (float*)(k0->ws + WS_SSP); }
    volatile LAS unsigned* MISC = (volatile LAS unsigned*)((LAS unsigned char*)lds_raw + MISC_OFF);
    for (int u = c.tid; u < (LDS_BYTES - LDSCTL_OFF) / 4; u += NTHR) ((LAS unsigned*)((LAS unsigned char*)lds_raw + LDSCTL_OFF))[u] = 0u;
    __syncthreads();
    KArgs kb = kargs();
    (void)xcd_barrier_post((unsigned*)(kb->ws + WS_CTL) + CW_BAR, MISC + 8, c.tid == 0);
#define BAR() do { KArgs kq = kargs(); xcd_barrier((unsigned*)(kq->ws + WS_CTL) + CW_BAR, MISC + 8, c.wave); } while (0)
    { KArgs k1 = kargs(); phase_fix(fresh(c), k1->in[I_X], 0); phase_convert<0>(fresh(c)); } BAR();
    { constexpr int L = 0;

        constexpr int s0 = 3 * L;
        { const int kgap = c.bid % 6;
          phase_inproj_mfma(fresh(c), L, s0, 0, kgap); __syncthreads(); phase_convert<1>(fresh(c)); __syncthreads(); phase_inproj_mfma(fresh(c), L, s0, kgap, 1 << 20); } BAR();
        phase_cmp_mfma(fresh(c), L); __syncthreads(); phase_lru<false>(fresh(c), L); BAR();
        phase_attn_mfma(fresh(c)); __syncthreads(); phase_lru<true>(fresh(c), L); BAR();
        phase_outproj_mfma(fresh(c), L, s0 + 1); BAR();
        if (L == 0) {
            phase_ffn_gu_mfma(fresh(c), s0 + 1); BAR();
            phase_ffn_dn_mfma(fresh(c), s0 + 2); BAR();
        } else {
            phase_moe_route(fresh(c), s0 + 1); BAR(); phase_moe_slots(fresh(c), s0 + 1); BAR();
            phase_moe_gu_mfma(fresh(c), 0); BAR();
            phase_moe_dn_mfma<false>(fresh(c), 0, s0 + 2); BAR();
            phase_moe_dn_reduce<false>(fresh(c), 0, s0 + 2); phase_moe_gu_mfma(fresh(c), 1); BAR();
            phase_moe_dn_mfma<true>(fresh(c), 1, s0 + 2); BAR();
        }
        if (L == 1) phase_moe_dn_reduce<true>(fresh(c), 1, s0 + 2);
        phase_ple_proj_mfma(fresh(c), L); BAR();
        phase_ple_mfma(fresh(c), L, s0 + 2, s0 + 3); BAR();
    }
    { constexpr int L = 1;

        constexpr int s0 = 3 * L;
        phase_inproj_mfma(fresh(c), L, s0); BAR();
        phase_cmp_mfma(fresh(c), L); __syncthreads(); phase_lru<false>(fresh(c), L); BAR();
        phase_attn_mfma(fresh(c)); __syncthreads(); phase_lru<true>(fresh(c), L); BAR();
        phase_outproj_mfma(fresh(c), L, s0 + 1); BAR();
        if (L == 0) {
            phase_ffn_gu_mfma(fresh(c), s0 + 1); BAR();
            phase_ffn_dn_mfma(fresh(c), s0 + 2); BAR();
        } else {
            phase_moe_route(fresh(c), s0 + 1); BAR(); phase_moe_slots(fresh(c), s0 + 1); BAR();
            phase_moe_gu_mfma(fresh(c), 0); BAR();
            phase_moe_dn_mfma<false>(fresh(c), 0, s0 + 2); BAR();
            phase_moe_dn_reduce<false>(fresh(c), 0, s0 + 2); phase_moe_gu_mfma(fresh(c), 1); BAR();
            phase_moe_dn_mfma<true>(fresh(c), 1, s0 + 2); BAR();
        }
        if (L == 1) phase_moe_dn_reduce<true>(fresh(c), 1, s0 + 2);
        phase_ple_proj_mfma(fresh(c), L); BAR();
        phase_ple_mfma(fresh(c), L, s0 + 2, s0 + 3); BAR();
    }
    phase_final(fresh(c), 3 * DEPTH);
#undef BAR
}

extern "C" void kernel_launch(void* const* d_in, const int* in_sizes, int n_in, void* d_out, int out_size, void* d_ws, size_t ws_size, hipStream_t stream) {
    static int grid = 0;
    if (grid == 0) {
        if (n_in != N_IN || out_size != NTOK * D_ || ws_size < WS_NEED2) { fprintf(stderr, "kernel_launch: unexpected arguments (n_in %d, out %d, ws %zu < %zu)\n", n_in, out_size, ws_size, (size_t)WS_NEED2); grid = -1; return; }
        int dev = 0, cus = 0;
        if (hipGetDevice(&dev) != hipSuccess || hipDeviceGetAttribute(&cus, hipDeviceAttributeMultiprocessorCount, dev) != hipSuccess) { grid = -1; return; }
        if (hipFuncSetAttribute((const void*)fwd_kernel, hipFuncAttributeMaxDynamicSharedMemorySize, LDS_BYTES) != hipSuccess) { grid = -1; return; }
        int per_cu = 0;
        (void)hipOccupancyMaxActiveBlocksPerMultiprocessor(&per_cu, (const void*)fwd_kernel, NTHR, LDS_BYTES);
        (void)hipGetLastError();
        grid = cus;
    }
    if (grid < 0) return;
    (void)hipMemsetAsync((char*)d_ws + WS_CTL, 0, CTL_ZERO_BYTES, stream);
    Args a{};
    for (int i = 0; i < N_IN; ++i) a.in[i] = (const float*)d_in[i];
    a.out = (float*)d_out; a.ws = (unsigned char*)d_ws; a.li = 0; a.pad = 0;
    a.ph_lo = 0; a.ph_hi = 0;
    hipLaunchKernelGGL(fwd_kernel, dim3(grid), dim3(NTHR), LDS_BYTES, stream, a);
}
```

```cpp
#include <hip/hip_runtime.h>
#include <cstdio>
#include <cstdint>


#define GAS __attribute__((address_space(1)))
#define LAS __attribute__((address_space(3)))
typedef unsigned short bf16;
typedef float f32x4 __attribute__((ext_vector_type(4)));
typedef unsigned u32x4 __attribute__((ext_vector_type(4)));
typedef unsigned u32x2 __attribute__((ext_vector_type(2)));
typedef float f32x16 __attribute__((ext_vector_type(16)));
typedef int i32x4v __attribute__((ext_vector_type(4)));
typedef short s16x8 __attribute__((ext_vector_type(8)));
typedef short s16x4 __attribute__((ext_vector_type(4)));

constexpr int NB_ = 4, T_ = 8192, D_ = 1024, NTOK = NB_ * T_;
constexpr int DEPTH = 2;
constexpr int NH = 8, HD = 64, NG = 2, HG = 4;
constexpr int D_ATTN = 512, D_REC = 512;
constexpr int L_CMP = 32, STRIDE = 16, L_SLC = 64, N_SEL = 16, W_WIN = 512;
constexpr int N_CMP = T_ / STRIDE - 1;
constexpr int N_SLC = T_ / L_SLC;
constexpr int CMP_HID = 128;
constexpr int IN_COLS = 2328;
constexpr int C_Q = 0, C_KC = 512, C_VC = 640, C_KS = 768, C_VS = 896, C_KW = 1024, C_VW = 1152, C_G = 1280, C_XR = 1304, C_YG = 1816;
constexpr int D_FF = 2816, N_EXP = 8, D_FFE = 3584;
constexpr int MOE_BLOCK = 256, N_PANEL = NTOK * 2 / MOE_BLOCK + 2 * N_EXP, NSLOT = N_PANEL * MOE_BLOCK;
constexpr int KPANEL_MAX = NTOK / MOE_BLOCK + N_EXP;
constexpr int PLE_DIM = 256;
constexpr float RMS_EPS = 1e-6f;
constexpr float LOG2E = 1.4426950408889634f;
constexpr float QSCALE = 0.125f * LOG2E;
constexpr int LRU_CHUNK = 128, LRU_NCH = T_ / LRU_CHUNK;
constexpr float W8_SCALE = 256.f, X8_SCALE = 8.f, ACT8_SCALE = 8.f;
constexpr float WI8_SCALE = 720.f, XQ_CLIP = 5.5f;

constexpr size_t MiB = 1u << 20;
constexpr size_t WS_CTL = 0, CTL_ZERO_BYTES = 64 * 1024;
constexpr size_t WS_SSP = 1 * MiB;
constexpr size_t WS_MISC = 15 * MiB;
constexpr size_t WS_XB = 20 * MiB;
constexpr size_t WS_BIG = 84 * MiB;
constexpr size_t WS_Q = WS_BIG;
constexpr size_t WS_KV = WS_Q + 32 * MiB;
constexpr size_t KV_STRIDE = (size_t)NTOK * 128 * 2;
constexpr size_t WS_XR = WS_KV + 48 * MiB;
constexpr size_t WS_YG = WS_XR + 32 * MiB;
constexpr size_t WS_GATE = WS_YG + 32 * MiB;
constexpr size_t WS_MIXED = WS_GATE + 4 * MiB;
constexpr size_t WS_MIX_END = WS_MIXED + 64 * MiB;
constexpr size_t WS_ACT = WS_BIG;
constexpr size_t WS_PROJ = WS_BIG;
constexpr size_t MS_KCMP = WS_MISC;
constexpr size_t MS_VCMP = MS_KCMP + 512 * 1024;
constexpr size_t MS_LRUA = MS_VCMP + 512 * 1024;
constexpr size_t MS_LRUB = MS_LRUA + 512 * 1024;
constexpr size_t MS_TOPE = MS_LRUB + 512 * 1024;
constexpr size_t MS_TOPG = MS_TOPE + 256 * 1024;
constexpr size_t MS_UCNT = MS_TOPG + 256 * 1024;
constexpr size_t MS_SLOTTOK = MS_UCNT + 16 * 1024;
constexpr size_t MS_SLOTG = MS_SLOTTOK + 272 * 1024;
constexpr size_t MS_SLOTRS = MS_SLOTG + 272 * 1024;
constexpr size_t MS_PANELE = MS_SLOTRS + 272 * 1024;
constexpr size_t MS_XSCI = MS_PANELE + 4096;
constexpr size_t MS_END = MS_XSCI + (size_t)NTOK * 4;
static_assert(MS_END <= WS_XB, "ws map");

constexpr size_t WS_W = 364 * MiB;
constexpr size_t WB_IN = WS_W, WB_OUT = WS_W + 10 * MiB, WB_GU = WS_W + 14 * MiB, WB_DN = WS_W + 25 * MiB, WB_PLEG = WS_W + 31 * MiB, WB_PLEP = WS_W + 35 * MiB, WB_END = WS_W + 36 * MiB;
constexpr size_t WS_PB = WB_END;
constexpr size_t WB_MGU = WS_PB + 32 * MiB;
constexpr size_t WB_MDN = WB_MGU + 112 * MiB;
constexpr size_t WS_NEED2 = WB_MDN + 56 * MiB;
constexpr size_t WS_SMALL = 324 * MiB;
constexpr size_t WB_C1T = WS_SMALL;
constexpr size_t WB_C2T = WB_C1T + 2 * MiB;
constexpr size_t WB_POSBP = WB_C2T + 64 * 1024;
constexpr size_t WB_LWA = WB_POSBP + 64 * 1024;
constexpr size_t WB_LWX = WB_LWA + 128 * 1024;
constexpr size_t WS_PART = 212 * MiB;
constexpr size_t X8_OFF = 64 * MiB;
constexpr int DN_MAIN_PANELS = 128, DN_KSPLIT = 7, DN_KSLICE = D_FFE / DN_KSPLIT, DN_KSLICE_P = DN_KSLICE / 2;
static_assert(WS_MIX_END <= WS_W, "BIG region vs weights");

constexpr int CW_BAR = 4096;

constexpr int LDS_BYTES = 161792;
constexpr int LDS_WORK = 160768;
constexpr int LDSCTL_OFF = LDS_WORK, MISC_OFF = LDSCTL_OFF + 320;
constexpr int NWAVES = 8, NTHR = 512;

__device__ __forceinline__ float bf2f(bf16 v) { return __uint_as_float(((unsigned)v) << 16); }
__device__ __forceinline__ unsigned pk2(float lo, float hi) { unsigned r; asm("v_cvt_pk_bf16_f32 %0, %1, %2" : "=v"(r) : "v"(lo), "v"(hi)); return r; }
__device__ __forceinline__ bf16 f2bf(float f) { return (bf16)pk2(f, f); }
__device__ __forceinline__ float blo(unsigned w) { return __uint_as_float(w << 16); }
__device__ __forceinline__ float bhi(unsigned w) { return __uint_as_float(w & 0xffff0000u); }
__device__ __forceinline__ float shx(float v, int o, int lane) { return __int_as_float(__builtin_amdgcn_ds_bpermute((lane ^ o) << 2, __float_as_int(v))); }
__device__ __forceinline__ int shxi(int v, int o, int lane) { return __builtin_amdgcn_ds_bpermute((lane ^ o) << 2, v); }
__device__ __forceinline__ float wave_sum(float v, int lane) {
#pragma unroll
    for (int o = 1; o < 64; o <<= 1) v += shx(v, o, lane);
    return v;
}
__device__ __forceinline__ float wave_max(float v, int lane) {
#pragma unroll
    for (int o = 1; o < 64; o <<= 1) v = fmaxf(v, shx(v, o, lane));
    return v;
}
__device__ __forceinline__ float sigmoidf_(float x) { return __builtin_amdgcn_rcpf(1.f + __expf(-x)); }
__device__ __forceinline__ float gelu_tanh(float x) { const float u = 0.7978845608028654f * (x + 0.044715f * x * x * x); return x * sigmoidf_(2.f * u); }
__device__ __forceinline__ float silu_(float x) { return x * sigmoidf_(x); }

#define XB_TMO      128
#define XB_XCNT(j)  (256  + 64 * (j))
#define XB_XSUB(j)  (1280 + 64 * (j))
#define XB_XGEN(j)  (2304 + 64 * (j))
#define XB_TOP      3328
#define XB_TOPGEN   3392
#define XCD_BAR_WORDS 3456
#define XB_SPIN_CAP (1u << 22)
__device__ __forceinline__ unsigned xb_ld(unsigned* p)              { return __hip_atomic_load(p, __ATOMIC_RELAXED, __HIP_MEMORY_SCOPE_AGENT); }
__device__ __forceinline__ unsigned xb_add(unsigned* p, unsigned v) { return __hip_atomic_fetch_add(p, v, __ATOMIC_RELAXED, __HIP_MEMORY_SCOPE_AGENT); }
__device__ __forceinline__ unsigned xb_xcc_id() { return (unsigned)__builtin_amdgcn_s_getreg((3 << 11) | 20) & 0xFu; }
#define XB_SPIN(cond, bar) do { unsigned _sp = 0; while (cond) { __builtin_amdgcn_s_sleep(1); \
    if ((++_sp & 255u) == 0u) { if (xb_ld(&(bar)[XB_TMO])) break; if (_sp > XB_SPIN_CAP) { atomicAdd(&(bar)[XB_TMO], 1u); break; } } } } while (0)
struct XcdBarrier { unsigned* bar; unsigned x; volatile LAS unsigned* st; };
__device__ __forceinline__ XcdBarrier xcd_barrier_post(unsigned* bar, volatile LAS unsigned* st, bool leader) {
    XcdBarrier b; b.bar = bar; b.x = (unsigned)__builtin_amdgcn_readfirstlane((int)xb_xcc_id()); b.st = st;
    if (leader) (void)xb_add(&bar[XB_XCNT(b.x)], 1u);
    return b;
}
__device__ __forceinline__ void xcd_barrier_complete(unsigned* bar, unsigned x, unsigned& nloc, unsigned& nx) {
    const unsigned G = gridDim.x * gridDim.y * gridDim.z;
    unsigned sum, cnt, mine, sp = 0u;
    for (;;) {
        sum = 0u; cnt = 0u; mine = 0u;
#pragma unroll
        for (unsigned j = 0; j < 16; ++j) { const unsigned c = xb_ld(&bar[XB_XCNT(j)]); sum += c; cnt += (c > 0u) ? 1u : 0u; mine = (j == x) ? c : mine; }
        if (sum == G) break;
        __builtin_amdgcn_s_sleep(1);
        if ((++sp & 255u) == 0u) { if (xb_ld(&bar[XB_TMO])) break; if (sp > XB_SPIN_CAP) { atomicAdd(&bar[XB_TMO], 1u); break; } }
    }
    nloc = mine > 0u ? mine : 1u; nx = cnt > 0u ? cnt : 1u;
}
__device__ __forceinline__ void xcd_barrier(unsigned* bar_in, volatile LAS unsigned* st_in, int wave) {
    XcdBarrier b; b.bar = bar_in; b.st = st_in; b.x = (unsigned)__builtin_amdgcn_readfirstlane((int)xb_xcc_id());
    asm volatile("s_waitcnt vmcnt(0)" ::: "memory");
    __syncthreads();
    if (wave == 0 && __builtin_amdgcn_mbcnt_hi(~0u, __builtin_amdgcn_mbcnt_lo(~0u, 0u)) == 0u) {
        unsigned* bar = b.bar;
        __builtin_amdgcn_s_waitcnt(0);
        unsigned nloc = b.st[0], nx = b.st[1];
        if (nloc == 0u) { xcd_barrier_complete(bar, b.x, nloc, nx); b.st[0] = nloc; b.st[1] = nx; }
        const unsigned old = xb_add(&bar[XB_XSUB(b.x)], 1u);
        const unsigned gen = old / nloc;
        if (old + 1u == (gen + 1u) * nloc) {
            __builtin_amdgcn_fence(__ATOMIC_RELEASE, "agent");
            asm volatile("s_waitcnt vmcnt(0)" ::: "memory");
            const unsigned og = xb_add(&bar[XB_TOP], 1u);
            const unsigned tg = og / nx;
            if (og + 1u == (tg + 1u) * nx) xb_add(&bar[XB_TOPGEN], 1u);
            else XB_SPIN(xb_ld(&bar[XB_TOPGEN]) == tg, bar);
            __builtin_amdgcn_fence(__ATOMIC_ACQUIRE, "agent");
            xb_add(&bar[XB_XGEN(b.x)], 1u);
            asm volatile("s_waitcnt vmcnt(0)" ::: "memory");
        } else {
            XB_SPIN(xb_ld(&bar[XB_XGEN(b.x)]) == gen, bar);
            __builtin_amdgcn_fence(__ATOMIC_ACQUIRE, "agent");
            asm volatile("s_waitcnt vmcnt(0)" ::: "memory");
        }
    }
    __syncthreads();
}

namespace pg8 {
#define PG8_LAS __attribute__((address_space(3)))
typedef unsigned short bf16_t;
typedef short bf16x8 __attribute__((ext_vector_type(8)));
typedef float f32x4 __attribute__((ext_vector_type(4)));
typedef unsigned u32x4 __attribute__((ext_vector_type(4)));
constexpr int BM = 256, BK = 64, HALF = 128, HTB = HALF * BK * 2  , STAGE_BYTES = 8 * HTB, NXCD = 8, WGM = 8;

__host__ __device__ __forceinline__ int lds_byte(int r, int c) { const int st = (r >> 4) * 2 + (c >> 5), rr = r & 15, cc = c & 31, ob = rr * 64 + cc * 2; return st * 1024 + (ob ^ (((ob >> 9) & 1) << 5)); }
__host__ __device__ __forceinline__ void stage_rc(int b, int& R, int& C) { const int st = b / 1024, sb = b % 1024, swz = sb ^ (((sb >> 9) & 1) << 5); R = (st >> 1) * 16 + swz / 64; C = (st & 1) * 32 + (swz % 64) / 2; }
__host__ __device__ __forceinline__ int perm32(int rho) { const int n = rho >> 4, i = rho & 15; return 8 * (i >> 2) + 4 * n + (i & 3); }

struct Unit { int pm, pn, kofs; };
struct Gemm { const bf16_t* A; const bf16_t* Bt; int M, N, K; const int* panel_e; size_t e_stride; int lda, ldb; };
struct RowsIdent { static constexpr bool GATHER = false; __device__ __forceinline__ unsigned row(int r) const { return (unsigned)r; } };
struct RowsGather { const int* map; static constexpr bool GATHER = true; __device__ __forceinline__ unsigned row(int r) const { const int t = map[r]; return (unsigned)(t < 0 ? 0 : t); } };

struct StaticOrder {
    int nM, nN, nwg, G, c;
    __host__ __device__ void init(int M, int N, int G_, int c_) { nM = M / BM; nN = N / BM; nwg = nM * nN; G = G_; c = c_; }
    __host__ __device__ bool next(int i, Unit& u) const {
        const long L = (long)i * G + c; if (L >= nwg) return false;
        int wgid = (int)L; { const int q = nwg / NXCD, r = nwg % NXCD, xcd = wgid % NXCD, off = wgid / NXCD; wgid = (xcd < r ? xcd * (q + 1) : r * (q + 1) + (xcd - r) * q) + off; }
        const int nig = WGM * nN, gid = wgid / nig, fm = gid * WGM, gsz = (nM - fm) < WGM ? (nM - fm) : WGM;
        u.pm = fm + ((wgid % nig) % gsz); u.pn = (wgid % nig) / gsz; u.kofs = 0; return true;
    }
    __device__ __forceinline__ void a_ready(const Unit&) const {}
    __device__ __forceinline__ void done(const Unit&) const {}
};

typedef int i32x8 __attribute__((ext_vector_type(8)));
typedef int i32x4 __attribute__((ext_vector_type(4)));
__device__ __forceinline__ unsigned cvt_pk_bf16(float lo, float hi) { unsigned r; asm volatile("v_cvt_pk_bf16_f32 %0, %1, %2" : "=v"(r) : "v"(lo), "v"(hi)); return r; }
template <class Epi, class Sched, bool ALIGN_EPI = false, bool SP2 = false, class AMap = RowsIdent, bool FP8 = false, bool I8 = false>
__device__ __forceinline__ void gemm_phase(PG8_LAS unsigned char* lds, const Gemm g, const Sched& S, const Epi& E, int tid_in, const AMap AM = AMap()) {
    int tid_ = tid_in; asm volatile("" : "+v"(tid_));
    const int tid = tid_, wid = __builtin_amdgcn_readfirstlane(tid >> 6), lane = tid & 63, wr = wid >> 2, wc = wid & 3, fr = lane & 15, fq = lane >> 4;
    int K_ = g.K; asm volatile("" : "+s"(K_));
    const int K = K_, nt = K / BK, lda = g.lda ? g.lda : K_, ldb = g.ldb ? g.ldb : K_;
    unsigned voffB[2]; int RA[2], CA2[2];
#pragma unroll
    for (int i = 0; i < 2; ++i) { int R, C; stage_rc(tid * 16 + i * 8192, R, C); const int Rb = Epi::PERM ? ((R & ~31) + perm32(R & 31)) : R;
        RA[i] = R; CA2[i] = C * 2; voffB[i] = (unsigned)(Rb * ldb + C) * 2u; }
    unsigned voC[2][2], voN[2][2];
#define PG8_CALCA(vo, pm_, ko_) do { _Pragma("unroll") for (int h_ = 0; h_ < 2; ++h_) _Pragma("unroll") for (int i_ = 0; i_ < 2; ++i_) \
        vo[h_][i_] = AM.row((pm_) * BM + h_ * HALF + RA[i_]) * (unsigned)(lda * 2) + (unsigned)(CA2[i_] + 2 * (ko_)); } while (0)
    const size_t kstep = (size_t)(BK * 2);
    const size_t hstep = (size_t)HALF * ldb * 2;
    const size_t tstep = 2 * hstep;
    const unsigned ldsw = (unsigned)wid * 1024u;
    const int aoff = lds_byte(wr * 64 + fr, fq * 8), boff = lds_byte(wc * 32 + fr, fq * 8);
#define PG8_SA(b, h) (((b) * 2 + (h)) * HTB)
#define PG8_SB(b, h) ((4 + (b) * 2 + (h)) * HTB)
#define PG8_STAGE(bufoff, gbase, voff) do { _Pragma("unroll") for (int _i = 0; _i < 2; ++_i) \
        __builtin_amdgcn_global_load_lds((const unsigned*)((const char*)(gbase) + (voff)[_i]), (PG8_LAS unsigned*)(lds + (bufoff) + ldsw + _i * 8192), 16, 0, 0); } while (0)
#define PG8_LDA(dst, b, h) do { _Pragma("unroll") for (int m = 0; m < 4; ++m) { if constexpr (FP8) { dst##8[m].lo = *(const PG8_LAS i32x4*)(lds + PG8_SA(b, h) + aoff + m * 2048); dst##8[m].hi = *(const PG8_LAS i32x4*)(lds + PG8_SA(b, h) + aoff + m * 2048 + 1024); } \
        else { _Pragma("unroll") for (int k = 0; k < 2; ++k) dst[m][k] = *(const PG8_LAS bf16x8*)(lds + PG8_SA(b, h) + aoff + m * 2048 + k * 1024); } } } while (0)
#define PG8_LDB(dst, b, h) do { _Pragma("unroll") for (int n = 0; n < 2; ++n) { if constexpr (FP8) { dst##8[n].lo = *(const PG8_LAS i32x4*)(lds + PG8_SB(b, h) + boff + n * 2048); dst##8[n].hi = *(const PG8_LAS i32x4*)(lds + PG8_SB(b, h) + boff + n * 2048 + 1024); } \
        else { _Pragma("unroll") for (int k = 0; k < 2; ++k) dst[n][k] = *(const PG8_LAS bf16x8*)(lds + PG8_SB(b, h) + boff + n * 2048 + k * 1024); } } } while (0)
#define PG8_MMA(ai, bj, At, Bt) do { __builtin_amdgcn_s_setprio(1); _Pragma("unroll") for (int m = 0; m < 4; ++m) _Pragma("unroll") for (int n = 0; n < 2; ++n) { \
        if constexpr (FP8) asm volatile("v_mfma_f32_16x16x128_f8f6f4 %0, %1, %2, %0" : "+v"(acc[ai][bj][m][n]) : "v"(Bt##8[n]), "v"(At##8[m]));   \
        else if constexpr (I8) { _Pragma("unroll") for (int k = 0; k < 2; ++k) acc[ai][bj][m][n] = __builtin_bit_cast(f32x4, __builtin_amdgcn_mfma_i32_16x16x64_i8(__builtin_bit_cast(i32x4, Bt[n][k]), __builtin_bit_cast(i32x4, At[m][k]), __builtin_bit_cast(i32x4, acc[ai][bj][m][n]), 0, 0, 0)); } \
        else { _Pragma("unroll") for (int k = 0; k < 2; ++k) acc[ai][bj][m][n] = __builtin_amdgcn_mfma_f32_16x16x32_bf16(Bt[n][k], At[m][k], acc[ai][bj][m][n], 0, 0, 0); } } __builtin_amdgcn_s_setprio(0); } while (0)
#define PG8_WAIT_V(n) asm volatile("s_waitcnt vmcnt(" #n ")" ::: "memory")
#define PG8_WAIT_L(n) asm volatile("s_waitcnt lgkmcnt(" #n ")" ::: "memory")
#define PG8_BAR __builtin_amdgcn_s_barrier()
#define PG8_SCHED __builtin_amdgcn_sched_barrier(0)
    Unit cur, nxt; int ui = 0;
    if (!S.next(0, cur)) return;
    f32x4 acc[2][2][4][2];
#pragma unroll
    for (int a = 0; a < 2; ++a)
#pragma unroll
        for (int b = 0; b < 2; ++b)
#pragma unroll
            for (int m = 0; m < 4; ++m)
#pragma unroll
                for (int n = 0; n < 2; ++n) acc[a][b][m][n] = (f32x4){0.f, 0.f, 0.f, 0.f};
    bf16x8 At[4][2], B0[2][2], B1[2][2];
    i32x8 At8[4], B08[2], B18[2];
    const char* const Ab = (const char*)g.A;
#define PG8_BBASE(u_) ((const char*)g.Bt + (g.panel_e ? (size_t)g.panel_e[(u_).pm] * g.e_stride * 2 : (size_t)0) + (size_t)(u_).pn * tstep + (size_t)(u_).kofs * 2)
    const char* cB = PG8_BBASE(cur); PG8_CALCA(voC, cur.pm, cur.kofs);
    S.a_ready(cur);
    if constexpr (SP2) {
        PG8_STAGE(PG8_SB(0, 0), cB, voffB); PG8_STAGE(PG8_SB(0, 1), cB + hstep, voffB); PG8_STAGE(PG8_SA(0, 0), Ab, voC[0]); PG8_STAGE(PG8_SA(0, 1), Ab, voC[1]);
        if (wr == 1) PG8_BAR;
        PG8_WAIT_V(2); PG8_BAR;
        PG8_STAGE(PG8_SB(1, 0), cB + kstep, voffB); PG8_STAGE(PG8_SA(1, 0), Ab + kstep, voC[0]); PG8_STAGE(PG8_SB(1, 1), cB + hstep + kstep, voffB);
        PG8_WAIT_V(6); PG8_BAR;
    } else {
        PG8_STAGE(PG8_SB(0, 0), cB, voffB); PG8_STAGE(PG8_SA(0, 0), Ab, voC[0]); PG8_STAGE(PG8_SB(0, 1), cB + hstep, voffB); PG8_STAGE(PG8_SA(0, 1), Ab, voC[1]);
        if (wr == 1) PG8_BAR;
        PG8_WAIT_V(4); PG8_BAR;
        PG8_STAGE(PG8_SB(1, 0), cB + kstep, voffB); PG8_STAGE(PG8_SA(1, 0), Ab + kstep, voC[0]); PG8_STAGE(PG8_SB(1, 1), cB + hstep + kstep, voffB);
        PG8_WAIT_V(6); PG8_BAR;
    }
    for (;;) {
        const bool has_next = S.next(ui + 1, nxt);
        const char* nB = has_next ? PG8_BBASE(nxt) : cB;
        if (has_next) { PG8_CALCA(voN, nxt.pm, nxt.kofs); } else {
#pragma unroll
            for (int h_ = 0; h_ < 2; ++h_)
#pragma unroll
                for (int i_ = 0; i_ < 2; ++i_) voN[h_][i_] = voC[h_][i_]; }
        for (int t = 0; t < nt; t += 2) {
            const bool last = (t == nt - 2);
            const char* a1 = Ab + (size_t)(t + 1) * kstep;
            const char* a2 = last ? Ab : Ab + (size_t)(t + 2) * kstep; const char* b2 = last ? nB : cB + (size_t)(t + 2) * kstep;
            const char* a3 = a2 + kstep; const char* b3 = b2 + kstep;
            unsigned vo2[2][2];
#pragma unroll
            for (int h_ = 0; h_ < 2; ++h_)
#pragma unroll
                for (int i_ = 0; i_ < 2; ++i_) vo2[h_][i_] = last ? voN[h_][i_] : voC[h_][i_];
            if (last && has_next) S.a_ready(nxt);
            if constexpr (SP2) {
            PG8_LDB(B0, 0, 0); PG8_LDB(B1, 0, 1); PG8_SCHED; PG8_LDA(At, 0, 0); PG8_STAGE(PG8_SA(1, 1), a1, voC[1]);
            PG8_WAIT_V(8); PG8_WAIT_L(0); PG8_BAR; PG8_MMA(0, 0, At, B0); PG8_MMA(0, 1, At, B1); PG8_BAR; PG8_SCHED;
            PG8_LDA(At, 0, 1); PG8_STAGE(PG8_SB(0, 0), b2, voffB); PG8_STAGE(PG8_SB(0, 1), b2 + hstep, voffB); PG8_STAGE(PG8_SA(0, 0), a2, vo2[0]);
            PG8_WAIT_V(8); PG8_WAIT_L(0); PG8_BAR; PG8_MMA(1, 0, At, B0); PG8_MMA(1, 1, At, B1); PG8_BAR; PG8_SCHED;
            PG8_LDB(B0, 1, 0); PG8_LDB(B1, 1, 1); PG8_SCHED; PG8_LDA(At, 1, 0); PG8_STAGE(PG8_SA(0, 1), a2, vo2[1]);
            PG8_WAIT_V(8); PG8_WAIT_L(0); PG8_BAR; PG8_MMA(0, 0, At, B0); PG8_MMA(0, 1, At, B1); PG8_BAR; PG8_SCHED;
            PG8_LDA(At, 1, 1); PG8_STAGE(PG8_SB(1, 0), b3, voffB); PG8_STAGE(PG8_SB(1, 1), b3 + hstep, voffB); PG8_STAGE(PG8_SA(1, 0), a3, vo2[0]);
            PG8_WAIT_V(8); PG8_WAIT_L(0); PG8_BAR; PG8_MMA(1, 0, At, B0); PG8_MMA(1, 1, At, B1); PG8_BAR; PG8_SCHED;
            } else {
            PG8_LDB(B0, 0, 0); PG8_SCHED; PG8_LDA(At, 0, 0); PG8_STAGE(PG8_SA(1, 1), a1, voC[1]);
            PG8_WAIT_L(8); PG8_BAR; PG8_WAIT_L(0); PG8_MMA(0, 0, At, B0); PG8_BAR; PG8_SCHED;
            PG8_LDB(B1, 0, 1); PG8_STAGE(PG8_SB(0, 0), b2, voffB);
            PG8_BAR; PG8_WAIT_L(0); PG8_MMA(0, 1, At, B1); PG8_BAR;
            PG8_LDA(At, 0, 1); PG8_STAGE(PG8_SA(0, 0), a2, vo2[0]);
            PG8_BAR; PG8_WAIT_L(0); PG8_MMA(1, 0, At, B0); PG8_BAR; PG8_SCHED;
            PG8_STAGE(PG8_SB(0, 1), b2 + hstep, voffB);
            PG8_WAIT_V(6); PG8_BAR; PG8_MMA(1, 1, At, B1); PG8_BAR;
            PG8_LDB(B0, 1, 0); PG8_SCHED; PG8_LDA(At, 1, 0); PG8_STAGE(PG8_SA(0, 1), a2, vo2[1]);
            PG8_WAIT_L(8); PG8_BAR; PG8_WAIT_L(0); PG8_MMA(0, 0, At, B0); PG8_BAR; PG8_SCHED;
            PG8_LDB(B1, 1, 1); PG8_STAGE(PG8_SB(1, 0), b3, voffB);
            PG8_BAR; PG8_WAIT_L(0); PG8_MMA(0, 1, At, B1); PG8_BAR;
            PG8_LDA(At, 1, 1); PG8_STAGE(PG8_SA(1, 0), a3, vo2[0]);
            PG8_BAR; PG8_WAIT_L(0); PG8_MMA(1, 0, At, B0); PG8_BAR; PG8_SCHED;
            PG8_STAGE(PG8_SB(1, 1), b3 + hstep, voffB);
            PG8_WAIT_V(6); PG8_BAR; PG8_MMA(1, 1, At, B1); PG8_BAR;
            }
        }
        if constexpr (FP8) asm volatile("s_nop 15\n\ts_nop 15" ::: "memory");
        if constexpr (ALIGN_EPI) { if (wr == 0) PG8_BAR; }
        if constexpr (!Epi::AFTER_DRAIN) { E(acc, cur, wr, wc, fr, fq); S.done(cur); }
        if (!has_next) break;
#pragma unroll
        for (int a = 0; a < 2; ++a)
#pragma unroll
            for (int b = 0; b < 2; ++b)
#pragma unroll
                for (int m = 0; m < 4; ++m)
#pragma unroll
                    for (int n = 0; n < 2; ++n) acc[a][b][m][n] = (f32x4){0.f, 0.f, 0.f, 0.f};
        cur = nxt; cB = nB; ++ui;
#pragma unroll
        for (int h_ = 0; h_ < 2; ++h_)
#pragma unroll
            for (int i_ = 0; i_ < 2; ++i_) voC[h_][i_] = voN[h_][i_];
        if constexpr (ALIGN_EPI) { if (wr == 1) PG8_BAR; }
    }
    PG8_WAIT_V(0);
    if constexpr (!ALIGN_EPI) { if (wr == 0) PG8_BAR; }
    PG8_BAR;
    if constexpr (Epi::AFTER_DRAIN) { E.fused(acc, cur, wr, wc, fr, fq, lds, wid, lane); S.done(cur); }
#undef PG8_CALCA
#undef PG8_BBASE
#undef PG8_SA
#undef PG8_SB
#undef PG8_STAGE
#undef PG8_LDA
#undef PG8_LDB
#undef PG8_MMA
#undef PG8_WAIT_V
#undef PG8_WAIT_L
#undef PG8_BAR
#undef PG8_SCHED
}
}

enum { I_X = 0, I_P, I_ATTN_NORM, I_W_IN, I_CMP_POS, I_CMP_W1, I_CMP_W2, I_CONV_W, I_CONV_B, I_LRU_WA, I_LRU_BA, I_LRU_WX, I_LRU_BX, I_LRU_LAMBDA,
       I_OUT_NORM_ATTN, I_OUT_NORM_REC, I_W_OUT, I_FFN_NORM, I_DENSE_WG, I_DENSE_WU, I_DENSE_WD, I_ROUTER_W, I_MOE_WG, I_MOE_WU, I_MOE_WD,
       I_PLE_NORM, I_PLE_WG, I_PLE_WP, I_FINAL_NORM, N_IN };
struct Args { const float* in[N_IN]; float* out; unsigned char* ws; int ph_lo, ph_hi, li, pad; };

typedef const __attribute__((address_space(4))) Args* KArgs;
__device__ __forceinline__ KArgs kargs() { KArgs p = (KArgs)__builtin_amdgcn_kernarg_segment_ptr(); asm volatile("" : "+s"(p)); return p; }
struct Ctx {
    LAS float* lds; int tid, lane, wave, bid, nblk;
    bf16* XO; bf16* XB; float* SSP;
};
__device__ __forceinline__ Ctx fresh(const Ctx& c) {
    Ctx f = c;
    asm volatile("" : "+s"(f.wave), "+s"(f.bid), "+s"(f.nblk));
    f.lane = (int)__builtin_amdgcn_mbcnt_hi(~0u, __builtin_amdgcn_mbcnt_lo(~0u, 0u)); f.tid = f.wave * 64 + f.lane;
    asm volatile("" : "+v"(f.tid), "+v"(f.lane));
    asm volatile("" : "+s"(f.XO), "+s"(f.XB), "+s"(f.SSP));
    return f;
}
#define CA_IN(i) (ka->in[i])
#define CA_WS (ka->ws)

__device__ __forceinline__ float row_rs(const float* SSP, int stage, int row) {
    const f32x4* p = (const f32x4*)(SSP + ((size_t)stage * NTOK + row) * 16);
    f32x4 a = p[0], b = p[1], c = p[2], d = p[3];
    float s = ((a.x + a.y) + (a.z + a.w)) + ((b.x + b.y) + (b.z + b.w)) + ((c.x + c.y) + (c.z + c.w)) + ((d.x + d.y) + (d.z + d.w));
    return __builtin_amdgcn_rsqf(s * (1.f / D_) + RMS_EPS);
}

__device__ __forceinline__ void phase_fix(Ctx c, const float* src, int stage) {
    const int gw = c.bid * NWAVES + c.wave, NGW = c.nblk * NWAVES;
    for (int m = gw; m < NTOK; m += NGW) {
        const f32x4* xr = (const f32x4*)(src + (size_t)m * D_) + c.lane;
        f32x4 v[4]; float s = 0.f;
#pragma unroll
        for (int j = 0; j < 4; ++j) { v[j] = xr[64 * j]; s += (v[j].x * v[j].x + v[j].y * v[j].y) + (v[j].z * v[j].z + v[j].w * v[j].w); }
        s = wave_sum(s, c.lane);
        u32x2* o8 = (u32x2*)(c.XB + (size_t)m * D_) + c.lane;
#pragma unroll
        for (int j = 0; j < 4; ++j) { u32x2 w; w.x = pk2(v[j].x, v[j].y); w.y = pk2(v[j].z, v[j].w); o8[64 * j] = w; }
        if (c.lane < 16) c.SSP[((size_t)stage * NTOK + m) * 16 + c.lane] = (c.lane == 0) ? s : 0.f;
    }
}
__device__ __forceinline__ void phase_final(Ctx c, int stage) {
    KArgs ka = kargs();
    const float* gn = CA_IN(I_FINAL_NORM); const bf16* RIN = (const bf16*)(CA_WS + WS_MIXED); float* out = ka->out;
    const int gw = c.bid * NWAVES + c.wave, NGW = c.nblk * NWAVES;
    for (int m = gw; m < NTOK; m += NGW) {
        const u32x2* xr = (const u32x2*)(RIN + (size_t)m * D_) + c.lane; f32x4* orow = (f32x4*)(out + (size_t)m * D_) + c.lane;
        const float rs = row_rs(c.SSP, stage, m);
#pragma unroll
        for (int j = 0; j < 4; ++j) { const u32x2 w = xr[64 * j]; const f32x4 g = ((const f32x4*)gn)[64 * j + c.lane];
            orow[64 * j] = (f32x4){blo(w.x) * rs * g.x, bhi(w.x) * rs * g.y, blo(w.y) * rs * g.z, bhi(w.y) * rs * g.w}; }
    }
}

template <bool FINAL>
__device__ __forceinline__ void phase_lru(Ctx c, int L) {
    KArgs ka = kargs();
    unsigned char* ws = CA_WS;
    const bf16* XR = (const bf16*)(ws + WS_XR); const bf16* YG = (const bf16*)(ws + WS_YG); bf16* MIXED = (bf16*)(ws + WS_MIXED);
    float* SA = (float*)(ws + MS_LRUA); float* SB = (float*)(ws + MS_LRUB);
    const float* conv_w = CA_IN(I_CONV_W) + L * 4 * D_REC; const float* conv_b = CA_IN(I_CONV_B) + L * D_REC;
    const float* ba = CA_IN(I_LRU_BA) + L * D_REC; const float* bx = CA_IN(I_LRU_BX) + L * D_REC; const float* lam = CA_IN(I_LRU_LAMBDA) + L * D_REC;
    const int ch = c.tid, blk = c.wave, lane = c.lane, fr = lane & 15, fq = lane >> 4;
    LAS char* lds = (LAS char*)c.lds;
    LAS unsigned short* xcb = (LAS unsigned short*)lds;
    LAS float* pre = (LAS float*)(lds + 16640);
    LAS float* red = (LAS float*)(lds + 16640 + 65536);
    const float cw0 = conv_w[0 * D_REC + ch], cw1 = conv_w[1 * D_REC + ch], cw2 = conv_w[2 * D_REC + ch], cw3 = conv_w[3 * D_REC + ch], cb = conv_b[ch];
    const float b_a = ba[ch], b_x = bx[ch];
    const float lmb = lam[ch]; const float sp = (lmb > 0.f) ? __logf(1.f + __expf(-lmb)) : (-lmb + __logf(1.f + __expf(lmb)));
    s16x8 wfa[4][2], wfx[4][2];
    { const bf16* WA = (const bf16*)(ws + WB_LWA) + ((size_t)L * 8 + blk) * 4096; const bf16* WX = (const bf16*)(ws + WB_LWX) + ((size_t)L * 8 + blk) * 4096;
#pragma unroll
      for (int ct = 0; ct < 4; ++ct)
#pragma unroll
          for (int ks = 0; ks < 2; ++ks) { wfa[ct][ks] = *(const s16x8*)(WA + (16 * ct + fr) * 64 + 32 * ks + 8 * fq); wfx[ct][ks] = *(const s16x8*)(WX + (16 * ct + fr) * 64 + 32 * ks + 8 * fq); } }
#define LRU_BAR() asm volatile("s_waitcnt lgkmcnt(0)\n\ts_barrier" ::: "memory")
    for (int u = c.bid; u < NB_ * LRU_NCH; u += c.nblk) {
        const int b = u / LRU_NCH, cki = u % LRU_NCH, t0 = cki * LRU_CHUNK;
        float h = 0.f, Aprod = 1.f;
        const bf16* xrp = XR + ((size_t)b * T_) * D_REC + ch; const bf16* ygp = YG + ((size_t)b * T_) * D_REC + ch;
        unsigned short xn[16], yn[16];
#pragma unroll
        for (int i = 0; i < 16; ++i) { xn[i] = xrp[(size_t)(t0 + i) * D_REC]; if (FINAL) yn[i] = ygp[(size_t)(t0 + i) * D_REC]; }
        float x1 = (t0 >= 1) ? bf2f(xrp[(size_t)(t0 - 1) * D_REC]) : 0.f, x2 = (t0 >= 2) ? bf2f(xrp[(size_t)(t0 - 2) * D_REC]) : 0.f, x3 = (t0 >= 3) ? bf2f(xrp[(size_t)(t0 - 3) * D_REC]) : 0.f;
        if (FINAL) {
            for (int j0 = 0; j0 < cki; j0 += 16) { float aa[16], bq[16];
#pragma unroll
                for (int k = 0; k < 16; ++k) { const bool v = j0 + k < cki; aa[k] = v ? SA[((size_t)b * LRU_NCH + j0 + k) * D_REC + ch] : 1.f; bq[k] = v ? SB[((size_t)b * LRU_NCH + j0 + k) * D_REC + ch] : 0.f; }
#pragma unroll
                for (int k = 0; k < 16; ++k) h = aa[k] * h + bq[k]; } }
        __syncthreads();
        for (int s = 0; s < LRU_CHUNK; s += 16) {
            float xc[16], yv[16];
#pragma unroll
            for (int i = 0; i < 16; ++i) { const float x0 = bf2f(xn[i]); if (FINAL) yv[i] = bf2f(yn[i]); xc[i] = cw0 * x3 + cw1 * x2 + cw2 * x1 + cw3 * x0 + cb; x3 = x2; x2 = x1; x1 = x0; xcb[i * 520 + ch] = f2bf(xc[i]); }
            if (s + 16 < LRU_CHUNK) {
#pragma unroll
                for (int i = 0; i < 16; ++i) { xn[i] = xrp[(size_t)(t0 + s + 16 + i) * D_REC]; if (FINAL) yn[i] = ygp[(size_t)(t0 + s + 16 + i) * D_REC]; } }
            LRU_BAR();
            { s16x8 af[2];
#pragma unroll
              for (int ks = 0; ks < 2; ++ks) af[ks] = *(const LAS s16x8*)(xcb + fr * 520 + blk * 64 + 32 * ks + 8 * fq);
#pragma unroll
              for (int ct = 0; ct < 4; ++ct) { f32x4 ra = (f32x4){0.f, 0.f, 0.f, 0.f}, rx = ra;
#pragma unroll
                  for (int ks = 0; ks < 2; ++ks) { ra = __builtin_amdgcn_mfma_f32_16x16x32_bf16(af[ks], wfa[ct][ks], ra, 0, 0, 0); rx = __builtin_amdgcn_mfma_f32_16x16x32_bf16(af[ks], wfx[ct][ks], rx, 0, 0, 0); }
#pragma unroll
                  for (int i = 0; i < 4; ++i) { pre[(4 * fq + i) * 512 + blk * 64 + 16 * ct + fr] = ra[i]; pre[8192 + (4 * fq + i) * 512 + blk * 64 + 16 * ct + fr] = rx[i]; } } }
            LRU_BAR();
            float o[16];
            typedef float f32x2 __attribute__((ext_vector_type(2)));
            const float ca = -8.f * sp * LOG2E;
#pragma unroll
            for (int i = 0; i < 16; i += 2) {
                const f32x2 pa = (f32x2){pre[i * 512 + ch], pre[(i + 1) * 512 + ch]} + b_a, px = (f32x2){pre[8192 + i * 512 + ch], pre[8192 + (i + 1) * 512 + ch]} + b_x;
                const f32x2 ta = pa * (-LOG2E), tx = px * (-LOG2E);
                const f32x2 da = (f32x2){__builtin_amdgcn_exp2f(ta.x), __builtin_amdgcn_exp2f(ta.y)} + 1.f, dx = (f32x2){__builtin_amdgcn_exp2f(tx.x), __builtin_amdgcn_exp2f(tx.y)} + 1.f;
                const f32x2 r = (f32x2){__builtin_amdgcn_rcpf(da.x), __builtin_amdgcn_rcpf(da.y)}, ig = (f32x2){__builtin_amdgcn_rcpf(dx.x), __builtin_amdgcn_rcpf(dx.y)};
                const f32x2 la2 = r * ca; const f32x2 av = (f32x2){__builtin_amdgcn_exp2f(la2.x), __builtin_amdgcn_exp2f(la2.y)};
                const f32x2 om = 1.f - av * av; const f32x2 sq = (f32x2){__builtin_amdgcn_sqrtf(fmaxf(om.x, 0.f)), __builtin_amdgcn_sqrtf(fmaxf(om.y, 0.f))};
                const f32x2 bb = sq * ig * (f32x2){xc[i], xc[i + 1]};
                h = av.x * h + bb.x; o[i] = h; h = av.y * h + bb.y; o[i + 1] = h; Aprod *= av.x * av.y; }
            if (FINAL) {
                float v8[8], v4[4], v2[2], v1;
#pragma unroll
                for (int i = 0; i < 16; i += 2) {
                    const f32x2 y = (f32x2){yv[i], yv[i + 1]}; const f32x2 t = (y * y * 0.044715f + 1.f) * y * (-2.f * 0.7978845608028654f * LOG2E);
                    const f32x2 d = (f32x2){__builtin_amdgcn_exp2f(t.x), __builtin_amdgcn_exp2f(t.y)} + 1.f;
                    const f32x2 gl = y * (f32x2){__builtin_amdgcn_rcpf(d.x), __builtin_amdgcn_rcpf(d.y)};
                    o[i] *= gl.x; o[i + 1] *= gl.y; }
                { const bool up = (lane & 32) != 0;
#pragma unroll
                  for (int i = 0; i < 8; ++i) { const float lo = o[i] * o[i], hi2 = o[i + 8] * o[i + 8]; const float keep = up ? hi2 : lo, send = up ? lo : hi2; v8[i] = keep + shx(send, 32, lane); } }
                { const bool up = (lane & 16) != 0;
#pragma unroll
                  for (int i = 0; i < 4; ++i) { const float keep = up ? v8[i + 4] : v8[i], send = up ? v8[i] : v8[i + 4]; v4[i] = keep + shx(send, 16, lane); } }
                { const bool up = (lane & 8) != 0;
#pragma unroll
                  for (int i = 0; i < 2; ++i) { const float keep = up ? v4[i + 2] : v4[i], send = up ? v4[i] : v4[i + 2]; v2[i] = keep + shx(send, 8, lane); } }
                { const bool up = (lane & 4) != 0; const float keep = up ? v2[1] : v2[0], send = up ? v2[0] : v2[1]; v1 = keep + shx(send, 4, lane); }
                v1 += shx(v1, 2, lane); v1 += shx(v1, 1, lane);
                if ((lane & 3) == 0) red[(((lane >> 5) & 1) * 8 + ((lane >> 4) & 1) * 4 + ((lane >> 3) & 1) * 2 + ((lane >> 2) & 1)) * 8 + c.wave] = v1;
                LRU_BAR();
                float rsl = 0.f;
                if ((lane & 3) == 0) { float q = 0.f;
#pragma unroll
                    for (int w = 0; w < 8; ++w) q += red[(lane >> 2) * 8 + w];
                    rsl = __builtin_amdgcn_rsqf(q * (1.f / D_REC) + RMS_EPS); }
#pragma unroll
                for (int i = 0; i < 16; ++i) { const float rs = __builtin_bit_cast(float, __builtin_amdgcn_readlane(__builtin_bit_cast(int, rsl), 4 * i)); MIXED[((size_t)b * T_ + t0 + s + i) * D_ + 512 + ch] = f2bf(o[i] * rs); }
            }
            LRU_BAR();
        }
        if (!FINAL) { SA[((size_t)b * LRU_NCH + cki) * D_REC + ch] = Aprod; SB[((size_t)b * LRU_NCH + cki) * D_REC + ch] = h; }
    }
    __syncthreads();
}

constexpr int AT_K = 0, AT_V = 24576, AT_PSLC = 57344, AT_PSLC_LD = 132, AT_SEL = AT_PSLC + 64 * AT_PSLC_LD * 4, AT_MISC = AT_SEL + 1024, AT_OST = AT_MISC + 2560, AT_END = AT_OST + 65536;
constexpr float NEG_BIG = -INFINITY;
__device__ __forceinline__ unsigned cvtpk(float lo, float hi) { unsigned r; asm("v_cvt_pk_bf16_f32 %0, %1, %2" : "=v"(r) : "v"(lo), "v"(hi)); return r; }
__device__ __forceinline__ s16x4 vtr(const LAS char* p) { return __builtin_bit_cast(s16x4, __builtin_amdgcn_ds_read_tr16_b64_v4i16((LAS s16x4*)p)); }
__device__ __forceinline__ void dma16(const void* g, LAS char* l) { __builtin_amdgcn_global_load_lds((const unsigned*)g, (LAS unsigned*)l, 16, 0, 0); }

struct AttnW {
    LAS char* lds; int lane, wave, r32, hi, hl, qh;
};
__device__ __forceinline__ void at_load_tile(const AttnW& w, const bf16* Kt, const bf16* Vt, int tile) {
    dma16((const char*)Kt + (8 * w.wave + (w.lane >> 3)) * 128 + (((w.lane & 7) ^ (w.lane >> 3)) * 16), w.lds + AT_K + (tile % 3) * 8192 + w.wave * 1024);
    dma16((const char*)Vt + (16 * (w.wave & 3) + (w.lane >> 2)) * 128 + (w.wave >> 2) * 64 + (w.lane & 3) * 16, w.lds + AT_V + (tile & 3) * 8192 + w.wave * 1024);
}
__device__ __forceinline__ void at_ldk(const AttnW& w, int tile, s16x8 (&kf)[8]) {
    const unsigned ka = (unsigned)(uintptr_t)w.lds + (unsigned)(AT_K + (tile % 3) * 8192 + w.r32 * 128);
#pragma unroll
    for (int d0 = 0; d0 < 4; ++d0) { const unsigned kd = ka + (unsigned)((((2 * d0 + w.hi) ^ (w.r32 & 7))) * 16);
        asm volatile("ds_read_b128 %0, %1 offset:0" : "=v"(kf[2 * d0]) : "v"(kd) : "memory");
        asm volatile("ds_read_b128 %0, %1 offset:4096" : "=v"(kf[2 * d0 + 1]) : "v"(kd) : "memory"); }
}
__device__ __forceinline__ void at_ldv(const AttnW& w, int tile, s16x4 (&vl)[8], s16x4 (&vh)[8]) {
    const unsigned va = (unsigned)(uintptr_t)w.lds + (unsigned)(AT_V + (tile & 3) * 8192 + ((w.lane >> 4) & 1) * 32 + (w.lane & 3) * 8 + (4 * w.hi + ((w.lane & 15) >> 2)) * 64);
#pragma unroll
    for (int i = 0; i < 8; ++i) {
        asm volatile("ds_read_b64_tr_b16 %0, %1 offset:%2" : "=v"(vl[i]) : "v"(va), "n"((i >> 2) * 4096 + (i & 3) * 1024) : "memory");
        asm volatile("ds_read_b64_tr_b16 %0, %1 offset:%2" : "=v"(vh[i]) : "v"(va), "n"((i >> 2) * 4096 + (i & 3) * 1024 + 512) : "memory"); }
}
#define AT_LGKM0() do { asm volatile("s_waitcnt lgkmcnt(0)" ::: "memory"); __builtin_amdgcn_sched_barrier(0); } while (0)
__device__ __forceinline__ void at_bias(const AttnW& w, float ks, float lb, f32x16& p0, f32x16& p1) {
    float bb = lb + ks * (float)(4 * w.hi); const float k32 = 32.f * ks, k5 = 5.f * ks;
#pragma unroll
    for (int r = 0; r < 16; ++r) { p0[r] = bb; p1[r] = bb + k32; bb += ((r & 3) == 3) ? k5 : ks; }
}
template <int MASK>
__device__ __forceinline__ void at_bias_m(const AttnW& w, float ks, float lb, int lim, f32x16& p0, f32x16& p1) {
    float bb = lb + ks * (float)(4 * w.hi); const float k32 = 32.f * ks, k5 = 5.f * ks;
    int l0 = lim - 4 * w.hi; asm volatile("" : "+v"(l0));
#pragma unroll
    for (int r = 0; r < 16; ++r) { const int kc = (r & 3) + 8 * (r >> 2);
        const bool k0 = (MASK == 1) ? (kc <= l0) : (kc > l0), k1 = (MASK == 1) ? (kc + 32 <= l0) : (kc + 32 > l0);
        p0[r] = k0 ? bb : NEG_BIG; p1[r] = k1 ? bb + k32 : NEG_BIG; bb += ((r & 3) == 3) ? k5 : ks; }
}
__device__ __forceinline__ void at_qk(const s16x8 (&kf)[8], const s16x8 (&qr)[4], f32x16& p0, f32x16& p1) {
#pragma unroll
    for (int d0 = 0; d0 < 4; ++d0) { p0 = __builtin_amdgcn_mfma_f32_32x32x16_bf16(kf[2 * d0], qr[d0], p0, 0, 0, 0); p1 = __builtin_amdgcn_mfma_f32_32x32x16_bf16(kf[2 * d0 + 1], qr[d0], p1, 0, 0, 0); }
}
template <int MASK>
__device__ __forceinline__ void at_mask(const AttnW& w, f32x16& p0, f32x16& p1, int lim) {
    int l0 = lim - 4 * w.hi; asm volatile("" : "+v"(l0));
#pragma unroll
    for (int r = 0; r < 16; ++r) { const int kc = (r & 3) + 8 * (r >> 2);
        if (MASK == 1) { if (!(kc <= l0)) p0[r] = NEG_BIG; if (!(kc + 32 <= l0)) p1[r] = NEG_BIG; }
        if (MASK == 2) { if (!(kc > l0)) p0[r] = NEG_BIG; if (!(kc + 32 > l0)) p1[r] = NEG_BIG; } }
}
__device__ __forceinline__ void at_softmax(f32x16& p0, f32x16& p1, float& l, u32x4 (&pw)[4]) {
    float ls = 0.f;
#pragma unroll
    for (int r = 0; r < 16; ++r) { p0[r] = __builtin_amdgcn_exp2f(p0[r]); p1[r] = __builtin_amdgcn_exp2f(p1[r]); ls += p0[r] + p1[r]; }
    l += ls;
#pragma unroll
    for (int k = 0; k < 2; ++k) { pw[k] = (u32x4){cvtpk(p0[8 * k], p0[8 * k + 1]), cvtpk(p0[8 * k + 2], p0[8 * k + 3]), cvtpk(p0[8 * k + 4], p0[8 * k + 5]), cvtpk(p0[8 * k + 6], p0[8 * k + 7])};
        pw[2 + k] = (u32x4){cvtpk(p1[8 * k], p1[8 * k + 1]), cvtpk(p1[8 * k + 2], p1[8 * k + 3]), cvtpk(p1[8 * k + 4], p1[8 * k + 5]), cvtpk(p1[8 * k + 6], p1[8 * k + 7])}; }
}
__device__ __forceinline__ void at_pv(const s16x4 (&vl)[8], const s16x4 (&vh)[8], const u32x4 (&pw)[4], f32x16 (&o)[2]) {
#pragma unroll
    for (int dh = 0; dh < 2; ++dh)
#pragma unroll
        for (int k = 0; k < 4; ++k) { const s16x4 a = vl[dh * 4 + k], b = vh[dh * 4 + k];
            o[dh] = __builtin_amdgcn_mfma_f32_32x32x16_bf16((s16x8){a[0], a[1], a[2], a[3], b[0], b[1], b[2], b[3]}, __builtin_bit_cast(s16x8, pw[k]), o[dh], 0, 0, 0); }
}
#define AT_STEP(t, n, ACT_, BIASSTMT) AT_STEPM(t, n, ACT_, BIASSTMT, (void)0)
#define AT_STEPM(t, n, ACT_, BIASSTMT, MASKSTMT) do { \
        if (w.wave >= 4 && (t) > 0 && pend) { s16x4 vl[8], vh[8]; at_ldv(w, (t) - 1, vl, vh); AT_LGKM0(); at_pv(vl, vh, pw, o); } \
        pend = false; \
        if ((t) < (n) && (ACT_)) { f32x16 p0, p1; { s16x8 kf[8]; at_ldk(w, (t), kf); BIASSTMT; AT_LGKM0(); at_qk(kf, qr, p0, p1); } MASKSTMT; at_softmax(p0, p1, l, pw); pend = true; \
            if (w.wave < 4) { s16x4 vl[8], vh[8]; at_ldv(w, (t), vl, vh); AT_LGKM0(); at_pv(vl, vh, pw, o); } } } while (0)
#define AT_NEGL 60.f
#define AT_WAITBAR(newer) do { if (newer) asm volatile("s_waitcnt vmcnt(2) lgkmcnt(0)\n\ts_barrier" ::: "memory"); else asm volatile("s_waitcnt vmcnt(0) lgkmcnt(0)\n\ts_barrier" ::: "memory"); } while (0)

__device__ __forceinline__ void phase_attn_mfma(Ctx c) {
    KArgs ka = kargs(); unsigned char* ws = CA_WS;
    const bf16* Q = (const bf16*)(ws + WS_Q); const float* GATE = (const float*)(ws + WS_GATE); bf16* MIXED = (bf16*)(ws + WS_MIXED);
    AttnW w; w.lds = (LAS char*)c.lds; w.lane = c.lane; w.wave = c.wave; w.r32 = c.lane & 31; w.hi = c.lane >> 5; w.hl = (c.wave < 4) ? (c.wave >> 1) : 3 - ((c.wave - 4) >> 1); w.qh = c.wave & 1;
    LAS float* pslc = (LAS float*)(w.lds + AT_PSLC); LAS unsigned* selm = (LAS unsigned*)(w.lds + AT_SEL);
    LAS unsigned* uni = (LAS unsigned*)(w.lds + AT_MISC); LAS float* ssq = (LAS float*)(w.lds + AT_MISC + 256); LAS unsigned short* ost = (LAS unsigned short*)(w.lds + AT_OST);
    const f32x16 zero16 = (f32x16){0,0,0,0,0,0,0,0,0,0,0,0,0,0,0,0};
    for (int uu = c.bid; uu < NB_ * 128; uu += c.nblk) {
        const int b = (uu >> 6) & 3, i = (uu < 256) ? (uu & 63) : 127 - (uu & 63);
        const int s0 = i * 64;
        for (int g = 0; g < NG; ++g) {
            { int ln = c.lane; asm volatile("" : "+v"(ln)); w.lane = ln; w.r32 = ln & 31; w.hi = ln >> 5; c.lane = ln; c.tid = c.wave * 64 + ln; }
            const int qq = 32 * w.qh + w.r32, t = s0 + qq; const size_t row = (size_t)b * T_ + t;
            const size_t bg = (size_t)b * NG + g; const int h = g * 4 + w.hl;
            const float slope2 = __builtin_amdgcn_exp2f(-(float)(h + 1)) * LOG2E;
            const bf16* KC = (const bf16*)(ws + MS_KCMP) + bg * 512 * 64; const bf16* VC = (const bf16*)(ws + MS_VCMP) + bg * 512 * 64;
            const bf16* KS = (const bf16*)(ws + WS_KV + 2 * KV_STRIDE) + bg * T_ * 64; const bf16* VS = (const bf16*)(ws + WS_KV + 3 * KV_STRIDE) + bg * T_ * 64;
            const bf16* KW = (const bf16*)(ws + WS_KV + 4 * KV_STRIDE) + bg * T_ * 64; const bf16* VW = (const bf16*)(ws + WS_KV + 5 * KV_STRIDE) + bg * T_ * 64;
            s16x8 qr[4];
#pragma unroll
            for (int d0 = 0; d0 < 4; ++d0) qr[d0] = *(const s16x8*)(Q + row * 512 + h * 64 + 16 * d0 + 8 * w.hi);
            const float g0 = GATE[row * 24 + h * 3 + 0], g1 = GATE[row * 24 + h * 3 + 1], g2 = GATE[row * 24 + h * 3 + 2];
            f32x16 oacc[2]; oacc[0] = zero16; oacc[1] = zero16;
            for (int e = c.tid; e < 64 * AT_PSLC_LD; e += NTHR) pslc[e] = 0.f;
            const int ntc = ((4 * i + 2) >> 6) + 1;
            const int limc = (t - 31) >> 4;
            const float lbc = slope2 * (float)(31 - t);
            float l = 0.f; f32x16 o[2]; o[0] = zero16; o[1] = zero16;
            u32x4 pw[4]; bool pend = false;
            const int tmin = s0 + 32 * w.qh;
            {
            __syncthreads();
            at_load_tile(w, KC, VC, 0); if (ntc > 1) at_load_tile(w, KC + 4096, VC + 4096, 1);
            for (int j = 0; j <= ntc; ++j) {
                AT_WAITBAR(j + 1 < ntc);
                if (j + 2 < ntc) at_load_tile(w, KC + (size_t)(j + 2) * 4096, VC + (size_t)(j + 2) * 4096, j + 2);
                const int dmc = tmin - (1024 * j + 1039);
                AT_STEP(j, ntc, (dmc <= 0 || slope2 * (float)dmc < AT_NEGL), at_bias_m<1>(w, slope2 * 16.f, lbc + slope2 * (float)(1024 * j), limc - 64 * j, p0, p1));
            }
            }
            float lt = l + shx(l, 32, w.lane); float il = lt > 0.f ? 1.f / lt : 0.f;
#pragma unroll
            for (int r = 0; r < 16; ++r) { oacc[0][r] += o[0][r] * (g0 * il); oacc[1][r] += o[1][r] * (g0 * il); }
            if (i >= 16) {
                LAS float* ilbuf = (LAS float*)selm;
                if (w.hi == 0) ilbuf[w.hl * 64 + qq] = il;
                const int hd = w.r32 >> 3, q2 = 8 * w.wave + (w.r32 & 7), t2 = s0 + q2; const size_t row2 = (size_t)b * T_ + t2;
                s16x8 qr2[4];
#pragma unroll
                for (int d0 = 0; d0 < 4; ++d0) qr2[d0] = *(const s16x8*)(Q + row2 * 512 + (g * 4 + hd) * 64 + 16 * d0 + 8 * w.hi);
                const float sl2 = __builtin_amdgcn_exp2f(-(float)(g * 4 + hd + 1)) * LOG2E, lbc2 = sl2 * (float)(31 - t2); const int limc2 = (t2 - 31) >> 4;
                __syncthreads();
                const float il2 = ilbuf[hd * 64 + q2];
                at_load_tile(w, KC, VC, 0); if (ntc > 1) at_load_tile(w, KC + 4096, VC + 4096, 1);
                for (int j = 0; j < ntc; ++j) {
                    AT_WAITBAR(j + 1 < ntc);
                    if (j + 2 < ntc) at_load_tile(w, KC + (size_t)(j + 2) * 4096, VC + (size_t)(j + 2) * 4096, j + 2);
                    f32x16 p0, p1; { s16x8 kf[8]; at_ldk(w, j, kf); at_bias_m<1>(w, sl2 * 16.f, lbc2 + sl2 * (float)(1024 * j), limc2 - 64 * j, p0, p1); AT_LGKM0(); at_qk(kf, qr2, p0, p1); }
                    float av[8], bv[8];
#pragma unroll
                    for (int q4 = 0; q4 < 4; ++q4) {
                        const float a0 = __builtin_amdgcn_exp2f(p0[4 * q4]) * il2, a1 = __builtin_amdgcn_exp2f(p0[4 * q4 + 1]) * il2, a2 = __builtin_amdgcn_exp2f(p0[4 * q4 + 2]) * il2, a3 = __builtin_amdgcn_exp2f(p0[4 * q4 + 3]) * il2;
                        av[q4] = 2.f * ((a0 + a1) + a2) + a3; bv[q4] = a3;
                        const float c0 = __builtin_amdgcn_exp2f(p1[4 * q4]) * il2, c1 = __builtin_amdgcn_exp2f(p1[4 * q4 + 1]) * il2, c2 = __builtin_amdgcn_exp2f(p1[4 * q4 + 2]) * il2, c3 = __builtin_amdgcn_exp2f(p1[4 * q4 + 3]) * il2;
                        av[4 + q4] = 2.f * ((c0 + c1) + c2) + c3; bv[4 + q4] = c3; }
#pragma unroll
                    for (int e = 0; e < 8; ++e) { av[e] += shx(av[e], 8, w.lane); av[e] += shx(av[e], 16, w.lane); bv[e] += shx(bv[e], 8, w.lane); bv[e] += shx(bv[e], 16, w.lane); }
                    if (hd == 0) {
                        LAS float* prow = pslc + q2 * AT_PSLC_LD + 16 * j + w.hi;
#pragma unroll
                        for (int e = 0; e < 8; ++e) { LAS float* p = prow + 8 * (e >> 2) + 2 * (e & 3); *p += av[e]; }
                        asm volatile("s_waitcnt lgkmcnt(0)" ::: "memory");
#pragma unroll
                        for (int e = 0; e < 8; ++e) { LAS float* p = prow + 8 * (e >> 2) + 2 * (e & 3) + 1; *p += bv[e]; }
                        asm volatile("s_waitcnt lgkmcnt(0)" ::: "memory");
                    }
                }
            }
            __syncthreads();
            if (i < 16) { if (c.tid < 64) { selm[c.tid * 4] = (1u << (i + 1)) - 1u; selm[c.tid * 4 + 1] = 0u; selm[c.tid * 4 + 2] = 0u; selm[c.tid * 4 + 3] = 0u; }
                if (c.tid < 4) uni[c.tid] = (c.tid == 0) ? ((1u << (i + 1)) - 1u) : 0u; }
            else {
                unsigned uw0 = 0u, uw1 = 0u, uw2 = 0u, uw3 = 0u;
                for (int qi = 0; qi < 8; ++qi) {
                    const int q = w.wave * 8 + qi; const int n0 = w.lane, n1 = w.lane + 64;
                    const bool c0 = (n0 >= 1 && n0 <= i - 2), c1 = (n1 <= i - 2);
                    const unsigned v0 = c0 ? __float_as_uint(pslc[q * AT_PSLC_LD + n0]) : 0u, v1 = c1 ? __float_as_uint(pslc[q * AT_PSLC_LD + n1]) : 0u;
                    unsigned T = 0u;
                    for (int bit = 30; bit >= 0; --bit) { const unsigned cand = T | (1u << bit);
                        const int cnt = __builtin_popcountll(__ballot(c0 && v0 >= cand)) + __builtin_popcountll(__ballot(c1 && v1 >= cand));
                        if (cnt >= 13) { T = cand; if (cnt == 13) break; } }
                    const unsigned long long gt0 = __ballot(c0 && v0 > T), gt1 = __ballot(c1 && v1 > T), eq0 = __ballot(c0 && v0 == T), eq1 = __ballot(c1 && v1 == T);
                    const int need = 13 - (__builtin_popcountll(gt0) + __builtin_popcountll(gt1));
                    const unsigned long long below = (w.lane == 0) ? 0ull : (~0ull >> (64 - w.lane));
                    const bool s0b = (c0 && v0 > T) || (c0 && v0 == T && __builtin_popcountll(eq0 & below) < need);
                    const bool s1b = (c1 && v1 > T) || (c1 && v1 == T && (__builtin_popcountll(eq0) + __builtin_popcountll(eq1 & below)) < need);
                    unsigned long long m0 = __ballot(s0b), m1 = __ballot(s1b);
                    m0 |= 1ull; { const int f1 = i - 1, f2 = i; if (f1 < 64) m0 |= 1ull << f1; else m1 |= 1ull << (f1 - 64); if (f2 < 64) m0 |= 1ull << f2; else m1 |= 1ull << (f2 - 64); }
                    if (w.lane == 0) { selm[q * 4] = (unsigned)m0; selm[q * 4 + 1] = (unsigned)(m0 >> 32); selm[q * 4 + 2] = (unsigned)m1; selm[q * 4 + 3] = (unsigned)(m1 >> 32); }
                    uw0 |= (unsigned)m0; uw1 |= (unsigned)(m0 >> 32); uw2 |= (unsigned)m1; uw3 |= (unsigned)(m1 >> 32);
                }
                if (w.lane == 0) { uni[4 + w.wave * 4] = uw0; uni[4 + w.wave * 4 + 1] = uw1; uni[4 + w.wave * 4 + 2] = uw2; uni[4 + w.wave * 4 + 3] = uw3; }
                __syncthreads();
                if (c.tid < 4) { unsigned u = 0u; for (int k = 0; k < 8; ++k) u |= uni[4 + k * 4 + c.tid]; uni[c.tid] = u; }
            }
            __syncthreads();
            unsigned um[4]; um[0] = uni[0]; um[1] = uni[1]; um[2] = uni[2]; um[3] = uni[3];
            const unsigned sm0 = selm[qq * 4], sm1 = selm[qq * 4 + 1], sm2 = selm[qq * 4 + 2], sm3 = selm[qq * 4 + 3];
            {
                l = 0.f; o[0] = zero16; o[1] = zero16;
                um[0] = __builtin_amdgcn_readfirstlane(um[0]); um[1] = __builtin_amdgcn_readfirstlane(um[1]); um[2] = __builtin_amdgcn_readfirstlane(um[2]); um[3] = __builtin_amdgcn_readfirstlane(um[3]);
                int wsel = 0; unsigned cur = um[0];
                auto next_blk = [&]() -> int { while (cur == 0u && wsel < 3) { ++wsel; cur = (wsel == 1) ? um[1] : (wsel == 2) ? um[2] : um[3]; }
                    if (cur == 0u) return -1; const int bpos = __builtin_ctz(cur); cur &= cur - 1u; return wsel * 32 + bpos; };
                int nb = next_blk(), nb1 = next_blk(), it = 0;
                __syncthreads();
                at_load_tile(w, KS + (size_t)nb * 4096, VS + (size_t)nb * 4096, 0);
                if (nb1 >= 0) at_load_tile(w, KS + (size_t)nb1 * 4096, VS + (size_t)nb1 * 4096, 1);
                for (;;) {
                    const int nb2 = (nb1 >= 0) ? next_blk() : -1;
                    AT_WAITBAR(nb1 >= 0);
                    if (nb2 >= 0) at_load_tile(w, KS + (size_t)nb2 * 4096, VS + (size_t)nb2 * 4096, it + 2);
                    const int nbc = nb < 0 ? 0 : nb;
                    const unsigned smw = (nbc < 32) ? sm0 : (nbc < 64) ? sm1 : (nbc < 96) ? sm2 : sm3;
                    const bool en = (smw >> (nbc & 31)) & 1u;
                    const float lb = en ? slope2 * (float)(64 * nbc - t) : NEG_BIG;
                    const int dms = tmin - (64 * nbc + 63);
                    AT_STEP(it, (nb >= 0 ? it + 1 : it), (dms <= 0 || slope2 * (float)dms < AT_NEGL), if (nb == i) at_bias_m<1>(w, slope2, lb, qq, p0, p1); else at_bias(w, slope2, lb, p0, p1));
                    if (nb < 0) break;
                    nb = nb1; nb1 = nb2; ++it;
                }
                lt = l + shx(l, 32, w.lane); il = lt > 0.f ? 1.f / lt : 0.f;
#pragma unroll
                for (int r = 0; r < 16; ++r) { oacc[0][r] += o[0][r] * (g1 * il); oacc[1][r] += o[1][r] * (g1 * il); }
            }
            {
                l = 0.f; o[0] = zero16; o[1] = zero16;
                const int j0 = (i >= 8) ? 0 : 8 - i;
                const bf16* KW0 = KW + (ptrdiff_t)(s0 - 512) * 64; const bf16* VW0 = VW + (ptrdiff_t)(s0 - 512) * 64;
                __syncthreads();
                at_load_tile(w, KW0 + (ptrdiff_t)j0 * 4096, VW0 + (ptrdiff_t)j0 * 4096, 0); if (j0 < 8) at_load_tile(w, KW0 + (ptrdiff_t)(j0 + 1) * 4096, VW0 + (ptrdiff_t)(j0 + 1) * 4096, 1);
                for (int j = j0; j <= 9; ++j) {
                    AT_WAITBAR(j < 8);
                    if (j + 2 <= 8) at_load_tile(w, KW0 + (ptrdiff_t)(j + 2) * 4096, VW0 + (ptrdiff_t)(j + 2) * 4096, j - j0 + 2);
                    const int dmw = 32 * w.qh + 449 - 64 * j;
                    AT_STEPM(j - j0, 9 - j0, (dmw <= 0 || slope2 * (float)dmw < AT_NEGL), at_bias(w, slope2, slope2 * (float)(64 * j - 512 - qq), p0, p1), if (j == 0) at_mask<2>(w, p0, p1, qq); else if (j == 8) at_mask<1>(w, p0, p1, qq));
                }
                lt = l + shx(l, 32, w.lane); il = lt > 0.f ? 1.f / lt : 0.f;
#pragma unroll
                for (int r = 0; r < 16; ++r) { oacc[0][r] += o[0][r] * (g2 * il); oacc[1][r] += o[1][r] * (g2 * il); }
            }
            {
                float sq = 0.f;
#pragma unroll
                for (int dh = 0; dh < 2; ++dh)
#pragma unroll
                    for (int r4 = 0; r4 < 4; ++r4) { const float x0 = oacc[dh][4 * r4], x1 = oacc[dh][4 * r4 + 1], x2 = oacc[dh][4 * r4 + 2], x3 = oacc[dh][4 * r4 + 3];
                        sq += (x0 * x0 + x1 * x1) + (x2 * x2 + x3 * x3);
                        u32x2 pk; pk.x = cvtpk(x0, x1); pk.y = cvtpk(x2, x3);
                        *(LAS u32x2*)(ost + qq * 512 + h * 64 + 32 * dh + 8 * r4 + 4 * w.hi) = pk; }
                sq += shx(sq, 32, w.lane);
                if (w.hi == 0) ssq[(g * 4 + w.hl) * 64 + qq] = sq;
            }
            __syncthreads();
        }
        {
            const int q = c.tid >> 3, part = c.tid & 7;
            float ss = 0.f;
#pragma unroll
            for (int k = 0; k < 8; ++k) ss += ssq[k * 64 + q];
            const float rs = __builtin_amdgcn_rsqf(ss * (1.f / 512.f) + RMS_EPS);
            bf16* orow = MIXED + ((size_t)b * T_ + s0 + q) * D_ + part * 64;
#pragma unroll
            for (int k = 0; k < 8; ++k) { const u32x4 v = *(const LAS u32x4*)(ost + q * 512 + part * 64 + 8 * k);
                u32x4 o4; o4.x = cvtpk(__uint_as_float(v.x << 16) * rs, __uint_as_float(v.x & 0xffff0000u) * rs); o4.y = cvtpk(__uint_as_float(v.y << 16) * rs, __uint_as_float(v.y & 0xffff0000u) * rs);
                o4.z = cvtpk(__uint_as_float(v.z << 16) * rs, __uint_as_float(v.z & 0xffff0000u) * rs); o4.w = cvtpk(__uint_as_float(v.w << 16) * rs, __uint_as_float(v.w & 0xffff0000u) * rs);
                *(u32x4*)(orow + 8 * k) = o4; }
        }
        __syncthreads();
    }
}

static_assert(AT_END <= LDS_WORK, "attention LDS map");
typedef float f32x4v __attribute__((ext_vector_type(4)));
__device__ __forceinline__ void phase_cmp_mfma(Ctx c, int L) {
    KArgs ka = kargs(); unsigned char* ws = CA_WS;
    LAS char* lds = (LAS char*)c.lds; LAS char* hidl = lds + 69632;
    LAS float* pbl = (LAS float*)(lds + 69632 + 8704);
    const int lane = c.lane, wv = c.wave, fr = lane & 15, fq = lane >> 4;
    for (int u = c.bid; u < 2 * NB_ * NG * 16; u += c.nblk) {
        const int kv = u >> 7, bg = (u >> 4) & 7, c0 = (u & 15) * 32;
        const bf16* RAW = (const bf16*)(ws + WS_KV + kv * KV_STRIDE) + ((size_t)bg * T_ + 16 * c0) * 64;
        const bf16* W1T = (const bf16*)(ws + WB_C1T) + ((size_t)L * 2 + kv) * CMP_HID * (L_CMP * HD); const bf16* W2T = (const bf16*)(ws + WB_C2T) + ((size_t)L * 2 + kv) * HD * CMP_HID;
        const float* PP = (const float*)(ws + WB_POSBP) + ((size_t)L * 2 + kv) * 32 * CMP_HID;
        bf16* OUT = (bf16*)(ws + (kv ? MS_VCMP : MS_KCMP)) + (size_t)bg * 512 * 64;
        __syncthreads();
        for (int e = c.tid; e < 528 * 8; e += NTHR) { const int tk = e >> 3, ch = e & 7; *(LAS u32x4*)(lds + tk * 128 + (tk >> 4) * 16 + ch * 16) = *(const u32x4*)(RAW + (size_t)tk * 64 + ch * 8); }
        if (c.tid < CMP_HID) { float a = 0.f; for (int k = 0; k < 32; ++k) a += PP[k * CMP_HID + c.tid]; pbl[c.tid] = a; }
        __syncthreads();
        f32x4v acc[2]; acc[0] = (f32x4v){0.f, 0.f, 0.f, 0.f}; acc[1] = acc[0];
        const bf16* wrow = W1T + (size_t)(16 * wv + fr) * (L_CMP * HD) + 8 * fq;
#pragma unroll 4
        for (int st = 0; st < 64; ++st) {
            const s16x8 bfr = *(const s16x8*)(wrow + 32 * st);
            const int tk = st >> 1, off = tk * 128 + (tk >> 4) * 16 + (32 * (st & 1) + 8 * fq) * 2;
#pragma unroll
            for (int rt = 0; rt < 2; ++rt) { const s16x8 afr = *(const LAS s16x8*)(lds + (16 * rt + fr) * 2064 + off);
                acc[rt] = __builtin_amdgcn_mfma_f32_16x16x32_bf16(afr, bfr, acc[rt], 0, 0, 0); }
        }
        { const float pb = pbl[16 * wv + fr];
#pragma unroll
          for (int rt = 0; rt < 2; ++rt)
#pragma unroll
              for (int i = 0; i < 4; ++i) *(LAS unsigned short*)(hidl + ((16 * rt + 4 * fq + i) * 136 + 16 * wv + fr) * 2) = f2bf(gelu_tanh(acc[rt][i] + pb)); }
        __syncthreads();
        { const int rt = wv & 1, ct = wv >> 1; f32x4v o = (f32x4v){0.f, 0.f, 0.f, 0.f};
#pragma unroll
          for (int st = 0; st < 4; ++st) { const s16x8 afr = *(const LAS s16x8*)(hidl + ((16 * rt + fr) * 136 + 32 * st + 8 * fq) * 2); const s16x8 bfr = *(const s16x8*)(W2T + (size_t)(16 * ct + fr) * CMP_HID + 32 * st + 8 * fq);
              o = __builtin_amdgcn_mfma_f32_16x16x32_bf16(afr, bfr, o, 0, 0, 0); }
#pragma unroll
          for (int i = 0; i < 4; ++i) { const int cr = c0 + 16 * rt + 4 * fq + i; OUT[(size_t)cr * 64 + 16 * ct + fr] = (cr < N_CMP) ? f2bf(o[i]) : (bf16)0; } }
    }
}

__device__ __forceinline__ void phase_moe_route(Ctx c, int stage) {
    KArgs ka = kargs();
    unsigned char* ws = CA_WS; int* TOPE = (int*)(ws + MS_TOPE); float* TOPG = (float*)(ws + MS_TOPG); int* UCNT = (int*)(ws + MS_UCNT);
    const float* RW = CA_IN(I_ROUTER_W); const float* gn = CA_IN(I_FFN_NORM) + 1 * D_;
    LAS int* cnt = (LAS int*)c.lds;
    for (int u = c.bid; u < 256; u += c.nblk) {
        if (c.tid < 16) cnt[c.tid] = 0;
        __syncthreads();
        for (int i = 0; i < 16; ++i) {
            const int m = u * 128 + c.wave * 16 + i;
            const float rs = row_rs(c.SSP, stage, m);
            float lg[8] = {0, 0, 0, 0, 0, 0, 0, 0};
            for (int j = 0; j < 16; ++j) { const int k = c.lane + 64 * j; const float hv = bf2f(c.XB[(size_t)m * D_ + k]) * rs * gn[k]; const f32x4 w0 = *(const f32x4*)(RW + (size_t)k * 8), w1 = *(const f32x4*)(RW + (size_t)k * 8 + 4);
                lg[0] = fmaf(hv, w0.x, lg[0]); lg[1] = fmaf(hv, w0.y, lg[1]); lg[2] = fmaf(hv, w0.z, lg[2]); lg[3] = fmaf(hv, w0.w, lg[3]);
                lg[4] = fmaf(hv, w1.x, lg[4]); lg[5] = fmaf(hv, w1.y, lg[5]); lg[6] = fmaf(hv, w1.z, lg[6]); lg[7] = fmaf(hv, w1.w, lg[7]); }
#pragma unroll
            for (int e = 0; e < 8; ++e) lg[e] = wave_sum(lg[e], c.lane);
            int e0 = 0; float l0 = lg[0];
#pragma unroll
            for (int e = 1; e < 8; ++e) if (lg[e] > l0) { l0 = lg[e]; e0 = e; }
            int e1 = -1; float l1 = -INFINITY;
#pragma unroll
            for (int e = 0; e < 8; ++e) if (e != e0 && lg[e] > l1) { l1 = lg[e]; e1 = e; }
            const float z = __expf(l1 - l0), g0 = 1.f / (1.f + z), g1 = z / (1.f + z);
            if (c.lane == 0) { TOPE[m * 2] = e0; TOPE[m * 2 + 1] = e1; TOPG[m * 2] = g0; TOPG[m * 2 + 1] = g1; __hip_atomic_fetch_add(&cnt[e0], 1, __ATOMIC_RELAXED, __HIP_MEMORY_SCOPE_WORKGROUP); __hip_atomic_fetch_add(&cnt[8 + e1], 1, __ATOMIC_RELAXED, __HIP_MEMORY_SCOPE_WORKGROUP); }
        }
        __syncthreads();
        if (c.tid < 16) UCNT[c.tid * 256 + u] = cnt[c.tid];
        __syncthreads();
    }
}
__device__ __forceinline__ int wave_sum_i(int v, int lane) {
#pragma unroll
    for (int o = 1; o < 64; o <<= 1) v += shxi(v, o, lane);
    return v;
}
__device__ __forceinline__ void phase_moe_slots(Ctx c, int stage) {
    KArgs ka = kargs();
    unsigned char* ws = CA_WS; const int* TOPE = (const int*)(ws + MS_TOPE); const float* TOPG = (const float*)(ws + MS_TOPG); const int* UCNT = (const int*)(ws + MS_UCNT);
    int* SLOT_TOK = (int*)(ws + MS_SLOTTOK); float* SLOT_G = (float*)(ws + MS_SLOTG); float* SLOT_RS = (float*)(ws + MS_SLOTRS); int* PANEL_E = (int*)(ws + MS_PANELE);
    LAS int* sh = (LAS int*)c.lds;
    typedef int i32x4 __attribute__((ext_vector_type(4)));
    i32x4 cv[2];
#pragma unroll
    for (int j = 0; j < 2; ++j) { cv[j] = *(const i32x4*)(UCNT + (c.wave + 8 * j) * 256 + 4 * c.lane); const int t = wave_sum_i((cv[j].x + cv[j].y) + (cv[j].z + cv[j].w), c.lane); if (c.lane == 0) sh[c.wave + 8 * j] = t; }
    __syncthreads();
    if (c.tid == 0) { int ps = 0; for (int e = 0; e < 16; ++e) { sh[16 + e] = ps; ps += (sh[e] + 255) / 256 * 256; } sh[48] = ps; }
    __syncthreads();
    for (int s2 = c.bid * NTHR + c.tid; s2 < NSLOT; s2 += c.nblk * NTHR) {
        int gi = 15; for (int k = 0; k < 16; ++k) { if (s2 >= sh[16 + k] && s2 < sh[16 + k] + (sh[k] + 255) / 256 * 256) { gi = k; break; } }
        const bool used = s2 < sh[48];
        const bool real = used && (s2 - sh[16 + gi]) < sh[gi];
        if (!real) { SLOT_TOK[s2] = -1; SLOT_G[s2] = 0.f; SLOT_RS[s2] = 0.f; }
        if ((s2 & 255) == 0) PANEL_E[s2 >> 8] = used ? (gi & 7) : -1;
    }
    if (c.bid == 0 && c.tid == 0) { PANEL_E[300] = sh[16 + 8] >> 8; PANEL_E[301] = sh[48] >> 8; }
    for (int u = c.bid; u < 256; u += c.nblk) {
        __syncthreads();
#pragma unroll
        for (int j = 0; j < 2; ++j) { const int u4 = 4 * c.lane; const int bsum = (u4 < u ? cv[j].x : 0) + (u4 + 1 < u ? cv[j].y : 0) + (u4 + 2 < u ? cv[j].z : 0) + (u4 + 3 < u ? cv[j].w : 0);
            const int t = wave_sum_i(bsum, c.lane); if (c.lane == 0) sh[32 + c.wave + 8 * j] = t; }
        int rank = 0, e = -1, k = 0, m = 0;
        if (c.wave < 4) { k = c.wave >> 1; m = u * 128 + (c.wave & 1) * 64 + c.lane; e = TOPE[m * 2 + k];
            const unsigned long long below = (c.lane == 0) ? 0ull : (~0ull >> (64 - c.lane));
#pragma unroll
            for (int e2 = 0; e2 < 8; ++e2) { const unsigned long long mk = __ballot(e == e2); if (e == e2) rank = __builtin_popcountll(mk & below); if (c.lane == 0) sh[64 + c.wave * 8 + e2] = __builtin_popcountll(mk); } }
        __syncthreads();
        if (c.wave < 4) { if (c.wave & 1) rank += sh[64 + (c.wave - 1) * 8 + e];
            const int gi = 8 * k + e, s2 = sh[16 + gi] + sh[32 + gi] + rank;
            SLOT_TOK[s2] = m; SLOT_G[s2] = TOPG[m * 2 + k] * (1.f / (W8_SCALE * ACT8_SCALE)); SLOT_RS[s2] = row_rs(c.SSP, stage, m) * (1.f / (W8_SCALE * X8_SCALE)); }
    }
}
constexpr int N_IN_PAD = 2560;
constexpr int TR_BUF = 8 * 264;
template <class AF>
__device__ __forceinline__ void tr_issue(AF ap, int k0, int n0, LAS float* buf, int lane) {
    const int r8 = lane >> 3, c4 = 4 * (lane & 7);
#pragma unroll
    for (int i = 0; i < 8; ++i) __builtin_amdgcn_global_load_lds((const unsigned*)ap(k0 + 8 * i + r8, n0 + c4), (LAS unsigned*)(buf + i * 264), 16, 0, 0);
}
#define TR_RD(dst, off) asm volatile("ds_read_b32 %0, %1 offset:" #off : "=v"(dst) : "v"(la))
template <int F8, class CF>
__device__ __forceinline__ void tr_finish(f32x4 g0, f32x4 g1, const LAS float* gl, CF cm, bf16* WT, int ldt, int k0, int n0, const LAS float* buf, int lane) {
    const int cch = lane & 7, nr = lane >> 3;
    const unsigned la = (unsigned)(size_t)(buf + cch * 264 + nr);
    float v[4][8];
    TR_RD(v[0][0], 0);  TR_RD(v[0][1], 128);  TR_RD(v[0][2], 256);  TR_RD(v[0][3], 384);  TR_RD(v[0][4], 512);  TR_RD(v[0][5], 640);  TR_RD(v[0][6], 768);  TR_RD(v[0][7], 896);
    TR_RD(v[1][0], 32); TR_RD(v[1][1], 160);  TR_RD(v[1][2], 288);  TR_RD(v[1][3], 416);  TR_RD(v[1][4], 544);  TR_RD(v[1][5], 672);  TR_RD(v[1][6], 800);  TR_RD(v[1][7], 928);
    TR_RD(v[2][0], 64); TR_RD(v[2][1], 192);  TR_RD(v[2][2], 320);  TR_RD(v[2][3], 448);  TR_RD(v[2][4], 576);  TR_RD(v[2][5], 704);  TR_RD(v[2][6], 832);  TR_RD(v[2][7], 960);
    TR_RD(v[3][0], 96); TR_RD(v[3][1], 224);  TR_RD(v[3][2], 352);  TR_RD(v[3][3], 480);  TR_RD(v[3][4], 608);  TR_RD(v[3][5], 736);  TR_RD(v[3][6], 864);  TR_RD(v[3][7], 992);
    if (gl) { const unsigned ga = (unsigned)(size_t)(gl + k0 + 8 * cch); asm volatile("ds_read_b128 %0, %1" : "=v"(g0) : "v"(ga)); asm volatile("ds_read_b128 %0, %1 offset:16" : "=v"(g1) : "v"(ga)); }
    asm volatile("s_waitcnt lgkmcnt(0)" ::: "memory"); __builtin_amdgcn_sched_barrier(0);
#pragma unroll
    for (int j = 0; j < 4; ++j) { const int n = nr + 8 * j; const float m = cm(n0 + n);
        if constexpr (F8 == 2) { unsigned w0, w1; auto q8 = [](float x) { return (unsigned)(int)__builtin_rintf(__builtin_amdgcn_fmed3f(x, -127.f, 127.f)) & 255u; };
            w0 = q8(g0.x * v[j][0] * m) | (q8(g0.y * v[j][1] * m) << 8) | (q8(g0.z * v[j][2] * m) << 16) | (q8(g0.w * v[j][3] * m) << 24);
            w1 = q8(g1.x * v[j][4] * m) | (q8(g1.y * v[j][5] * m) << 8) | (q8(g1.z * v[j][6] * m) << 16) | (q8(g1.w * v[j][7] * m) << 24);
            *(u32x2*)((unsigned char*)WT + (size_t)(n0 + n) * ldt + k0 + 8 * cch) = (u32x2){w0, w1}; }
        else if constexpr (F8 == 1) { int w0 = 0, w1 = 0;
            w0 = __builtin_amdgcn_cvt_pk_fp8_f32(g0.x * v[j][0] * m, g0.y * v[j][1] * m, w0, false); w0 = __builtin_amdgcn_cvt_pk_fp8_f32(g0.z * v[j][2] * m, g0.w * v[j][3] * m, w0, true);
            w1 = __builtin_amdgcn_cvt_pk_fp8_f32(g1.x * v[j][4] * m, g1.y * v[j][5] * m, w1, false); w1 = __builtin_amdgcn_cvt_pk_fp8_f32(g1.z * v[j][6] * m, g1.w * v[j][7] * m, w1, true);
            *(u32x2*)((unsigned char*)WT + (size_t)(n0 + n) * ldt + k0 + 8 * cch) = (u32x2){(unsigned)w0, (unsigned)w1}; }
        else {
        u32x4 o; o.x = pk2(g0.x * v[j][0] * m, g0.y * v[j][1] * m); o.y = pk2(g0.z * v[j][2] * m, g0.w * v[j][3] * m); o.z = pk2(g1.x * v[j][4] * m, g1.y * v[j][5] * m); o.w = pk2(g1.z * v[j][6] * m, g1.w * v[j][7] * m);
        *(u32x4*)(WT + (size_t)(n0 + n) * ldt + k0 + 8 * cch) = o; } }
}
#undef TR_RD
constexpr int TR_GAIN_OFF = NWAVES * 2 * TR_BUF;
static_assert((TR_GAIN_OFF + 1024) * 4 <= LDS_WORK, "conversion LDS map");
template <int F8 = 0, class AF, class GF, class CF>
__device__ __forceinline__ void transpose_matrix(Ctx& c, AF ap, GF gk, CF cm, bf16* WT, int K, int Nd, int& it0) {
    const int gw = c.bid * NWAVES + c.wave, NGW = c.nblk * NWAVES, nnb = Nd / 32, nkb = K / 64, nit = nkb * nnb;
    const bool grouped = (nnb % 8) == 0;
    const int NG8 = nnb >> 3, G = nkb * NG8, CH = (G + c.nblk - 1) / c.nblk;
    const int cu = (c.bid + c.nblk - (it0 >> 3) % c.nblk) % c.nblk, base = cu * CH;
    const int first = (gw - it0 % NGW + NGW) % NGW;
    const int cnt = grouped ? (base >= G ? 0 : (G - base < CH ? G - base : CH)) : (first < nit ? (nit - 1 - first) / NGW + 1 : 0);
    LAS float* scr = c.lds + c.wave * (2 * TR_BUF);
    const LAS float* gl = nullptr;
    if (gk(0) != nullptr) {
        LAS float* gw_ = c.lds + TR_GAIN_OFF;
        __syncthreads();
        if (c.tid < K / 4 && K <= 1024) *(LAS f32x4*)(gw_ + 4 * c.tid) = *(const f32x4*)gk(4 * c.tid);
        __syncthreads();
        gl = gw_;
    }
    int sq = 0, pb = 0; bool fst = true;
#define TR_DECODE(s_, k0_, n0_) do { if (grouped) { const int L_ = base + (s_); k0_ = 64 * (L_ % nkb); n0_ = 32 * ((L_ / nkb) * 8 + c.wave); } else { const int it_ = first + (s_) * NGW; k0_ = 64 * (it_ / nnb); n0_ = 32 * (it_ % nnb); } } while (0)
    const f32x4 one4 = (f32x4){1.f, 1.f, 1.f, 1.f};
    if (cnt > 0) { int k0, n0; TR_DECODE(0, k0, n0); tr_issue(ap, k0, n0, scr, c.lane); }
    while (sq < cnt) {
        int k0, n0; TR_DECODE(sq, k0, n0);
        if (sq + 1 < cnt) { int k1, n1; TR_DECODE(sq + 1, k1, n1); tr_issue(ap, k1, n1, scr + (pb ^ 1) * TR_BUF, c.lane);
            if (fst) asm volatile("s_waitcnt vmcnt(8)" ::: "memory"); else asm volatile("s_waitcnt vmcnt(12)" ::: "memory"); }
        else { if (fst) asm volatile("s_waitcnt vmcnt(0)" ::: "memory"); else asm volatile("s_waitcnt vmcnt(4)" ::: "memory"); }
        tr_finish<F8>(one4, one4, gl, cm, WT, K, k0, n0, scr + pb * TR_BUF, c.lane);
        fst = false; ++sq; pb ^= 1;
    }
#undef TR_DECODE
    it0 += grouped ? 8 * ((G + CH - 1) / CH) : nit;
}
template <int PART>
__device__ __forceinline__ void phase_convert(Ctx c) {
    KArgs ka = kargs(); unsigned char* ws = CA_WS; int it0 = 0;
    auto one = [](int) { return 1.f; }; auto nog = [](int) { return (const float*)nullptr; };
    for (int L = 0; L < DEPTH; ++L) {
        if ((L == 0) == (PART == 0))
        { const float* W = CA_IN(I_W_IN) + (size_t)L * D_ * IN_COLS; const float* gn = CA_IN(I_ATTN_NORM) + L * D_;
          auto scol = [](int n) { return n < 1280 ? n : (n < 1792 ? C_XR + (n - 1280) : (n < 2304 ? C_YG + (n - 1792) : (n < 2328 ? C_G + (n - 2304) : -1))); };
          transpose_matrix(c, [=](int k, int n) { const int sc = scol(n); return W + (size_t)k * IN_COLS + (sc < 0 ? 0 : sc); }, [=](int k) { return gn + k; }, [=](int n) { return scol(n) < 0 ? 0.f : 1.f; },
                           (bf16*)(ws + WB_IN) + (size_t)L * N_IN_PAD * D_, D_, N_IN_PAD, it0); }
        if (PART == 1) {
        { const float* W = CA_IN(I_W_OUT) + (size_t)L * D_ * D_; const float* ga = CA_IN(I_OUT_NORM_ATTN) + L * 512; const float* gr = CA_IN(I_OUT_NORM_REC) + L * 512;
          transpose_matrix(c, [=](int k, int n) { return W + (size_t)k * D_ + n; }, [=](int k) { return k < 512 ? ga + k : gr + (k - 512); }, one, (bf16*)(ws + WB_OUT) + (size_t)L * D_ * D_, D_, D_, it0); }
        { const float* W = CA_IN(I_PLE_WG) + (size_t)L * D_ * D_; const float* gn = CA_IN(I_PLE_NORM) + L * D_;
          transpose_matrix(c, [=](int k, int n) { return W + (size_t)k * D_ + n; }, [=](int k) { return gn + k; }, one, (bf16*)(ws + WB_PLEG) + (size_t)L * D_ * D_, D_, D_, it0); }
        { const float* W = CA_IN(I_PLE_WP) + (size_t)L * PLE_DIM * D_;
          transpose_matrix(c, [=](int k, int n) { return W + (size_t)k * D_ + n; }, nog, one, (bf16*)(ws + WB_PLEP) + (size_t)L * D_ * PLE_DIM, PLE_DIM, D_, it0); }
        }
    }
    if (PART == 1) {
    { const float* WG = CA_IN(I_DENSE_WG); const float* WU = CA_IN(I_DENSE_WU); const float* gn = CA_IN(I_FFN_NORM);
      transpose_matrix<2>(c, [=](int k, int n) { const int col = 128 * (n >> 8) + (n & 127); return ((n >> 7) & 1 ? WU : WG) + (size_t)k * D_FF + col; }, [=](int k) { return gn + k; }, [](int) { return WI8_SCALE; }, (bf16*)(ws + WB_GU), D_, 2 * D_FF, it0); }
    { const float* WD = CA_IN(I_DENSE_WD);
      transpose_matrix<1>(c, [=](int k, int n) { return WD + (size_t)k * D_ + n; }, nog, [](int) { return W8_SCALE; }, (bf16*)(ws + WB_DN), D_FF, D_, it0); }
    { const float* WG = CA_IN(I_MOE_WG); const float* WU = CA_IN(I_MOE_WU); const float* gn = CA_IN(I_FFN_NORM) + D_;
      transpose_matrix<1>(c, [=](int k, int n) { const int e = n / (2 * D_FFE), nn = n % (2 * D_FFE), col = 128 * (nn >> 8) + (nn & 127); return ((nn >> 7) & 1 ? WU : WG) + (size_t)e * D_ * D_FFE + (size_t)k * D_FFE + col; },
                       [=](int k) { return gn + k; }, [](int) { return W8_SCALE; }, (bf16*)(ws + WB_MGU), D_, N_EXP * 2 * D_FFE, it0); }
    { const float* WD = CA_IN(I_MOE_WD);
      transpose_matrix<1>(c, [=](int k, int n) { const int e = n / D_, nn = n % D_; return WD + (size_t)e * D_FFE * D_ + (size_t)k * D_ + nn; }, nog, [](int) { return W8_SCALE; }, (bf16*)(ws + WB_MDN), D_FFE, N_EXP * D_, it0); }
    }
    if (PART == 0)
    for (int L = 0; L < DEPTH; ++L) {
        for (int kv = 0; kv < 2; ++kv) {
            const float* W1 = CA_IN(I_CMP_W1) + ((size_t)L * 2 + kv) * (L_CMP * HD) * CMP_HID; const float* W2 = CA_IN(I_CMP_W2) + ((size_t)L * 2 + kv) * CMP_HID * HD;
            transpose_matrix(c, [=](int k, int n) { return W1 + (size_t)k * CMP_HID + n; }, nog, one, (bf16*)(ws + WB_C1T) + ((size_t)L * 2 + kv) * CMP_HID * (L_CMP * HD), L_CMP * HD, CMP_HID, it0);
            transpose_matrix(c, [=](int k, int n) { return W2 + (size_t)k * HD + n; }, nog, one, (bf16*)(ws + WB_C2T) + ((size_t)L * 2 + kv) * HD * CMP_HID, CMP_HID, HD, it0);
        }
        for (int blk = 0; blk < 8; ++blk) {
            const float* WA = CA_IN(I_LRU_WA) + ((size_t)L * 8 + blk) * 4096; const float* WX = CA_IN(I_LRU_WX) + ((size_t)L * 8 + blk) * 4096;
            transpose_matrix(c, [=](int k, int n) { return WA + k * 64 + n; }, nog, one, (bf16*)(ws + WB_LWA) + ((size_t)L * 8 + blk) * 4096, 64, 64, it0);
            transpose_matrix(c, [=](int k, int n) { return WX + k * 64 + n; }, nog, one, (bf16*)(ws + WB_LWX) + ((size_t)L * 8 + blk) * 4096, 64, 64, it0);
        }
    }
    asm volatile("s_waitcnt vmcnt(0) lgkmcnt(0)" ::: "memory");
    if (PART == 0)
    { float* PP = (float*)(ws + WB_POSBP);
      for (int task = c.bid; task < DEPTH * 2 * 32; task += c.nblk) { const int lk = task >> 5, sl = task & 31;
          if (c.tid < CMP_HID) { const float* W1 = CA_IN(I_CMP_W1) + (size_t)lk * (L_CMP * HD) * CMP_HID + (size_t)sl * 64 * CMP_HID + c.tid; const float* POS = CA_IN(I_CMP_POS) + (size_t)lk * (L_CMP * HD) + sl * 64;
              float a = 0.f; for (int k = 0; k < 64; ++k) a = fmaf(POS[k], W1[(size_t)k * CMP_HID], a);
              PP[(size_t)task * CMP_HID + c.tid] = a; } } }
    if (PART == 1)
    { const float* P = CA_IN(I_P); bf16* PB = (bf16*)(ws + WS_PB); const size_t n8 = (size_t)DEPTH * NTOK * PLE_DIM / 8, step = (size_t)c.nblk * NTHR;
      for (size_t i = (size_t)c.bid * NTHR + c.tid; i < n8; i += 4 * step) {
          f32x4 a[4], b[4];
#pragma unroll
          for (int q = 0; q < 4; ++q) { a[q] = ((const f32x4*)P)[2 * (i + q * step)]; b[q] = ((const f32x4*)P)[2 * (i + q * step) + 1]; }
#pragma unroll
          for (int q = 0; q < 4; ++q) { u32x4 o; o.x = pk2(a[q].x, a[q].y); o.y = pk2(a[q].z, a[q].w); o.z = pk2(b[q].x, b[q].y); o.w = pk2(b[q].z, b[q].w); ((u32x4*)PB)[i + q * step] = o; } } }
}
static_assert(((size_t)DEPTH * NTOK * PLE_DIM / 8) % (4 * 256 * NTHR) == 0, "p cast loop");

__device__ __forceinline__ u32x4 pack8(const f32x4 a, const f32x4 b) { u32x4 w; w.x = pg8::cvt_pk_bf16(a[0], a[1]); w.y = pg8::cvt_pk_bf16(a[2], a[3]); w.z = pg8::cvt_pk_bf16(b[0], b[1]); w.w = pg8::cvt_pk_bf16(b[2], b[3]); return w; }
struct EpiInproj {
    static constexpr bool PERM = true, AFTER_DRAIN = false;
    const float* SSPs; unsigned char* ws;
    __device__ __forceinline__ void operator()(const f32x4 (&acc)[2][2][4][2], const pg8::Unit& u, int wr, int wc, int fr, int fq) const {
        const int row0 = u.pm * 256 + wr * 64 + fr, pn = u.pn, cw = wc * 32 + 8 * fq;
#pragma unroll
        for (int ai = 0; ai < 2; ++ai)
#pragma unroll
            for (int m = 0; m < 4; ++m) {
                const int r = row0 + ai * 128 + m * 16;
                const float rs = row_rs(SSPs, 0, r);
#pragma unroll
                for (int bj = 0; bj < 2; ++bj) {
                    f32x4 v0 = acc[ai][bj][m][0] * rs, v1 = acc[ai][bj][m][1] * rs;
                    if (pn < 2) { v0 = v0 * QSCALE; v1 = v1 * QSCALE; *(u32x4*)((bf16*)(ws + WS_Q) + (size_t)r * 512 + pn * 256 + bj * 128 + cw) = pack8(v0, v1); }
                    else if (pn < 5) { const int j = 2 * (pn - 2) + bj, g = cw >> 6, d = cw & 63, b = r / T_, t = r % T_;
                        *(u32x4*)((bf16*)(ws + WS_KV + j * KV_STRIDE) + (((size_t)b * NG + g) * T_ + t) * 64 + d) = pack8(v0, v1); }
                    else if (pn < 7) *(u32x4*)((bf16*)(ws + WS_XR) + (size_t)r * 512 + (pn - 5) * 256 + bj * 128 + cw) = pack8(v0, v1);
                    else if (pn < 9) *(u32x4*)((bf16*)(ws + WS_YG) + (size_t)r * 512 + (pn - 7) * 256 + bj * 128 + cw) = pack8(v0, v1);
                    else if (bj == 0 && cw < 24) { float* gp = (float*)(ws + WS_GATE) + (size_t)r * 24 + cw;
                        *(f32x4*)gp = (f32x4){sigmoidf_(v0[0]), sigmoidf_(v0[1]), sigmoidf_(v0[2]), sigmoidf_(v0[3])}; *(f32x4*)(gp + 4) = (f32x4){sigmoidf_(v1[0]), sigmoidf_(v1[1]), sigmoidf_(v1[2]), sigmoidf_(v1[3])}; }
                }
                asm volatile("" ::: "memory");
            }
    }
};
#define UNPK_LO(v_) ((f32x4){blo((v_).x), bhi((v_).x), blo((v_).y), bhi((v_).y)})
#define UNPK_HI(v_) ((f32x4){blo((v_).z), bhi((v_).z), blo((v_).w), bhi((v_).w)})
template <int MODE> struct EpiResid {
    static constexpr bool PERM = true, AFTER_DRAIN = false;
    const bf16* RIN; bf16* ROUT; float* SSPo; const float* SSPi; const bf16* PROJ;
    __device__ __forceinline__ void operator()(const f32x4 (&acc)[2][2][4][2], const pg8::Unit& u, int wr, int wc, int fr, int fq) const {
        const int row0 = u.pm * 256 + wr * 64 + fr, col0 = u.pn * 256 + wc * 32 + 8 * fq;
#pragma unroll
        for (int ai = 0; ai < 2; ++ai)
#pragma unroll
            for (int m = 0; m < 4; ++m) {
                const int r = row0 + ai * 128 + m * 16; float ss = 0.f; float rs = 1.f;
                if (MODE == 1) rs = row_rs(SSPi, 0, r);
#pragma unroll
                for (int bj = 0; bj < 2; ++bj) {
                    const size_t off = (size_t)r * D_ + col0 + bj * 128;
                    f32x4 a0 = acc[ai][bj][m][0], a1 = acc[ai][bj][m][1];
                    if (MODE == 1) { const u32x4 pw = *(const u32x4*)(PROJ + off);
                        a0 = (f32x4){sigmoidf_(a0[0] * rs) * __uint_as_float(pw.x << 16), sigmoidf_(a0[1] * rs) * __uint_as_float(pw.x & 0xffff0000u), sigmoidf_(a0[2] * rs) * __uint_as_float(pw.y << 16), sigmoidf_(a0[3] * rs) * __uint_as_float(pw.y & 0xffff0000u)};
                        a1 = (f32x4){sigmoidf_(a1[0] * rs) * __uint_as_float(pw.z << 16), sigmoidf_(a1[1] * rs) * __uint_as_float(pw.z & 0xffff0000u), sigmoidf_(a1[2] * rs) * __uint_as_float(pw.w << 16), sigmoidf_(a1[3] * rs) * __uint_as_float(pw.w & 0xffff0000u)}; }
                    const u32x4 xw = *(const u32x4*)(RIN + off);
                    const f32x4 x0 = UNPK_LO(xw) + a0, x1 = UNPK_HI(xw) + a1;
                    *(u32x4*)(ROUT + off) = pack8(x0, x1);
                    ss += ((x0[0] * x0[0] + x0[1] * x0[1]) + (x0[2] * x0[2] + x0[3] * x0[3])) + ((x1[0] * x1[0] + x1[1] * x1[1]) + (x1[2] * x1[2] + x1[3] * x1[3]));
                }
                { const int ln = fq * 16 + fr; ss += shx(ss, 16, ln); ss += shx(ss, 32, ln); }
                if (fq == 0) SSPo[(size_t)r * 16 + u.pn * 4 + wc] = ss;
                asm volatile("" ::: "memory");
            }
    }
};
template <> struct EpiResid<0> {
    static constexpr bool PERM = true, AFTER_DRAIN = false;
    const bf16* RIN; bf16* ROUT; float* SSPo; const float* SSPi; const bf16* PROJ; int x8mode; float post; int qstage;
    __device__ __forceinline__ void operator()(const f32x4 (&acc)[2][2][4][2], const pg8::Unit& u, int wr, int wc, int fr, int fq) const {
        const int row0 = u.pm * 256 + wr * 64 + fr, col0 = u.pn * 256 + wc * 32 + 8 * fq;
        KArgs ka = kargs(); unsigned char* const X8 = x8mode ? (unsigned char*)ka->out + X8_OFF : (unsigned char*)nullptr;
        const float* const SSPq = (x8mode == 2) ? (const float*)(ka->ws + WS_SSP) + (size_t)qstage * NTOK * 16 : (const float*)nullptr; float* const XSCI = (float*)(ka->ws + MS_XSCI);
        u32x4 xb[2][2];
#pragma unroll
        for (int bj = 0; bj < 2; ++bj) xb[0][bj] = *(const u32x4*)(RIN + (size_t)row0 * D_ + col0 + bj * 128);
#pragma unroll
        for (int it = 0; it < 8; ++it) {
            const int ai = it >> 2, m = it & 3, r = row0 + ai * 128 + m * 16;
            if (it + 1 < 8) { const int rn = row0 + ((it + 1) >> 2) * 128 + ((it + 1) & 3) * 16;
#pragma unroll
                for (int bj = 0; bj < 2; ++bj) xb[(it + 1) & 1][bj] = *(const u32x4*)(RIN + (size_t)rn * D_ + col0 + bj * 128); }
            float ss = 0.f; float qs = 0.f;
            if (SSPq) { const f32x4* sp = (const f32x4*)(SSPq + (size_t)r * 16); const f32x4 s0 = sp[0], s1 = sp[1], s2 = sp[2], s3 = sp[3];
                const float ms = (((s0.x + s0.y) + (s0.z + s0.w)) + ((s1.x + s1.y) + (s1.z + s1.w)) + ((s2.x + s2.y) + (s2.z + s2.w)) + ((s3.x + s3.y) + (s3.z + s3.w))) * (1.f / D_);
                const float qi = XQ_CLIP * (1.f / 127.f) * __builtin_amdgcn_sqrtf(ms + 1.2f); qs = __builtin_amdgcn_rcpf(qi);
                if (u.pn == 0 && wc == 0 && fq == 0) XSCI[r] = qi; }
#pragma unroll
            for (int bj = 0; bj < 2; ++bj) {
                const size_t off = (size_t)r * D_ + col0 + bj * 128;
                const f32x4 x0 = UNPK_LO(xb[it & 1][bj]) + acc[ai][bj][m][0] * post, x1 = UNPK_HI(xb[it & 1][bj]) + acc[ai][bj][m][1] * post;
                *(u32x4*)(ROUT + off) = pack8(x0, x1);
                if (X8 && SSPq) { auto q8 = [](float x) { return (unsigned)(int)__builtin_rintf(__builtin_amdgcn_fmed3f(x, -127.f, 127.f)) & 255u; };
                    const unsigned w0 = q8(x0[0] * qs) | (q8(x0[1] * qs) << 8) | (q8(x0[2] * qs) << 16) | (q8(x0[3] * qs) << 24), w1 = q8(x1[0] * qs) | (q8(x1[1] * qs) << 8) | (q8(x1[2] * qs) << 16) | (q8(x1[3] * qs) << 24);
                    *(u32x2*)(X8 + off) = (u32x2){w0, w1}; }
                else if (X8) { int w0 = 0, w1 = 0;
                    w0 = __builtin_amdgcn_cvt_pk_fp8_f32(x0[0] * X8_SCALE, x0[1] * X8_SCALE, w0, false); w0 = __builtin_amdgcn_cvt_pk_fp8_f32(x0[2] * X8_SCALE, x0[3] * X8_SCALE, w0, true);
                    w1 = __builtin_amdgcn_cvt_pk_fp8_f32(x1[0] * X8_SCALE, x1[1] * X8_SCALE, w1, false); w1 = __builtin_amdgcn_cvt_pk_fp8_f32(x1[2] * X8_SCALE, x1[3] * X8_SCALE, w1, true);
                    *(u32x2*)(X8 + off) = (u32x2){(unsigned)w0, (unsigned)w1}; }
                ss += ((x0[0] * x0[0] + x0[1] * x0[1]) + (x0[2] * x0[2] + x0[3] * x0[3])) + ((x1[0] * x1[0] + x1[1] * x1[1]) + (x1[2] * x1[2] + x1[3] * x1[3]));
            }
            { const int ln = fq * 16 + fr; ss += shx(ss, 16, ln); ss += shx(ss, 32, ln); }
            if (fq == 0) SSPo[(size_t)r * 16 + u.pn * 4 + wc] = ss;
            asm volatile("" ::: "memory");
        }
    }
};
template <bool F8, bool IACC = false> struct EpiSwiglu {
    static constexpr bool PERM = true, AFTER_DRAIN = false;
    bf16* ACT; int ldc; const float* SSPi; const float* ROWRS; float post; const float* XSCI;
    __device__ __forceinline__ void operator()(const f32x4 (&acc)[2][2][4][2], const pg8::Unit& u, int wr, int wc, int fr, int fq) const {
        const int row0 = u.pm * 256 + wr * 64 + fr, col0 = u.pn * 128 + wc * 32 + 8 * fq;
#pragma unroll
        for (int ai = 0; ai < 2; ++ai)
#pragma unroll
            for (int m = 0; m < 4; ++m) {
                const int r = row0 + ai * 128 + m * 16; const float rs = ROWRS ? ROWRS[r] : row_rs(SSPi, 0, r) * post * (XSCI ? XSCI[r] : 1.f);
                f32x4 o[2];
#pragma unroll
                for (int n = 0; n < 2; ++n) { f32x4 ga = acc[ai][0][m][n], ua = acc[ai][1][m][n];
                    if constexpr (IACC) { const i32x4v gi = __builtin_bit_cast(i32x4v, ga), ui = __builtin_bit_cast(i32x4v, ua); ga = (f32x4){(float)gi.x, (float)gi.y, (float)gi.z, (float)gi.w}; ua = (f32x4){(float)ui.x, (float)ui.y, (float)ui.z, (float)ui.w}; }
                    const f32x4 g = ga * rs, up = ua * rs; o[n] = (f32x4){silu_(g[0]) * up[0], silu_(g[1]) * up[1], silu_(g[2]) * up[2], silu_(g[3]) * up[3]}; }
                if constexpr (F8) { int w0 = 0, w1 = 0;
#pragma unroll
                    for (int n = 0; n < 2; ++n)
#pragma unroll
                        for (int i = 0; i < 4; ++i) o[n][i] = __builtin_amdgcn_fmed3f(o[n][i] * ACT8_SCALE, -448.f, 448.f);
                    w0 = __builtin_amdgcn_cvt_pk_fp8_f32(o[0][0], o[0][1], w0, false); w0 = __builtin_amdgcn_cvt_pk_fp8_f32(o[0][2], o[0][3], w0, true);
                    w1 = __builtin_amdgcn_cvt_pk_fp8_f32(o[1][0], o[1][1], w1, false); w1 = __builtin_amdgcn_cvt_pk_fp8_f32(o[1][2], o[1][3], w1, true);
                    *(u32x2*)((unsigned char*)ACT + (size_t)r * ldc + col0) = (u32x2){(unsigned)w0, (unsigned)w1}; }
                else *(u32x4*)(ACT + (size_t)r * ldc + col0) = pack8(o[0], o[1]);
                asm volatile("" ::: "memory");
            }
    }
};
struct EpiPlain {
    static constexpr bool PERM = true, AFTER_DRAIN = false;
    bf16* O; int ldc;
    __device__ __forceinline__ void operator()(const f32x4 (&acc)[2][2][4][2], const pg8::Unit& u, int wr, int wc, int fr, int fq) const {
        const int row0 = u.pm * 256 + wr * 64 + fr, col0 = u.pn * 256 + wc * 32 + 8 * fq;
#pragma unroll
        for (int ai = 0; ai < 2; ++ai)
#pragma unroll
            for (int m = 0; m < 4; ++m)
#pragma unroll
                for (int bj = 0; bj < 2; ++bj) { *(u32x4*)(O + (size_t)(row0 + ai * 128 + m * 16) * ldc + col0 + bj * 128) = pack8(acc[ai][bj][m][0], acc[ai][bj][m][1]); asm volatile("" ::: "memory"); }
    }
};
#define GEMM_LDS(c) ((PG8_LAS unsigned char*)(c).lds)
struct SubOrder {
    pg8::StaticOrder S; int lo, hi;
    __device__ __forceinline__ bool next(int i, pg8::Unit& u) const { return (lo + i < hi) && S.next(lo + i, u); }
    __device__ __forceinline__ void a_ready(const pg8::Unit&) const {}
    __device__ __forceinline__ void done(const pg8::Unit&) const {}
};
__device__ __forceinline__ void phase_inproj_mfma(Ctx c, int L, int stage, int ulo = 0, int uhi = 1 << 20) {
    KArgs ka = kargs(); unsigned char* ws = CA_WS;
    pg8::Gemm g{(const pg8::bf16_t*)(L == 0 ? c.XB : c.XO),
 (const pg8::bf16_t*)((bf16*)(ws + WB_IN) + (size_t)L * N_IN_PAD * D_), NTOK, N_IN_PAD, D_, nullptr, 0, 0, 0}; pg8::StaticOrder S; S.init(NTOK, N_IN_PAD, c.nblk, c.bid);
    EpiInproj E{c.SSP + (size_t)stage * NTOK * 16, ws};
    SubOrder SS{S, ulo, uhi};
    pg8::gemm_phase<EpiInproj, SubOrder, true, true>(GEMM_LDS(c), g, SS, E, c.tid);
}
__device__ __forceinline__ void phase_outproj_mfma(Ctx c, int L, int stage_out) {
    KArgs ka = kargs(); unsigned char* ws = CA_WS;
    pg8::Gemm g{(const pg8::bf16_t*)(ws + WS_MIXED), (const pg8::bf16_t*)((bf16*)(ws + WB_OUT) + (size_t)L * D_ * D_), NTOK, D_, D_, nullptr, 0, 0, 0}; pg8::StaticOrder S; S.init(NTOK, D_, c.nblk, c.bid);
    EpiResid<0> E{(L == 0) ? c.XB : c.XO, c.XB, c.SSP + (size_t)stage_out * NTOK * 16, nullptr, nullptr, (L == 0) ? 2 : 1, 1.f, stage_out - 1};
    pg8::gemm_phase<EpiResid<0>, pg8::StaticOrder, true, true>(GEMM_LDS(c), g, S, E, c.tid);
}
__device__ __forceinline__ void phase_ffn_gu_mfma(Ctx c, int stage) {
    KArgs ka = kargs(); unsigned char* ws = CA_WS;
    pg8::Gemm g{(const pg8::bf16_t*)((unsigned char*)ka->out + X8_OFF), (const pg8::bf16_t*)(ws + WB_GU), NTOK, 2 * D_FF, D_ / 2, nullptr, 0, 0, 0}; pg8::StaticOrder S; S.init(NTOK, 2 * D_FF, c.nblk, c.bid);
    EpiSwiglu<true, true> E{(bf16*)(ws + WS_ACT), D_FF, c.SSP + (size_t)stage * NTOK * 16, nullptr, 1.f / WI8_SCALE, (const float*)(ws + MS_XSCI)};
    pg8::gemm_phase<EpiSwiglu<true, true>, pg8::StaticOrder, true, true, pg8::RowsIdent, false, true>(GEMM_LDS(c), g, S, E, c.tid);
}
__device__ __forceinline__ void phase_ffn_dn_mfma(Ctx c, int stage_out) {
    KArgs ka = kargs(); unsigned char* ws = CA_WS;
    pg8::Gemm g{(const pg8::bf16_t*)(ws + WS_ACT), (const pg8::bf16_t*)(ws + WB_DN), NTOK, D_, D_FF / 2, nullptr, 0, 0, 0}; pg8::StaticOrder S; S.init(NTOK, D_, c.nblk, c.bid);
    EpiResid<0> E{c.XB, c.XB, c.SSP + (size_t)stage_out * NTOK * 16, nullptr, nullptr, 0, 1.f / (W8_SCALE * ACT8_SCALE), 0};
    pg8::gemm_phase<EpiResid<0>, pg8::StaticOrder, true, true, pg8::RowsIdent, true>(GEMM_LDS(c), g, S, E, c.tid);
}
__device__ __forceinline__ void phase_ple_proj_mfma(Ctx c, int L) {
    KArgs ka = kargs(); unsigned char* ws = CA_WS;
    pg8::Gemm g{(const pg8::bf16_t*)((bf16*)(ws + WS_PB) + (size_t)L * NTOK * PLE_DIM), (const pg8::bf16_t*)((bf16*)(ws + WB_PLEP) + (size_t)L * D_ * PLE_DIM), NTOK, D_, PLE_DIM, nullptr, 0, 0, 0}; pg8::StaticOrder S; S.init(NTOK, D_, c.nblk, c.bid);
    EpiPlain E{(bf16*)(ws + WS_PROJ), D_};
    pg8::gemm_phase<EpiPlain, pg8::StaticOrder, true, true>(GEMM_LDS(c), g, S, E, c.tid);
}
__device__ __forceinline__ void phase_ple_mfma(Ctx c, int L, int stage_in, int stage_out) {
    KArgs ka = kargs(); unsigned char* ws = CA_WS;
    pg8::Gemm g{(const pg8::bf16_t*)c.XB, (const pg8::bf16_t*)((bf16*)(ws + WB_PLEG) + (size_t)L * D_ * D_), NTOK, D_, D_, nullptr, 0, 0, 0}; pg8::StaticOrder S; S.init(NTOK, D_, c.nblk, c.bid);
    EpiResid<1> E{c.XB, (L + 1 < DEPTH) ? c.XO : (bf16*)(ws + WS_MIXED), c.SSP + (size_t)stage_out * NTOK * 16, c.SSP + (size_t)stage_in * NTOK * 16, (const bf16*)(ws + WS_PROJ)};
    pg8::gemm_phase<EpiResid<1>, pg8::StaticOrder, true, true>(GEMM_LDS(c), g, S, E, c.tid);
}

struct MoeOrder {
    pg8::StaticOrder S; int p_lo;
    __device__ __forceinline__ MoeOrder(int p_lo_, int np, int nN, int G, int c) : p_lo(p_lo_) { S.init(np * 256, nN * 256, G, c); }
    __device__ __forceinline__ bool next(int i, pg8::Unit& u) const { if (!S.next(i, u)) return false; u.pm += p_lo; return true; }
    __device__ __forceinline__ void a_ready(const pg8::Unit&) const {}
    __device__ __forceinline__ void done(const pg8::Unit&) const {}
};
template <bool LAST> struct EpiMoeDn {
    static constexpr bool PERM = true, AFTER_DRAIN = false;
    const bf16* RIN; bf16* ROUT; float* SSPo; const int* SLOT_TOK; const float* SLOT_G;
    __device__ __forceinline__ void operator()(const f32x4 (&acc)[2][2][4][2], const pg8::Unit& u, int wr, int wc, int fr, int fq) const {
        const int row0 = u.pm * 256 + wr * 64 + fr, col0 = u.pn * 256 + wc * 32 + 8 * fq, ln = fq * 16 + fr;
#pragma unroll
        for (int ai = 0; ai < 2; ++ai)
#pragma unroll
            for (int m = 0; m < 4; ++m) {
                const int r = row0 + ai * 128 + m * 16; const int tok = SLOT_TOK[r]; const float g = SLOT_G[r]; float ss = 0.f;
                if (tok >= 0) {
#pragma unroll
                    for (int bj = 0; bj < 2; ++bj) {
                        const size_t off = (size_t)tok * D_ + col0 + bj * 128;
                        const u32x4 xw = *(const u32x4*)(RIN + off);
                        const f32x4 x0 = UNPK_LO(xw) + acc[ai][bj][m][0] * g, x1 = UNPK_HI(xw) + acc[ai][bj][m][1] * g;
                        *(u32x4*)(ROUT + off) = pack8(x0, x1);
                        if (LAST) ss += ((x0[0] * x0[0] + x0[1] * x0[1]) + (x0[2] * x0[2] + x0[3] * x0[3])) + ((x1[0] * x1[0] + x1[1] * x1[1]) + (x1[2] * x1[2] + x1[3] * x1[3]));
                    }
                }
                if (LAST) { ss += shx(ss, 16, ln); ss += shx(ss, 32, ln); if (fq == 0 && tok >= 0) SSPo[(size_t)tok * 16 + u.pn * 4 + wc] = ss; }
                asm volatile("" ::: "memory");
            }
    }
};
__device__ __forceinline__ void phase_moe_gu_mfma(Ctx c, int k) {
    KArgs ka = kargs(); unsigned char* ws = CA_WS; const int* PANEL_E = (const int*)(ws + MS_PANELE);
    const int P0 = PANEL_E[300], PT = PANEL_E[301], p_lo = k ? P0 : 0, np = k ? PT - P0 : P0;
    pg8::Gemm g{(const pg8::bf16_t*)((unsigned char*)ka->out + X8_OFF), (const pg8::bf16_t*)(ws + WB_MGU), NSLOT, 2 * D_FFE, D_ / 2, PANEL_E, (size_t)2 * D_FFE * (D_ / 2), 0, 0};
    MoeOrder S(p_lo, np, 2 * D_FFE / 256, c.nblk, c.bid);
    EpiSwiglu<true> E{(bf16*)(ws + WS_ACT - (size_t)p_lo * 256 * D_FFE), D_FFE, nullptr, (const float*)(ws + MS_SLOTRS), 1.f, nullptr};
    pg8::gemm_phase<EpiSwiglu<true>, MoeOrder, true, true, pg8::RowsGather, true>(GEMM_LDS(c), g, S, E, c.tid, pg8::RowsGather{(const int*)(ws + MS_SLOTTOK)});
}
struct TailOrder {
    int p_first, nunits, G, c;
    __device__ __forceinline__ bool next(int i, pg8::Unit& u) const { const int L = i * G + c; if (L >= nunits) return false; u.pm = p_first + L / (4 * DN_KSPLIT); u.pn = (L / DN_KSPLIT) & 3; u.kofs = (L % DN_KSPLIT) * DN_KSLICE_P; return true; }
    __device__ __forceinline__ void a_ready(const pg8::Unit&) const {}
    __device__ __forceinline__ void done(const pg8::Unit&) const {}
};
struct EpiPartial {
    static constexpr bool PERM = true, AFTER_DRAIN = false;
    float* PART; int p_first;
    __device__ __forceinline__ void operator()(const f32x4 (&acc)[2][2][4][2], const pg8::Unit& u, int wr, int wc, int fr, int fq) const {
        float* T = PART + (size_t)((((u.pm - p_first) * 4 + u.pn) * DN_KSPLIT) + u.kofs / DN_KSLICE_P) * 65536;
#pragma unroll
        for (int ai = 0; ai < 2; ++ai)
#pragma unroll
            for (int m = 0; m < 4; ++m)
#pragma unroll
                for (int bj = 0; bj < 2; ++bj) { float* p = T + (size_t)(ai * 128 + wr * 64 + m * 16 + fr) * 256 + bj * 128 + wc * 32 + 8 * fq; *(f32x4*)p = acc[ai][bj][m][0]; *(f32x4*)(p + 4) = acc[ai][bj][m][1]; asm volatile("" ::: "memory"); }
    }
};
template <bool LAST>
__device__ __forceinline__ void phase_moe_dn_mfma(Ctx c, int k, int stage_out) {
    KArgs ka = kargs(); unsigned char* ws = CA_WS; const int* PANEL_E = (const int*)(ws + MS_PANELE);
    const int P0 = PANEL_E[300], PT = PANEL_E[301], p_lo = k ? P0 : 0, np = k ? PT - P0 : P0;
    const int nmain = np < DN_MAIN_PANELS ? np : DN_MAIN_PANELS, ntail = np - nmain;
    const pg8::bf16_t* A = (const pg8::bf16_t*)(ws + WS_ACT - (size_t)p_lo * 256 * D_FFE);
    { pg8::Gemm g{A, (const pg8::bf16_t*)(ws + WB_MDN), NSLOT, D_, D_FFE / 2, PANEL_E, (size_t)D_ * (D_FFE / 2), 0, 0};
      MoeOrder S(p_lo, nmain, D_ / 256, c.nblk, c.bid);
      EpiMoeDn<LAST> E{LAST ? c.XO : c.XB, LAST ? c.XB : c.XO, c.SSP + (size_t)stage_out * NTOK * 16, (const int*)(ws + MS_SLOTTOK), (const float*)(ws + MS_SLOTG)};
      pg8::gemm_phase<EpiMoeDn<LAST>, MoeOrder, true, true, pg8::RowsIdent, true>(GEMM_LDS(c), g, S, E, c.tid); }
    if (ntail > 0) {
      pg8::Gemm g{A, (const pg8::bf16_t*)(ws + WB_MDN), NSLOT, D_, DN_KSLICE_P, PANEL_E, (size_t)D_ * (D_FFE / 2), D_FFE / 2, D_FFE / 2};
      TailOrder S{p_lo + nmain, ntail * 4 * DN_KSPLIT, c.nblk, c.bid};
      EpiPartial E{(float*)(ws + WS_PART), p_lo + nmain};
      pg8::gemm_phase<EpiPartial, TailOrder, true, true, pg8::RowsIdent, true>(GEMM_LDS(c), g, S, E, c.tid); }
}
template <bool LAST>
__device__ __forceinline__ void phase_moe_dn_reduce(Ctx c, int k, int stage_out) {
    KArgs ka = kargs(); unsigned char* ws = CA_WS; const int* PANEL_E = (const int*)(ws + MS_PANELE);
    const int P0 = PANEL_E[300], PT = PANEL_E[301], p_lo = k ? P0 : 0, np = k ? PT - P0 : P0;
    const int nmain = np < DN_MAIN_PANELS ? np : DN_MAIN_PANELS, ntail = np - nmain;
    const float* PART = (const float*)(ws + WS_PART); const int* SLOT_TOK = (const int*)(ws + MS_SLOTTOK); const float* SLOT_G = (const float*)(ws + MS_SLOTG);
    float* SSPo = c.SSP + (size_t)stage_out * NTOK * 16;
    const int gw = c.bid * NWAVES + c.wave, NGW = c.nblk * NWAVES, nitem = ntail * 4 * 256;
    for (int it = gw; it < nitem; it += NGW) {
        const int tt = it >> 8, r = it & 255, tp = tt >> 2, pn = tt & 3; const int slot = (p_lo + nmain + tp) * 256 + r; const int tok = SLOT_TOK[slot];
        if (tok < 0) continue;
        const float g = SLOT_G[slot];
        f32x4 y = (f32x4){0.f, 0.f, 0.f, 0.f};
#pragma unroll
        for (int ks = 0; ks < DN_KSPLIT; ++ks) y += *(const f32x4*)(PART + ((size_t)(tt * DN_KSPLIT + ks) * 256 + r) * 256 + 4 * c.lane);
        const size_t off = (size_t)tok * D_ + pn * 256 + 4 * c.lane;
        const u32x2 xw = *(const u32x2*)((LAST ? c.XO : c.XB) + off);
        const f32x4 x = (f32x4){blo(xw.x), bhi(xw.x), blo(xw.y), bhi(xw.y)} + y * g;
        { u32x2 w; w.x = pk2(x[0], x[1]); w.y = pk2(x[2], x[3]); *(u32x2*)((LAST ? c.XB : c.XO) + off) = w; }
        if (LAST) {
            float ss = (x[0] * x[0] + x[1] * x[1]) + (x[2] * x[2] + x[3] * x[3]);
            ss += shx(ss, 1, c.lane); ss += shx(ss, 2, c.lane); ss += shx(ss, 4, c.lane); ss += shx(ss, 8, c.lane);
            if ((c.lane & 15) == 0) SSPo[(size_t)tok * 16 + pn * 4 + (c.lane >> 4)] = ss; }
    }
}

__global__ void __launch_bounds__(NTHR, 2) fwd_kernel(Args args) {
    extern __shared__ __attribute__((aligned(16))) unsigned char lds_raw[];
    Ctx c; c.lds = (LAS float*)lds_raw; c.tid = threadIdx.x; c.lane = c.tid & 63; c.wave = __builtin_amdgcn_readfirstlane(c.tid >> 6); c.bid = blockIdx.x; c.nblk = gridDim.x;
    { KArgs k0 = kargs(); c.XO = (bf16*)k0->out; c.XB = (bf16*)(k0->ws + WS_XB); c.SSP = (float*)(k0->ws + WS_SSP); }
    volatile LAS unsigned* MISC = (volatile LAS unsigned*)((LAS unsigned char*)lds_raw + MISC_OFF);
    for (int u = c.tid; u < (LDS_BYTES - LDSCTL_OFF) / 4; u += NTHR) ((LAS unsigned*)((LAS unsigned char*)lds_raw + LDSCTL_OFF))[u] = 0u;
    __syncthreads();
    KArgs kb = kargs();
    (void)xcd_barrier_post((unsigned*)(kb->ws + WS_CTL) + CW_BAR, MISC + 8, c.tid == 0);
#define BAR() do { KArgs kq = kargs(); xcd_barrier((unsigned*)(kq->ws + WS_CTL) + CW_BAR, MISC + 8, c.wave); } while (0)
    { KArgs k1 = kargs(); phase_fix(fresh(c), k1->in[I_X], 0); phase_convert<0>(fresh(c)); } BAR();
    { constexpr int L = 0;

        constexpr int s0 = 3 * L;
        { const int kgap = c.bid % 6;
          phase_inproj_mfma(fresh(c), L, s0, 0, kgap); __syncthreads(); phase_convert<1>(fresh(c)); __syncthreads(); phase_inproj_mfma(fresh(c), L, s0, kgap, 1 << 20); } BAR();
        phase_cmp_mfma(fresh(c), L); __syncthreads(); phase_lru<false>(fresh(c), L); BAR();
        phase_attn_mfma(fresh(c)); __syncthreads(); phase_lru<true>(fresh(c), L); BAR();
        phase_outproj_mfma(fresh(c), L, s0 + 1); BAR();
        if (L == 0) {
            phase_ffn_gu_mfma(fresh(c), s0 + 1); BAR();
            phase_ffn_dn_mfma(fresh(c), s0 + 2); BAR();
        } else {
            phase_moe_route(fresh(c), s0 + 1); BAR(); phase_moe_slots(fresh(c), s0 + 1); BAR();
            phase_moe_gu_mfma(fresh(c), 0); BAR();
            phase_moe_dn_mfma<false>(fresh(c), 0, s0 + 2); BAR();
            phase_moe_dn_reduce<false>(fresh(c), 0, s0 + 2); phase_moe_gu_mfma(fresh(c), 1); BAR();
            phase_moe_dn_mfma<true>(fresh(c), 1, s0 + 2); BAR();
        }
        if (L == 1) phase_moe_dn_reduce<true>(fresh(c), 1, s0 + 2);
        phase_ple_proj_mfma(fresh(c), L); BAR();
        phase_ple_mfma(fresh(c), L, s0 + 2, s0 + 3); BAR();
    }
    { constexpr int L = 1;

        constexpr int s0 = 3 * L;
        phase_inproj_mfma(fresh(c), L, s0); BAR();
        phase_cmp_mfma(fresh(c), L); __syncthreads(); phase_lru<false>(fresh(c), L); BAR();
        phase_attn_mfma(fresh(c)); __syncthreads(); phase_lru<true>(fresh(c), L); BAR();
        phase_outproj_mfma(fresh(c), L, s0 + 1); BAR();
        if (L == 0) {
            phase_ffn_gu_mfma(fresh(c), s0 + 1); BAR();
            phase_ffn_dn_mfma(fresh(c), s0 + 2); BAR();
        } else {
            phase_moe_route(fresh(c), s0 + 1); BAR(); phase_moe_slots(fresh(c), s0 + 1); BAR();
            phase_moe_gu_mfma(fresh(c), 0); BAR();
            phase_moe_dn_mfma<false>(fresh(c), 0, s0 + 2); BAR();
            phase_moe_dn_reduce<false>(fresh(c), 0, s0 + 2); phase_moe_gu_mfma(fresh(c), 1); BAR();
            phase_moe_dn_mfma<true>(fresh(c), 1, s0 + 2); BAR();
        }
        if (L == 1) phase_moe_dn_reduce<true>(fresh(c), 1, s0 + 2);
        phase_ple_proj_mfma(fresh(c), L); BAR();
        phase_ple_mfma(fresh(c), L, s0 + 2, s0 + 3); BAR();
    }
    phase_final(fresh(c), 3 * DEPTH);
#undef BAR
}

extern "C" void kernel_launch(void* const* d_in, const int* in_sizes, int n_in, void* d_out, int out_size, void* d_ws, size_t ws_size, hipStream_t stream) {
    static int grid = 0;
    if (grid == 0) {
        if (n_in != N_IN || out_size != NTOK * D_ || ws_size < WS_NEED2) { fprintf(stderr, "kernel_launch: unexpected arguments (n_in %d, out %d, ws %zu < %zu)\n", n_in, out_size, ws_size, (size_t)WS_NEED2); grid = -1; return; }
        int dev = 0, cus = 0;
        if (hipGetDevice(&dev) != hipSuccess || hipDeviceGetAttribute(&cus, hipDeviceAttributeMultiprocessorCount, dev) != hipSuccess) { grid = -1; return; }
        if (hipFuncSetAttribute((const void*)fwd_kernel, hipFuncAttributeMaxDynamicSharedMemorySize, LDS_BYTES) != hipSuccess) { grid = -1; return; }
        int per_cu = 0;
        (void)hipOccupancyMaxActiveBlocksPerMultiprocessor(&per_cu, (const void*)fwd_kernel, NTHR, LDS_BYTES);
        (void)hipGetLastError();
        grid = cus;
    }
    if (grid < 0) return;
    (void)hipMemsetAsync((char*)d_ws + WS_CTL, 0, CTL_ZERO_BYTES, stream);
    Args a{};
    for (int i = 0; i < N_IN; ++i) a.in[i] = (const float*)d_in[i];
    a.out = (float*)d_out; a.ws = (unsigned char*)d_ws; a.li = 0; a.pad = 0;
    a.ph_lo = 0; a.ph_hi = 0;
    hipLaunchKernelGGL(fwd_kernel, dim3(grid), dim3(NTHR), LDS_BYTES, stream, a);
}
```
